# Optimizing an MI355X kernel written in HIP

```python
import jax, jax.numpy as jnp
from jax import lax
import numpy as np

D_MODEL = 1024
BATCH = 4
SEQ = 8192
DEPTH = 4

GRID_W = 64
CTX_LEN = 256
N_MIXERS = 3
Q_BLOCK = 128
ROPE_THETA = 10000.0
NORM_EPS = 1e-6

GQA_HEAD_DIM = 128
GQA_HEADS = D_MODEL // GQA_HEAD_DIM
GQA_KV_HEADS = GQA_HEADS // 4
GQA_GROUP = GQA_HEADS // GQA_KV_HEADS
GQA_WIDTH = GQA_HEADS * GQA_HEAD_DIM
GQA_KV_WIDTH = GQA_KV_HEADS * GQA_HEAD_DIM
GQA_PROJ = 2 * GQA_WIDTH + 2 * GQA_KV_WIDTH

NA_HEAD_DIM = 64
NA_HEADS = D_MODEL // NA_HEAD_DIM
NA_WIDTH = NA_HEADS * NA_HEAD_DIM
NA_KH = 8
NA_KW = 16
NA_PROJ = 4 * NA_WIDTH

MLA_HEADS = 8
MLA_Q_LORA = 512
MLA_KV_LORA = 256
MLA_NOPE = 128
MLA_ROPE = 64
MLA_V = 128
MLA_WIDTH = MLA_HEADS * MLA_V
MLA_PROJ = MLA_Q_LORA + MLA_KV_LORA + MLA_ROPE + MLA_WIDTH

kernel_name = 'hybrid_gqa_natten_mla_prefix_dit'


def rms_norm(x, g):
    xf = x.astype(jnp.float32)
    y = xf * lax.rsqrt(jnp.mean(xf * xf, axis=-1, keepdims=True) + NORM_EPS)
    return (y * g.astype(jnp.float32)).astype(x.dtype)


def axial_rope_tables(n_tok, rot_dim):
    n_freq = rot_dim // 4
    inv = ROPE_THETA ** (-jnp.arange(n_freq, dtype=jnp.float32) / n_freq)
    t = jnp.arange(n_tok)
    row = (t // GRID_W).astype(jnp.float32)
    col = (t % GRID_W).astype(jnp.float32)
    ang_r = row[:, None] * inv
    ang_c = col[:, None] * inv
    ang = jnp.concatenate([ang_r, ang_r, ang_c, ang_c], axis=-1)
    return jnp.cos(ang), jnp.sin(ang)


def apply_axial_rope(x, cos, sin):
    n_freq = x.shape[-1] // 4
    bshape = (cos.shape[0],) + (1,) * (x.ndim - 3) + (cos.shape[1],)
    xs = x.reshape(x.shape[:-1] + (2, 2, n_freq))
    rot = jnp.concatenate([-xs[..., 1:2, :], xs[..., 0:1, :]], axis=-2).reshape(x.shape)
    return x * cos.reshape(bshape).astype(x.dtype) + rot * sin.reshape(bshape).astype(x.dtype)


def blocked_attention(q, k, v, scale):
    b, n_q = q.shape[:2]
    nb = n_q // Q_BLOCK
    qb = jnp.moveaxis(q.reshape((b, nb, Q_BLOCK) + q.shape[2:]), 1, 0)

    def one_block(q_blk):
        s = jnp.einsum('bqkgd,bnkd->bkgqn', q_blk, k, preferred_element_type=jnp.float32) * scale
        p = jax.nn.softmax(s, axis=-1).astype(v.dtype)
        return jnp.einsum('bkgqn,bnkd->bqkgd', p, v)

    o = lax.map(one_block, qb)
    return jnp.moveaxis(o, 0, 1).reshape((b, n_q) + o.shape[3:])


def gqa_axial_mixer(h_lat, h_ctx, w_in, q_g, k_g, w_out, cos, sin, need_ctx):
    def project(h):
        b, n = h.shape[:2]
        q, k, v, g = jnp.split(h @ w_in, [GQA_WIDTH, GQA_WIDTH + GQA_KV_WIDTH, GQA_WIDTH + 2 * GQA_KV_WIDTH], axis=-1)
        q = rms_norm(q.reshape(b, n, GQA_KV_HEADS, GQA_GROUP, GQA_HEAD_DIM), q_g)
        k = rms_norm(k.reshape(b, n, GQA_KV_HEADS, GQA_HEAD_DIM), k_g)
        v = v.reshape(b, n, GQA_KV_HEADS, GQA_HEAD_DIM)
        return q, k, v, g

    q_l, k_l, v_l, g_l = project(h_lat)
    q_c, k_c, v_c, g_c = project(h_ctx)
    q_l = apply_axial_rope(q_l, cos, sin)
    k_l = apply_axial_rope(k_l, cos, sin)
    scale = GQA_HEAD_DIM ** -0.5
    o_l = blocked_attention(q_l, jnp.concatenate([k_c, k_l], axis=1), jnp.concatenate([v_c, v_l], axis=1), scale)
    y_l = (o_l.reshape(h_lat.shape[:2] + (GQA_WIDTH,)) * jax.nn.silu(g_l)) @ w_out
    if not need_ctx:
        return y_l, None
    o_c = blocked_attention(q_c, k_c, v_c, scale)
    y_c = (o_c.reshape(h_ctx.shape[:2] + (GQA_WIDTH,)) * jax.nn.silu(g_c)) @ w_out
    return y_l, y_c


def neighbourhood_mixer(h_lat, h_ctx, w_in, rpb, w_out, need_ctx):
    b, n = h_lat.shape[:2]
    rows = n // GRID_W
    kh = min(NA_KH, rows)
    kw = NA_KW

    def project(h):
        q, k, v, g = jnp.split(h @ w_in, [NA_WIDTH, 2 * NA_WIDTH, 3 * NA_WIDTH], axis=-1)
        sh = h.shape[:2] + (NA_HEADS, NA_HEAD_DIM)
        return q.reshape(sh), k.reshape(sh), v.reshape(sh), g

    q_l, k_l, v_l, g_l = project(h_lat)
    q_c, k_c, v_c, g_c = project(h_ctx)
    grid = (b, rows, GRID_W, NA_HEADS, NA_HEAD_DIM)
    qg, kg, vg = q_l.reshape(grid), k_l.reshape(grid), v_l.reshape(grid)
    scale = NA_HEAD_DIM ** -0.5
    row_start = jnp.clip(jnp.arange(rows) - kh // 2, 0, rows - kh)
    col_idx = jnp.clip(jnp.arange(GRID_W) - kw // 2, 0, GRID_W - kw)[:, None] + jnp.arange(kw)
    col_off = col_idx - jnp.arange(GRID_W)[:, None] + (NA_KW - 1)

    def row_block(r):
        rs = row_start[r]
        q_r = lax.dynamic_index_in_dim(qg, r, axis=1, keepdims=False)
        k_win = lax.dynamic_slice_in_dim(kg, rs, kh, axis=1)[:, :, col_idx]
        v_win = lax.dynamic_slice_in_dim(vg, rs, kh, axis=1)[:, :, col_idx]
        row_off = rs + jnp.arange(kh) - r + (NA_KH - 1)
        bias = rpb[:, row_off[None, :, None], col_off[:, None, :]]
        s_loc = jnp.einsum('bqhd,biqjhd->bhqij', q_r, k_win, preferred_element_type=jnp.float32) * scale + bias
        s_ctx = jnp.einsum('bqhd,bchd->bhqc', q_r, k_c, preferred_element_type=jnp.float32) * scale
        s = jnp.concatenate([s_loc.reshape(b, NA_HEADS, GRID_W, kh * kw), s_ctx], axis=-1)
        p = jax.nn.softmax(s, axis=-1).astype(v_l.dtype)
        p_loc = p[..., :kh * kw].reshape(b, NA_HEADS, GRID_W, kh, kw)
        p_ctx = p[..., kh * kw:]
        return jnp.einsum('bhqij,biqjhd->bqhd', p_loc, v_win) + jnp.einsum('bhqc,bchd->bqhd', p_ctx, v_c)

    o = lax.map(row_block, jnp.arange(rows))
    o = jnp.moveaxis(o, 0, 1).reshape(b, n, NA_WIDTH)
    y_l = (o * jax.nn.silu(g_l)) @ w_out
    if not need_ctx:
        return y_l, None
    o_c = blocked_attention(q_c[:, :, :, None, :], k_c, v_c, scale)
    y_c = (o_c.reshape(h_ctx.shape[:2] + (NA_WIDTH,)) * jax.nn.silu(g_c)) @ w_out
    return y_l, y_c


def mla_mixer(h_lat, h_ctx, w_in, q_g, kv_g, w_uq, w_ukv, w_out, cos, sin, need_ctx):
    def project(h, use_rope):
        b, n = h.shape[:2]
        c_q, c_kv, k_r, g = jnp.split(h @ w_in, [MLA_Q_LORA, MLA_Q_LORA + MLA_KV_LORA, MLA_Q_LORA + MLA_KV_LORA + MLA_ROPE], axis=-1)
        q = (rms_norm(c_q, q_g) @ w_uq).reshape(b, n, MLA_HEADS, MLA_NOPE + MLA_ROPE)
        kv = (rms_norm(c_kv, kv_g) @ w_ukv).reshape(b, n, MLA_HEADS, MLA_NOPE + MLA_V)
        q_nope, q_rope = q[..., :MLA_NOPE], q[..., MLA_NOPE:]
        k_nope, v = kv[..., :MLA_NOPE], kv[..., MLA_NOPE:]
        k_r = k_r[:, :, None, :]
        if use_rope:
            q_rope = apply_axial_rope(q_rope, cos, sin)
            k_r = apply_axial_rope(k_r, cos, sin)
        q = jnp.concatenate([q_nope, q_rope], axis=-1)
        k = jnp.concatenate([k_nope, jnp.broadcast_to(k_r, (b, n, MLA_HEADS, MLA_ROPE))], axis=-1)
        return q, k, v, g

    q_l, k_l, v_l, g_l = project(h_lat, True)
    q_c, k_c, v_c, g_c = project(h_ctx, False)
    scale = (MLA_NOPE + MLA_ROPE) ** -0.5
    o_l = blocked_attention(q_l[:, :, :, None, :], jnp.concatenate([k_c, k_l], axis=1), jnp.concatenate([v_c, v_l], axis=1), scale)
    y_l = (o_l.reshape(h_lat.shape[:2] + (MLA_WIDTH,)) * jax.nn.silu(g_l)) @ w_out
    if not need_ctx:
        return y_l, None
    o_c = blocked_attention(q_c[:, :, :, None, :], k_c, v_c, scale)
    y_c = (o_c.reshape(h_ctx.shape[:2] + (MLA_WIDTH,)) * jax.nn.silu(g_c)) @ w_out
    return y_l, y_c


def setup_inputs(seed: int = 0) -> dict:
    key = jax.random.key(seed)
    ks = jax.random.split(key, 24)
    f32 = jnp.float32
    D = D_MODEL
    n_a = len(range(0, DEPTH, N_MIXERS))
    n_b = len(range(1, DEPTH, N_MIXERS))
    n_c = len(range(2, DEPTH, N_MIXERS))

    def dense(k, shape):
        return jax.random.normal(k, shape, f32) * shape[-2] ** -0.5

    def gain(k, shape):
        return 1.0 + 0.05 * jax.random.normal(k, shape, f32)

    return {
        'x': jax.random.normal(ks[0], (BATCH, SEQ, D), f32),
        'c': jax.random.normal(ks[1], (BATCH, D), f32),
        'ctx': jax.random.normal(ks[2], (BATCH, CTX_LEN, D), f32),
        'c_ctx': jax.random.normal(ks[3], (D,), f32),
        'mod_w': 0.5 * dense(ks[4], (DEPTH, D, 3 * D)),
        'mod_b': 0.01 * jax.random.normal(ks[5], (DEPTH, 3 * D), f32),
        'norm_g': gain(ks[6], (DEPTH, D)),
        'final_g': gain(ks[7], (D,)),
        'ga_w_in': dense(ks[8], (n_a, D, GQA_PROJ)),
        'ga_q_g': gain(ks[9], (n_a, GQA_HEAD_DIM)),
        'ga_k_g': gain(ks[10], (n_a, GQA_HEAD_DIM)),
        'ga_w_out': dense(ks[11], (n_a, GQA_WIDTH, D)),
        'na_w_in': dense(ks[12], (n_b, D, NA_PROJ)),
        'na_rpb': 0.1 * jax.random.normal(ks[13], (n_b, NA_HEADS, 2 * NA_KH - 1, 2 * NA_KW - 1), f32),
        'na_w_out': dense(ks[14], (n_b, NA_WIDTH, D)),
        'mla_w_in': dense(ks[15], (n_c, D, MLA_PROJ)),
        'mla_q_g': gain(ks[16], (n_c, MLA_Q_LORA)),
        'mla_kv_g': gain(ks[17], (n_c, MLA_KV_LORA)),
        'mla_w_uq': dense(ks[18], (n_c, MLA_Q_LORA, MLA_HEADS * (MLA_NOPE + MLA_ROPE))),
        'mla_w_ukv': dense(ks[19], (n_c, MLA_KV_LORA, MLA_HEADS * (MLA_NOPE + MLA_V))),
        'mla_w_out': dense(ks[20], (n_c, MLA_WIDTH, D)),
    }


def reference(x, c, ctx, c_ctx, mod_w, mod_b, norm_g, final_g,
              ga_w_in, ga_q_g, ga_k_g, ga_w_out,
              na_w_in, na_rpb, na_w_out,
              mla_w_in, mla_q_g, mla_kv_g, mla_w_uq, mla_w_ukv, mla_w_out):
    n_lat = x.shape[1]
    cos_a, sin_a = axial_rope_tables(n_lat, GQA_HEAD_DIM)
    cos_m, sin_m = axial_rope_tables(n_lat, MLA_ROPE)
    xc = ctx
    for i in range(DEPTH):
        kind, j = i % N_MIXERS, i // N_MIXERS
        need_ctx = i < DEPTH - 1
        shift, scale, gate = jnp.split(jax.nn.silu(c) @ mod_w[i] + mod_b[i], 3, axis=-1)
        shift_c, scale_c, gate_c = jnp.split(jax.nn.silu(c_ctx) @ mod_w[i] + mod_b[i], 3, axis=-1)
        h = rms_norm(x, norm_g[i]) * (1.0 + scale[:, None]) + shift[:, None]
        hc = rms_norm(xc, norm_g[i]) * (1.0 + scale_c) + shift_c
        if kind == 0:
            y, yc = gqa_axial_mixer(h, hc, ga_w_in[j], ga_q_g[j], ga_k_g[j], ga_w_out[j], cos_a, sin_a, need_ctx)
        elif kind == 1:
            y, yc = neighbourhood_mixer(h, hc, na_w_in[j], na_rpb[j], na_w_out[j], need_ctx)
        else:
            y, yc = mla_mixer(h, hc, mla_w_in[j], mla_q_g[j], mla_kv_g[j], mla_w_uq[j], mla_w_ukv[j], mla_w_out[j], cos_m, sin_m, need_ctx)
        x = x + gate[:, None] * y
        if need_ctx:
            xc = xc + gate_c * yc
    return rms_norm(x, final_g)
```

```cpp
#include <hip/hip_runtime.h>
#include <hip/hip_cooperative_groups.h>
#include <cstdio>
#include <cstring>
namespace cg = cooperative_groups;

#define LAS __attribute__((address_space(3)))
typedef unsigned short bf16_t;
typedef short bf16x8 __attribute__((ext_vector_type(8)));
typedef short s16x4 __attribute__((ext_vector_type(4)));
typedef float f32x4 __attribute__((ext_vector_type(4)));
typedef float f32x16 __attribute__((ext_vector_type(16)));
typedef unsigned u32x4 __attribute__((ext_vector_type(4)));
typedef unsigned u32x2 __attribute__((ext_vector_type(2)));

constexpr int NB = 4, SEQ = 8192, CTX = 256, DM = 1024, TPB = SEQ + CTX, T = NB * TPB;
constexpr int DEPTH = 4;
constexpr float EPS = 1e-6f;
constexpr int NTHREADS = 512;
constexpr int LDS_BYTES = 131072;

constexpr size_t OFF_XSC = 0;
constexpr size_t OFF_HB = OFF_XSC + (size_t)NB * CTX * DM * 4;
constexpr size_t OFF_PJ = OFF_HB + (size_t)T * DM * 2;
constexpr size_t OFF_QM = OFF_PJ + (size_t)T * 4096 * 2;
constexpr size_t OFF_W = OFF_QM + (size_t)T * 1536 * 2;
constexpr size_t W_GA_IN = 0, W_GA_OUT = W_GA_IN + 2ull * 2560 * 1024, W_NA_IN = W_GA_OUT + 2ull * 1024 * 1024, W_NA_OUT = W_NA_IN + 4096ull * 1024,
                 W_ML_IN = W_NA_OUT + 1024ull * 1024, W_ML_UQ = W_ML_IN + 2048ull * 1024, W_ML_UKV = W_ML_UQ + 1536ull * 512, W_ML_OUT = W_ML_UKV + 2048ull * 256,
                 W_END = W_ML_OUT + 1024ull * 1024;
constexpr size_t OFF_MODP = OFF_W + W_END * 2;
constexpr size_t OFF_MOD = OFF_MODP + 16ull * 4 * 5 * 3072 * 4;
constexpr size_t OFF_TABA = OFF_MOD + 4ull * 5 * 3072 * 4;
constexpr size_t OFF_TABM = OFF_TABA + 128ull * 32 * 8;
constexpr size_t WS_END = OFF_TABM + 128ull * 16 * 8;

struct WDesc { const float* src; unsigned long long dst; int K, N, Npad, tile0; };
struct Op { int type, i0, i1, i2; unsigned long long p0, p1, p2, p3; };
enum { OP_PRE = 0, OP_MODFIN, OP_NORM, OP_GEMM_BF, OP_GEMM_RES, OP_GQA_POST, OP_ATT_GQA, OP_ATT_NA, OP_MLA_POST1, OP_MLA_POST2, OP_ATT_MLA, OP_FINAL, OP_GEMM_BF_NOSYNC };
constexpr int MAXOPS = 40, NWD = 10;
struct Params {
  const float *x, *c, *ctx, *c_ctx, *mod_w, *mod_b, *norm_g, *final_g, *ga_q_g, *ga_k_g, *na_rpb, *mla_q_g, *mla_kv_g;
  float* out; char* ws;
  WDesc wd[NWD];
  int nops, ntiles_w;
  Op ops[MAXOPS];
};

__device__ const float INV_A[32] = {1.000000000e+00f, 7.498942614e-01f, 5.623413324e-01f, 4.216965139e-01f, 3.162277639e-01f, 2.371373773e-01f, 1.778279394e-01f, 1.333521307e-01f, 1.000000015e-01f, 7.498941571e-02f, 5.623413250e-02f, 4.216965288e-02f, 3.162277490e-02f, 2.371373773e-02f, 1.778279431e-02f, 1.333521493e-02f, 9.999999776e-03f, 7.498941850e-03f, 5.623413250e-03f, 4.216964822e-03f, 3.162277630e-03f, 2.371373586e-03f, 1.778279431e-03f, 1.333521446e-03f, 1.000000047e-03f, 7.498942432e-04f, 5.623413017e-04f, 4.216965172e-04f, 3.162277571e-04f, 2.371373703e-04f, 1.778279402e-04f, 1.333521504e-04f};
__device__ const float INV_M[16] = {1.000000000e+00f, 5.623413324e-01f, 3.162277639e-01f, 1.778279394e-01f, 1.000000015e-01f, 5.623413250e-02f, 3.162277490e-02f, 1.778279431e-02f, 9.999999776e-03f, 5.623413250e-03f, 3.162277630e-03f, 1.778279431e-03f, 1.000000047e-03f, 5.623413017e-04f, 3.162277571e-04f, 1.778279402e-04f};

__device__ __forceinline__ float bf2f(short b) { return __uint_as_float(((unsigned)(unsigned short)b) << 16); }
__device__ __forceinline__ unsigned cvtpk(float lo, float hi) { unsigned r; asm volatile("v_cvt_pk_bf16_f32 %0, %1, %2" : "=v"(r) : "v"(lo), "v"(hi)); return r; }
__device__ __forceinline__ bf16x8 pack8(const float* v) { u32x4 w = {cvtpk(v[0], v[1]), cvtpk(v[2], v[3]), cvtpk(v[4], v[5]), cvtpk(v[6], v[7])}; return *reinterpret_cast<bf16x8*>(&w); }
__device__ __forceinline__ float silu_f(float g) { return g * __builtin_amdgcn_rcpf(1.f + __builtin_amdgcn_exp2f(-g * 1.4426950408889634f)); }
__device__ __forceinline__ float wave_sum(float v) {
#pragma unroll
  for (int o = 32; o >= 1; o >>= 1) v += __shfl_xor(v, o);
  return v;
}
__device__ __forceinline__ const float* res_src(const Params& p, int layer, int row) {
  const int b = row / TPB, j = row - b * TPB;
  if (j < CTX) return (layer == 0 ? p.ctx : (const float*)(p.ws + OFF_XSC)) + ((size_t)b * CTX + j) * DM;
  return (layer == 0 ? p.x : (const float*)p.out) + ((size_t)b * SEQ + (j - CTX)) * DM;
}
__device__ __forceinline__ float* res_dst(const Params& p, int row) {
  const int b = row / TPB, j = row - b * TPB;
  if (j < CTX) return (float*)(p.ws + OFF_XSC) + ((size_t)b * CTX + j) * DM;
  return p.out + ((size_t)b * SEQ + (j - CTX)) * DM;
}

namespace pg8 {
constexpr int BM = 256, BK = 64, HALF = 128, HTB = HALF * BK * 2, STAGE_BYTES = 8 * HTB, NXCD = 8, WGM = 8;
__device__ __forceinline__ int lds_byte(int r, int c) { const int st = (r >> 4) * 2 + (c >> 5), rr = r & 15, cc = c & 31, ob = rr * 64 + cc * 2; return st * 1024 + (ob ^ (((ob >> 9) & 1) << 5)); }
__device__ __forceinline__ void stage_rc(int b, int& R, int& C) { const int st = b / 1024, sb = b % 1024, swz = sb ^ (((sb >> 9) & 1) << 5); R = (st >> 1) * 16 + swz / 64; C = (st & 1) * 32 + (swz % 64) / 2; }
__device__ __forceinline__ int perm32(int rho) { const int n = rho >> 4, i = rho & 15; return 8 * (i >> 2) + 4 * n + (i & 3); }
struct Unit { int pm, pn; };
struct Gemm { const bf16_t* A; const bf16_t* Bt; int M, N, K, lda; };
struct StaticOrder {
  int nM, nN, nwg, G, c;
  __device__ void init(int M, int N, int G_, int c_) { nM = M / BM; nN = N / BM; nwg = nM * nN; G = G_; c = c_; }
  __device__ bool next(int i, Unit& u) const {
    const long L = (long)i * G + c; if (L >= nwg) return false;
    int wgid = (int)L; { const int q = nwg / NXCD, r = nwg % NXCD, xcd = wgid % NXCD, off = wgid / NXCD; wgid = (xcd < r ? xcd * (q + 1) : r * (q + 1) + (xcd - r) * q) + off; }
    const int nig = WGM * nN, gid = wgid / nig, fm = gid * WGM, gsz = (nM - fm) < WGM ? (nM - fm) : WGM;
    u.pm = fm + ((wgid % nig) % gsz); u.pn = (wgid % nig) / gsz; return true;
  }
};
struct EpiBf16 {
  static constexpr bool PERM = true;
  bf16_t* O; int ldc;
  __device__ __forceinline__ void operator()(const f32x4 (&acc)[2][2][4][2], const Unit& u, int wr, int wc, int fr, int fq) const {
    const int row0 = u.pm * BM + wr * 64 + fr, col0 = u.pn * BM + wc * 32 + 8 * fq;
#pragma unroll
    for (int ai = 0; ai < 2; ++ai)
#pragma unroll
      for (int m = 0; m < 4; ++m) { bf16_t* rowp = O + (size_t)(row0 + ai * HALF + m * 16) * ldc + col0;
#pragma unroll
        for (int bj = 0; bj < 2; ++bj) { const f32x4 v0 = acc[ai][bj][m][0], v1 = acc[ai][bj][m][1];
          u32x4 w; w.x = cvtpk(v0[0], v0[1]); w.y = cvtpk(v0[2], v0[3]); w.z = cvtpk(v1[0], v1[1]); w.w = cvtpk(v1[2], v1[3]);
          *(u32x4*)(rowp + bj * HALF) = w; } }
  }
};
struct EpiResid {
  static constexpr bool PERM = false;
  const float* res_lat; const float* res_ctx; float* out_lat; float* out_ctx; const float* mod;
  __device__ __forceinline__ void operator()(const f32x4 (&acc)[2][2][4][2], const Unit& u, int wr, int wc, int fr, int fq) const {
    const int b = u.pm / 33, lt = u.pm - b * 33;
    const float* rb; float* ob; const float* g;
    if (lt == 0) { rb = res_ctx + (size_t)b * CTX * DM; ob = out_ctx + (size_t)b * CTX * DM; g = mod + 4 * 3072 + 2048; }
    else { const size_t o = ((size_t)b * SEQ + (size_t)(lt - 1) * 256) * DM; rb = res_lat + o; ob = out_lat + o; g = mod + b * 3072 + 2048; }
    const int lr0 = wr * 64 + fr, col0 = u.pn * BM + wc * 32 + 4 * fq;
    f32x4 gv[2][2];
#pragma unroll
    for (int bj = 0; bj < 2; ++bj)
#pragma unroll
      for (int n = 0; n < 2; ++n) gv[bj][n] = *(const f32x4*)(g + col0 + bj * HALF + n * 16);
#pragma unroll
    for (int ai = 0; ai < 2; ++ai)
#pragma unroll
      for (int m = 0; m < 4; ++m) { const size_t ro = (size_t)(lr0 + ai * HALF + m * 16) * DM + col0;
#pragma unroll
        for (int bj = 0; bj < 2; ++bj)
#pragma unroll
          for (int n = 0; n < 2; ++n) { const f32x4 r = *(const f32x4*)(rb + ro + bj * HALF + n * 16);
            *(f32x4*)(ob + ro + bj * HALF + n * 16) = r + gv[bj][n] * acc[ai][bj][m][n]; } }
  }
};

template <class Epi>
__device__ __forceinline__ void gemm_phase(LAS unsigned char* lds, const Gemm g, const StaticOrder& S, const Epi& E, const int tid) {
  const int wid = __builtin_amdgcn_readfirstlane(tid >> 6), lane = tid & 63, wr = wid >> 2, wc = wid & 3, fr = lane & 15, fq = lane >> 4;
  const int K = g.K, nt = K / BK, lda = g.lda;
  unsigned voffA[2], voffB[2];
#pragma unroll
  for (int i = 0; i < 2; ++i) { int R, C; stage_rc(tid * 16 + i * 8192, R, C); const int Rb = Epi::PERM ? ((R & ~31) + perm32(R & 31)) : R;
    voffA[i] = (unsigned)(R * lda + C) * 2u; voffB[i] = (unsigned)(Rb * K + C) * 2u; }
  const size_t kstep = (size_t)(BK * 2);
  const size_t hstepA = (size_t)HALF * lda * 2, hstepB = (size_t)HALF * K * 2;
  const size_t tstepA = 2 * hstepA, tstepB = 2 * hstepB;
  const unsigned ldsw = (unsigned)wid * 1024u;
  const int aoff = lds_byte(wr * 64 + fr, fq * 8), boff = lds_byte(wc * 32 + fr, fq * 8);
#define PG8_SA(b, h) (((b) * 2 + (h)) * HTB)
#define PG8_SB(b, h) ((4 + (b) * 2 + (h)) * HTB)
#define PG8_STAGE(bufoff, gbase, voff) do { _Pragma("unroll") for (int _i = 0; _i < 2; ++_i) \
    __builtin_amdgcn_global_load_lds((const unsigned*)((const char*)(gbase) + (voff)[_i]), (LAS unsigned*)(lds + (bufoff) + ldsw + _i * 8192), 16, 0, 0); } while (0)
#define PG8_LDA(dst, b, h) do { _Pragma("unroll") for (int m = 0; m < 4; ++m) _Pragma("unroll") for (int k = 0; k < 2; ++k) dst[m][k] = *(const LAS bf16x8*)(lds + PG8_SA(b, h) + aoff + m * 2048 + k * 1024); } while (0)
#define PG8_LDB(dst, b, h) do { _Pragma("unroll") for (int n = 0; n < 2; ++n) _Pragma("unroll") for (int k = 0; k < 2; ++k) dst[n][k] = *(const LAS bf16x8*)(lds + PG8_SB(b, h) + boff + n * 2048 + k * 1024); } while (0)
#define PG8_MMA(ai, bj, At, Bt) do { __builtin_amdgcn_s_setprio(1); _Pragma("unroll") for (int m = 0; m < 4; ++m) _Pragma("unroll") for (int n = 0; n < 2; ++n) _Pragma("unroll") for (int k = 0; k < 2; ++k) \
    acc[ai][bj][m][n] = __builtin_amdgcn_mfma_f32_16x16x32_bf16(Bt[n][k], At[m][k], acc[ai][bj][m][n], 0, 0, 0); __builtin_amdgcn_s_setprio(0); } while (0)
#define PG8_WAIT_V(n) asm volatile("s_waitcnt vmcnt(" #n ")" ::: "memory")
#define PG8_WAIT_L(n) asm volatile("s_waitcnt lgkmcnt(" #n ")" ::: "memory")
#define PG8_BAR __builtin_amdgcn_s_barrier()
#define PG8_SCHED __builtin_amdgcn_sched_barrier(0)
  Unit cur, nxt; int ui = 0;
  if (!S.next(0, cur)) return;
  f32x4 acc[2][2][4][2];
#pragma unroll
  for (int a = 0; a < 2; ++a)
#pragma unroll
    for (int b = 0; b < 2; ++b)
#pragma unroll
      for (int m = 0; m < 4; ++m)
#pragma unroll
        for (int n = 0; n < 2; ++n) acc[a][b][m][n] = (f32x4){0.f, 0.f, 0.f, 0.f};
  bf16x8 At[4][2], B0[2][2], B1[2][2];
  const char* cA = (const char*)g.A + (size_t)cur.pm * tstepA; const char* cB = (const char*)g.Bt + (size_t)cur.pn * tstepB;
  PG8_STAGE(PG8_SB(0, 0), cB, voffB); PG8_STAGE(PG8_SA(0, 0), cA, voffA); PG8_STAGE(PG8_SB(0, 1), cB + hstepB, voffB); PG8_STAGE(PG8_SA(0, 1), cA + hstepA, voffA);
  if (wr == 1) PG8_BAR;
  PG8_WAIT_V(4); PG8_BAR;
  PG8_STAGE(PG8_SB(1, 0), cB + kstep, voffB); PG8_STAGE(PG8_SA(1, 0), cA + kstep, voffA); PG8_STAGE(PG8_SB(1, 1), cB + hstepB + kstep, voffB);
  PG8_WAIT_V(6); PG8_BAR;
  for (;;) {
    const bool has_next = S.next(ui + 1, nxt);
    const char* nA = has_next ? (const char*)g.A + (size_t)nxt.pm * tstepA : cA; const char* nB = has_next ? (const char*)g.Bt + (size_t)nxt.pn * tstepB : cB;
    for (int t = 0; t < nt; t += 2) {
      const bool last = (t == nt - 2);
      const char* a1 = cA + (size_t)(t + 1) * kstep;
      const char* a2 = last ? nA : cA + (size_t)(t + 2) * kstep; const char* b2 = last ? nB : cB + (size_t)(t + 2) * kstep;
      const char* a3 = a2 + kstep; const char* b3 = b2 + kstep;
      PG8_LDB(B0, 0, 0); PG8_SCHED; PG8_LDA(At, 0, 0); PG8_STAGE(PG8_SA(1, 1), a1 + hstepA, voffA);
      PG8_WAIT_L(8); PG8_BAR; PG8_WAIT_L(0); PG8_MMA(0, 0, At, B0); PG8_BAR; PG8_SCHED;
      PG8_LDB(B1, 0, 1); PG8_STAGE(PG8_SB(0, 0), b2, voffB);
      PG8_BAR; PG8_WAIT_L(0); PG8_MMA(0, 1, At, B1); PG8_BAR;
      PG8_LDA(At, 0, 1); PG8_STAGE(PG8_SA(0, 0), a2, voffA);
      PG8_BAR; PG8_WAIT_L(0); PG8_MMA(1, 0, At, B0); PG8_BAR; PG8_SCHED;
      PG8_STAGE(PG8_SB(0, 1), b2 + hstepB, voffB);
      PG8_WAIT_V(6); PG8_BAR; PG8_MMA(1, 1, At, B1); PG8_BAR;
      PG8_LDB(B0, 1, 0); PG8_SCHED; PG8_LDA(At, 1, 0); PG8_STAGE(PG8_SA(0, 1), a2 + hstepA, voffA);
      PG8_WAIT_L(8); PG8_BAR; PG8_WAIT_L(0); PG8_MMA(0, 0, At, B0); PG8_BAR; PG8_SCHED;
      PG8_LDB(B1, 1, 1); PG8_STAGE(PG8_SB(1, 0), b3, voffB);
      PG8_BAR; PG8_WAIT_L(0); PG8_MMA(0, 1, At, B1); PG8_BAR;
      PG8_LDA(At, 1, 1); PG8_STAGE(PG8_SA(1, 0), a3, voffA);
      PG8_BAR; PG8_WAIT_L(0); PG8_MMA(1, 0, At, B0); PG8_BAR; PG8_SCHED;
      PG8_STAGE(PG8_SB(1, 1), b3 + hstepB, voffB);
      PG8_WAIT_V(6); PG8_BAR; PG8_MMA(1, 1, At, B1); PG8_BAR;
    }
    E(acc, cur, wr, wc, fr, fq);
    if (!has_next) break;
#pragma unroll
    for (int a = 0; a < 2; ++a)
#pragma unroll
      for (int b = 0; b < 2; ++b)
#pragma unroll
        for (int m = 0; m < 4; ++m)
#pragma unroll
          for (int n = 0; n < 2; ++n) acc[a][b][m][n] = (f32x4){0.f, 0.f, 0.f, 0.f};
    cur = nxt; cA = nA; cB = nB; ++ui;
  }
  PG8_WAIT_V(0);
  if (wr == 0) PG8_BAR;
  PG8_BAR;
#undef PG8_SA
#undef PG8_SB
#undef PG8_STAGE
#undef PG8_LDA
#undef PG8_LDB
#undef PG8_MMA
#undef PG8_WAIT_V
#undef PG8_WAIT_L
#undef PG8_BAR
#undef PG8_SCHED
}
}

#define SBAR() __builtin_amdgcn_sched_barrier(0)
__device__ __forceinline__ int crow(int r, int hi) { return (r & 3) + 8 * (r >> 2) + 4 * hi; }
constexpr float THR = 8.f;
template <int DQK> struct ScaleOf;
template <> struct ScaleOf<64> { static constexpr float v = 0.125f; };
template <> struct ScaleOf<128> { static constexpr float v = 0.088388347648318440f; };
template <> struct ScaleOf<192> { static constexpr float v = 0.072168783648703220f; };

template <int DQK>
__device__ __forceinline__ void partialSM(f32x16& p0, f32x16& p1, float& m_reg, float& mn, float& alpha) {
  constexpr float SCALE = ScaleOf<DQK>::v, C = SCALE * 1.4426950408889634f;
  float pmax = p0[0];
#pragma unroll
  for (int r = 1; r < 16; ++r) pmax = fmaxf(pmax, p0[r]);
#pragma unroll
  for (int r = 0; r < 16; ++r) pmax = fmaxf(pmax, p1[r]);
  { auto rr = __builtin_amdgcn_permlane32_swap(__float_as_uint(pmax), __float_as_uint(pmax), false, false);
    pmax = fmaxf(__uint_as_float(rr[0]), __uint_as_float(rr[1])); }
  if (__builtin_expect(__all(pmax - m_reg <= THR / SCALE), 1)) { mn = m_reg; alpha = 1.f; }
  else { mn = fmaxf(m_reg, pmax); alpha = __builtin_amdgcn_exp2f((m_reg - mn) * C); m_reg = mn; }
  const float mnC = -mn * C;
#pragma unroll
  for (int r = 0; r < 16; ++r) p0[r] = fmaf(p0[r], C, mnC);
#pragma unroll
  for (int r = 0; r < 16; ++r) p1[r] = fmaf(p1[r], C, mnC);
#pragma unroll
  for (int r = 0; r < 16; ++r) p0[r] = __builtin_amdgcn_exp2f(p0[r]);
}
__device__ __forceinline__ void finishSM(f32x16& p0, f32x16& p1, float alpha, float& l_reg, bf16x8& pa0, bf16x8& pa1, bf16x8& pa2, bf16x8& pa3) {
#pragma unroll
  for (int r = 0; r < 16; ++r) p1[r] = __builtin_amdgcn_exp2f(p1[r]);
  float ps = 0;
#pragma unroll
  for (int r = 0; r < 16; ++r) ps += p0[r];
#pragma unroll
  for (int r = 0; r < 16; ++r) ps += p1[r];
  { auto rr = __builtin_amdgcn_permlane32_swap(__float_as_uint(ps), __float_as_uint(ps), false, false);
    ps = __uint_as_float(rr[0]) + __uint_as_float(rr[1]); }
  l_reg = l_reg * alpha + ps;
#define PK4(P, BASE, OUT) do { unsigned a0 = cvtpk(P[BASE + 0], P[BASE + 1]), a1 = cvtpk(P[BASE + 2], P[BASE + 3]);   \
    unsigned b0 = cvtpk(P[BASE + 4], P[BASE + 5]), b1 = cvtpk(P[BASE + 6], P[BASE + 7]);                              \
    auto r0 = __builtin_amdgcn_permlane32_swap(a0, b0, false, false); auto r1 = __builtin_amdgcn_permlane32_swap(a1, b1, false, false); \
    u32x4 w = {r0[0], r1[0], r0[1], r1[1]}; OUT = *reinterpret_cast<bf16x8*>(&w); } while (0)
  PK4(p0, 0, pa0); PK4(p0, 8, pa1); PK4(p1, 0, pa2); PK4(p1, 8, pa3);
#undef PK4
}
template <int DQK>
__device__ __forceinline__ void qkt(f32x16& p0, f32x16& p1, const char* Ks, const bf16x8* qr, int r32, int hi) {
  constexpr int RB = DQK * 2;
  p0 = f32x16{}; p1 = f32x16{};
#pragma unroll
  for (int d0 = 0; d0 < DQK / 16; ++d0) { const int cb = (d0 * 16 + hi * 8) * 2;
    bf16x8 b0 = *reinterpret_cast<const bf16x8*>(Ks + r32 * RB + (cb ^ ((r32 & 7) << 4)));
    bf16x8 b1 = *reinterpret_cast<const bf16x8*>(Ks + (32 + r32) * RB + (cb ^ ((r32 & 7) << 4)));
    p0 = __builtin_amdgcn_mfma_f32_32x32x16_bf16(b0, qr[d0], p0, 0, 0, 0);
    p1 = __builtin_amdgcn_mfma_f32_32x32x16_bf16(b1, qr[d0], p1, 0, 0, 0); }
}
template <int NCB> __device__ __forceinline__ int v_st(int k, int c) { const int kk = (k & ~0xC) | ((k & 4) << 1) | ((k & 8) >> 1); return ((kk >> 3) * NCB + (c >> 5)) * 512 + ((kk & 7) * 32 + (c & 31)) * 2; }
__device__ __forceinline__ int v_rd_base(int lane) { return ((lane & 3) << 3) | (((lane >> 2) & 3) << 6) | (((lane >> 4) & 1) << 5) | (((lane >> 5) & 1) << 8); }
template <int OFF> __device__ __forceinline__ s16x4 tr_read(int vb) {
  s16x4 r; asm volatile("ds_read_b64_tr_b16 %0, %1 offset:%2" : "=&v"(r) : "v"(vb), "i"(OFF) : "memory"); return r;
}
template <int NCB, int D0> __device__ __forceinline__ void pv_one(f32x16& od, int vb, bf16x8 pa0, bf16x8 pa1, bf16x8 pa2, bf16x8 pa3) {
#define VOFF(ks, half) (D0 * 512 + (ks) * (NCB * 1024) + (half) * (NCB * 512))
  const s16x4 l0 = tr_read<VOFF(0, 0)>(vb), h0 = tr_read<VOFF(0, 1)>(vb), l1 = tr_read<VOFF(1, 0)>(vb), h1 = tr_read<VOFF(1, 1)>(vb);
  const s16x4 l2 = tr_read<VOFF(2, 0)>(vb), h2 = tr_read<VOFF(2, 1)>(vb), l3 = tr_read<VOFF(3, 0)>(vb), h3 = tr_read<VOFF(3, 1)>(vb);
#undef VOFF
  asm volatile("s_waitcnt lgkmcnt(0)" ::: "memory"); SBAR();
#define PK(L, H) (bf16x8){L[0], L[1], L[2], L[3], H[0], H[1], H[2], H[3]}
  od = __builtin_amdgcn_mfma_f32_32x32x16_bf16(pa0, PK(l0, h0), od, 0, 0, 0);
  od = __builtin_amdgcn_mfma_f32_32x32x16_bf16(pa1, PK(l1, h1), od, 0, 0, 0);
  od = __builtin_amdgcn_mfma_f32_32x32x16_bf16(pa2, PK(l2, h2), od, 0, 0, 0);
  od = __builtin_amdgcn_mfma_f32_32x32x16_bf16(pa3, PK(l3, h3), od, 0, 0, 0);
#undef PK
}
template <int NCB> __device__ __forceinline__ void pv_all(f32x16* o, int vb, bf16x8 pa0, bf16x8 pa1, bf16x8 pa2, bf16x8 pa3) {
  pv_one<NCB, 0>(o[0], vb, pa0, pa1, pa2, pa3); pv_one<NCB, 1>(o[1], vb, pa0, pa1, pa2, pa3);
  if constexpr (NCB == 4) { pv_one<NCB, 2>(o[2], vb, pa0, pa1, pa2, pa3); pv_one<NCB, 3>(o[3], vb, pa0, pa1, pa2, pa3); }
}

template <int DQK, int DV, int MODE, int SD>
__device__ __forceinline__ void attn_body(const bf16_t* __restrict__ Qb, int ldq, const bf16_t* __restrict__ Kp, const bf16_t* __restrict__ K2p, const bf16_t* __restrict__ Vp, int ldk,
                                          int krow_base, bf16_t* __restrict__ OG, int ldo, int NT, int na_r0, char* lds, int tid) {
  constexpr int NQ = DQK / 16, NCB = DV / 32, SHM_K = 64 * DQK * 2, SHM_V = 64 * DV * 2, RB = DQK * 2;
  constexpr int NKC = DQK / 64, NVC = DV / 64;
  constexpr float SCALE = ScaleOf<DQK>::v;
  const int wid = tid >> 6, lane = tid & 63, r32 = lane & 31, hi = lane >> 5;
  constexpr int SE = 0, SO = SD - 1;
  char* V_lds = lds; char* K_lds = lds + 2 * SHM_V;
  float* wsl = (float*)(lds + 2 * SHM_V + 2 * SHM_K) + wid * 64; float* li_l = wsl; float* al_l = wsl + 32;
  const float* bias_l = (const float*)(lds + 2 * SHM_V + 2 * SHM_K + 8 * 64 * 4);
  float m_reg = -1e30f, l_reg = 0; f32x16 o[NCB]; bf16x8 qr[NQ];
#pragma unroll
  for (int d = 0; d < NCB; ++d) o[d] = f32x16{};
  const bf16_t* Qw = Qb + (size_t)(wid * 32 + r32) * ldq + hi * 8;
#pragma unroll
  for (int d0 = 0; d0 < NQ; ++d0) qr[d0] = *reinterpret_cast<const bf16x8*>(Qw + d0 * 16);
  const int sr = tid >> 4, sc = (tid & 15) * 8, sr8 = tid >> 3, sc8 = (tid & 7) * 8;
  const int vb0 = (int)(uintptr_t)V_lds + v_rd_base(lane);
  struct { bf16x8 k[NKC], v[NVC]; } sr_[SD];
  auto tile_row = [&](int j) -> int {
    if constexpr (MODE == 0) return krow_base + j * 64;
    else { if (j < 4) return krow_base + j * 64; int kr = na_r0 - 8 + j; kr = kr < 0 ? 0 : (kr > 127 ? 127 : kr); return krow_base + CTX + kr * 64; }
  };
#define SLOAD(i, j) do { const size_t kr_ = (size_t)tile_row(j);                                                                              \
    if constexpr (DQK >= 128) { sr_[i].k[0] = *reinterpret_cast<const bf16x8*>(Kp + (kr_ + sr) * ldk + sc); sr_[i].k[1] = *reinterpret_cast<const bf16x8*>(Kp + (kr_ + 32 + sr) * ldk + sc); } \
    if constexpr (DQK == 192) sr_[i].k[2] = *reinterpret_cast<const bf16x8*>(K2p + (kr_ + sr8) * ldk + sc8);                                 \
    if constexpr (DQK == 64) sr_[i].k[0] = *reinterpret_cast<const bf16x8*>(Kp + (kr_ + sr8) * ldk + sc8);                                   \
    if constexpr (DV == 128) { sr_[i].v[0] = *reinterpret_cast<const bf16x8*>(Vp + (kr_ + sr) * ldk + sc); sr_[i].v[1] = *reinterpret_cast<const bf16x8*>(Vp + (kr_ + 32 + sr) * ldk + sc); } \
    else sr_[i].v[0] = *reinterpret_cast<const bf16x8*>(Vp + (kr_ + sr8) * ldk + sc8); } while (0)
#define KSW(row, colB) ((row) * RB + ((colB) ^ (((row) & 7) << 4)))
#define SWRITE(b, i) do {                                                                                                                       \
    if constexpr (DV == 128) { *(bf16x8*)(V_lds + (b) * SHM_V + v_st<NCB>(sr, sc)) = sr_[i].v[0]; *(bf16x8*)(V_lds + (b) * SHM_V + v_st<NCB>(32 + sr, sc)) = sr_[i].v[1]; } \
    else *(bf16x8*)(V_lds + (b) * SHM_V + v_st<NCB>(sr8, sc8)) = sr_[i].v[0];                                                                  \
    if constexpr (DQK >= 128) { *(bf16x8*)(K_lds + (b) * SHM_K + KSW(sr, sc * 2)) = sr_[i].k[0]; *(bf16x8*)(K_lds + (b) * SHM_K + KSW(32 + sr, sc * 2)) = sr_[i].k[1]; } \
    if constexpr (DQK == 192) *(bf16x8*)(K_lds + (b) * SHM_K + KSW(sr8, 256 + sc8 * 2)) = sr_[i].k[2];                                        \
    if constexpr (DQK == 64) *(bf16x8*)(K_lds + (b) * SHM_K + KSW(sr8, sc8 * 2)) = sr_[i].k[0]; } while (0)
#define SWAIT() asm volatile("s_waitcnt vmcnt(%0)" :: "n"(SD == 2 ? NKC + NVC : 0) : "memory")
#define RESC(a) do { if (__any((a) < 1.f)) { if (hi == 0) al_l[r32] = (a); asm volatile("s_waitcnt lgkmcnt(0)" ::: "memory"); \
    _Pragma("unroll") for (int d = 0; d < NCB; ++d) _Pragma("unroll") for (int r = 0; r < 16; ++r) o[d][r] *= al_l[crow(r, hi)]; } } while (0)
  auto na_mask = [&](f32x16& p0, f32x16& p1, int j) {
    if constexpr (MODE == 1) {
      if (j >= 4) {
        const int krraw = na_r0 - 8 + j, r = na_r0 + (wid >> 1);
        int rs = r - 4; rs = rs < 0 ? 0 : (rs > 120 ? 120 : rs);
        const float NINF = -__builtin_inff();
        if (krraw < rs || krraw >= rs + 8) {
#pragma unroll
          for (int q = 0; q < 16; ++q) { p0[q] = NINF; p1[q] = NINF; }
        } else {
          const float* brow = bias_l + (krraw - r + 7) * 32;
          const int c = (wid & 1) * 32 + r32; int cs = c - 8; cs = cs < 0 ? 0 : (cs > 48 ? 48 : cs);
#pragma unroll
          for (int q = 0; q < 16; ++q) {
            const int k0 = crow(q, hi), k1 = 32 + k0;
            int i0 = k0 - c + 15, i1 = k1 - c + 15; i0 = i0 < 0 ? 0 : (i0 > 30 ? 30 : i0); i1 = i1 < 0 ? 0 : (i1 > 30 ? 30 : i1);
            const float b0 = brow[i0], b1 = brow[i1];
            p0[q] = (k0 >= cs && k0 < cs + 16) ? p0[q] + b0 : NINF;
            p1[q] = (k1 >= cs && k1 < cs + 16) ? p1[q] + b1 : NINF;
          }
        }
      }
    }
  };
  f32x16 pA0, pA1, pB0, pB1; float mnA, mnB, alA, alB; bf16x8 pa0, pa1, pa2, pa3;
  SLOAD(SE, 0); asm volatile("s_waitcnt vmcnt(0)" ::: "memory"); SWRITE(0, SE); __syncthreads();
  qkt<DQK>(pA0, pA1, K_lds, qr, r32, hi); na_mask(pA0, pA1, 0); partialSM<DQK>(pA0, pA1, m_reg, mnA, alA);
  SLOAD(SO, 1); if constexpr (SD == 2) { if (2 < NT) SLOAD(SE, 2); }
  SWAIT(); SWRITE(1, SO); __syncthreads();
  for (int j = 1; j + 1 < NT; j += 2) {
    SBAR(); qkt<DQK>(pB0, pB1, K_lds + SHM_K, qr, r32, hi);
    finishSM(pA0, pA1, alA, l_reg, pa0, pa1, pa2, pa3); SBAR();
    SLOAD(SO, j + SD); SBAR();
    pv_all<NCB>(o, vb0, pa0, pa1, pa2, pa3); na_mask(pB0, pB1, j); partialSM<DQK>(pB0, pB1, m_reg, mnB, alB);
    __syncthreads(); SWAIT(); SWRITE(0, SE);
    RESC(alB); __syncthreads();
    SBAR(); qkt<DQK>(pA0, pA1, K_lds, qr, r32, hi);
    finishSM(pB0, pB1, alB, l_reg, pa0, pa1, pa2, pa3); SBAR();
    if (SD == 1 || j + 3 < NT) SLOAD(SE, j + 1 + SD); SBAR();
    pv_all<NCB>(o, vb0 + SHM_V, pa0, pa1, pa2, pa3); na_mask(pA0, pA1, j + 1); partialSM<DQK>(pA0, pA1, m_reg, mnA, alA);
    __syncthreads(); SWAIT(); SWRITE(1, SO);
    RESC(alA); __syncthreads();
  }
  SBAR(); qkt<DQK>(pB0, pB1, K_lds + SHM_K, qr, r32, hi);
  finishSM(pA0, pA1, alA, l_reg, pa0, pa1, pa2, pa3); SBAR();
  pv_all<NCB>(o, vb0, pa0, pa1, pa2, pa3); na_mask(pB0, pB1, NT - 1); partialSM<DQK>(pB0, pB1, m_reg, mnB, alB);
  __syncthreads(); RESC(alB);
  finishSM(pB0, pB1, alB, l_reg, pa0, pa1, pa2, pa3); SBAR();
  pv_all<NCB>(o, vb0 + SHM_V, pa0, pa1, pa2, pa3);
  if (hi == 0) li_l[r32] = l_reg; asm volatile("s_waitcnt lgkmcnt(0)" ::: "memory");
  float rli[16];
#pragma unroll
  for (int r = 0; r < 16; ++r) rli[r] = __builtin_amdgcn_rcpf(li_l[crow(r, hi)]);
  bf16_t* Ow = OG + (size_t)(wid * 32) * ldo;
#pragma unroll
  for (int r = 0; r < 16; ++r) { const int orow = crow(r, hi);
#pragma unroll
    for (int d0 = 0; d0 < NCB; ++d0) { bf16_t* pp = Ow + (size_t)orow * ldo + d0 * 32 + r32;
      const float g = bf2f((short)*pp); const float v = o[d0][r] * rli[r] * silu_f(g);
      *pp = (bf16_t)(cvtpk(v, v) & 0xffffu); } }
#undef SLOAD
#undef SWRITE
#undef SWAIT
#undef RESC
#undef KSW
}

template <int DQK, int DV>
__device__ __forceinline__ void attn_body_seq(const bf16_t* __restrict__ Qb, int ldq, const bf16_t* __restrict__ Kp, const bf16_t* __restrict__ K2p, const bf16_t* __restrict__ Vp, int ldk,
                                              int krow_base, bf16_t* __restrict__ OG, int ldo, int NT, char* lds, int tid) {
  constexpr int NQ = DQK / 16, NCB = DV / 32, SHM_K = 64 * DQK * 2, SHM_V = 64 * DV * 2, RB = DQK * 2;
  constexpr int NKC = DQK / 64, NVC = DV / 64;
  const int wid = tid >> 6, lane = tid & 63, r32 = lane & 31, hi = lane >> 5;
  char* V_lds = lds; char* K_lds = lds + 2 * SHM_V;
  float* wsl = (float*)(lds + 2 * SHM_V + 2 * SHM_K) + wid * 64; float* li_l = wsl; float* al_l = wsl + 32;
  float m_reg = -1e30f, l_reg = 0; f32x16 o[NCB]; bf16x8 qr[NQ];
#pragma unroll
  for (int d = 0; d < NCB; ++d) o[d] = f32x16{};
  const bf16_t* Qw = Qb + (size_t)(wid * 32 + r32) * ldq + hi * 8;
#pragma unroll
  for (int d0 = 0; d0 < NQ; ++d0) qr[d0] = *reinterpret_cast<const bf16x8*>(Qw + d0 * 16);
  const int sr = tid >> 4, sc = (tid & 15) * 8, sr8 = tid >> 3, sc8 = (tid & 7) * 8;
  const int vb0 = (int)(uintptr_t)V_lds + v_rd_base(lane);
  bf16x8 sk[NKC], sv[NVC];
#define SLOAD(j) do { const size_t kr_ = (size_t)(krow_base + (j) * 64);                                                                      \
    if constexpr (DQK >= 128) { sk[0] = *reinterpret_cast<const bf16x8*>(Kp + (kr_ + sr) * ldk + sc); sk[1] = *reinterpret_cast<const bf16x8*>(Kp + (kr_ + 32 + sr) * ldk + sc); } \
    if constexpr (DQK == 192) sk[2] = *reinterpret_cast<const bf16x8*>(K2p + (kr_ + sr8) * ldk + sc8);                                       \
    if constexpr (DQK == 64) sk[0] = *reinterpret_cast<const bf16x8*>(Kp + (kr_ + sr8) * ldk + sc8);                                         \
    if constexpr (DV == 128) { sv[0] = *reinterpret_cast<const bf16x8*>(Vp + (kr_ + sr) * ldk + sc); sv[1] = *reinterpret_cast<const bf16x8*>(Vp + (kr_ + 32 + sr) * ldk + sc); } \
    else sv[0] = *reinterpret_cast<const bf16x8*>(Vp + (kr_ + sr8) * ldk + sc8); } while (0)
#define KSW(row, colB) ((row) * RB + ((colB) ^ (((row) & 7) << 4)))
#define SWRITE(b) do {                                                                                                                          \
    if constexpr (DV == 128) { *(bf16x8*)(V_lds + (b) * SHM_V + v_st<NCB>(sr, sc)) = sv[0]; *(bf16x8*)(V_lds + (b) * SHM_V + v_st<NCB>(32 + sr, sc)) = sv[1]; } \
    else *(bf16x8*)(V_lds + (b) * SHM_V + v_st<NCB>(sr8, sc8)) = sv[0];                                                                        \
    if constexpr (DQK >= 128) { *(bf16x8*)(K_lds + (b) * SHM_K + KSW(sr, sc * 2)) = sk[0]; *(bf16x8*)(K_lds + (b) * SHM_K + KSW(32 + sr, sc * 2)) = sk[1]; } \
    if constexpr (DQK == 192) *(bf16x8*)(K_lds + (b) * SHM_K + KSW(sr8, 256 + sc8 * 2)) = sk[2];                                              \
    if constexpr (DQK == 64) *(bf16x8*)(K_lds + (b) * SHM_K + KSW(sr8, sc8 * 2)) = sk[0]; } while (0)
  SLOAD(0); asm volatile("s_waitcnt vmcnt(0)" ::: "memory"); SWRITE(0); __syncthreads();
  for (int j = 0; j < NT; ++j) {
    const int bsel = j & 1;
    if (j + 1 < NT) SLOAD(j + 1);
    SBAR();
    f32x16 p0, p1; float mn, al; bf16x8 pa0, pa1, pa2, pa3;
    qkt<DQK>(p0, p1, K_lds + bsel * SHM_K, qr, r32, hi);
    partialSM<DQK>(p0, p1, m_reg, mn, al);
    finishSM(p0, p1, al, l_reg, pa0, pa1, pa2, pa3);
    if (__any(al < 1.f)) { if (hi == 0) al_l[r32] = al; asm volatile("s_waitcnt lgkmcnt(0)" ::: "memory");
#pragma unroll
      for (int d = 0; d < NCB; ++d)
#pragma unroll
        for (int r = 0; r < 16; ++r) o[d][r] *= al_l[crow(r, hi)]; }
    SBAR();
    pv_all<NCB>(o, vb0 + bsel * SHM_V, pa0, pa1, pa2, pa3);
    if (j + 1 < NT) SWRITE(bsel ^ 1);
    __syncthreads();
  }
  if (hi == 0) li_l[r32] = l_reg; asm volatile("s_waitcnt lgkmcnt(0)" ::: "memory");
  float rli[16];
#pragma unroll
  for (int r = 0; r < 16; ++r) rli[r] = __builtin_amdgcn_rcpf(li_l[crow(r, hi)]);
  bf16_t* Ow = OG + (size_t)(wid * 32) * ldo;
#pragma unroll
  for (int r = 0; r < 16; ++r) { const int orow = crow(r, hi);
#pragma unroll
    for (int d0 = 0; d0 < NCB; ++d0) { bf16_t* pp = Ow + (size_t)orow * ldo + d0 * 32 + r32;
      const float g = bf2f((short)*pp); const float v = o[d0][r] * rli[r] * silu_f(g);
      *pp = (bf16_t)(cvtpk(v, v) & 0xffffu); } }
#undef SLOAD
#undef SWRITE
#undef KSW
}

__device__ __forceinline__ void phase_pre(const Params& p, char* lds, const int tid) {
  float* tl = (float*)lds;
  for (int tt = blockIdx.x; tt < p.ntiles_w; tt += gridDim.x) {
    int di = 0;
#pragma unroll
    for (int i = 1; i < NWD; ++i) if (tt >= p.wd[i].tile0) di = i;
    const float* src = p.wd[di].src; bf16_t* dst = (bf16_t*)(p.ws + OFF_W) + p.wd[di].dst; const int K = p.wd[di].K, N = p.wd[di].N, local = tt - p.wd[di].tile0;
    const int nkt = K >> 6, kt = local % nkt, ntile = local / nkt;
    const int kk = tid >> 3, n8 = (tid & 7) * 8;
    f32x4 a = {0.f, 0.f, 0.f, 0.f}, b = a;
    if (ntile * 64 < N) { const float* sp = src + (size_t)(kt * 64 + kk) * N + ntile * 64 + n8; a = *(const f32x4*)sp; b = *(const f32x4*)(sp + 4); }
    __syncthreads();
#pragma unroll
    for (int i = 0; i < 4; ++i) { tl[(n8 + i) * 65 + kk] = a[i]; tl[(n8 + 4 + i) * 65 + kk] = b[i]; }
    __syncthreads();
    const int n = tid >> 3, k8 = (tid & 7) * 8; float v[8];
#pragma unroll
    for (int i = 0; i < 8; ++i) v[i] = tl[n * 65 + k8 + i];
    *(bf16x8*)(dst + (size_t)(ntile * 64 + n) * K + kt * 64 + k8) = pack8(v);
  }
  float* part = (float*)(p.ws + OFF_MODP);
  for (int it = blockIdx.x; it < 4 * 16 * 6; it += gridDim.x) {
    const int nb = it % 6, kc = (it / 6) & 15, layer = it / 96;
    __syncthreads();
    if (tid < 320) { const int s = tid >> 6, kk = tid & 63; const float cv = s < 4 ? p.c[s * DM + kc * 64 + kk] : p.c_ctx[kc * 64 + kk]; tl[tid] = silu_f(cv); }
    __syncthreads();
    const int n = nb * 512 + tid; const float* wp = p.mod_w + ((size_t)layer * DM + kc * 64) * 3072 + n;
    float a0 = 0, a1 = 0, a2 = 0, a3 = 0, a4 = 0;
#pragma unroll 8
    for (int kk = 0; kk < 64; ++kk) { const float w = wp[(size_t)kk * 3072]; a0 += tl[kk] * w; a1 += tl[64 + kk] * w; a2 += tl[128 + kk] * w; a3 += tl[192 + kk] * w; a4 += tl[256 + kk] * w; }
    float* pp = part + ((size_t)(kc * 4 + layer) * 5) * 3072 + n;
    pp[0] = a0; pp[3072] = a1; pp[2 * 3072] = a2; pp[3 * 3072] = a3; pp[4 * 3072] = a4;
  }
  for (int i = blockIdx.x * NTHREADS + tid; i < 128 * 48; i += gridDim.x * NTHREADS) {
    int pos, f; float inv; float2* dstp;
    if (i < 128 * 32) { pos = i >> 5; f = i & 31; inv = INV_A[f]; dstp = (float2*)(p.ws + OFF_TABA) + i; }
    else { const int q = i - 128 * 32; pos = q >> 4; f = q & 15; inv = INV_M[f]; dstp = (float2*)(p.ws + OFF_TABM) + q; }
    const float angf = (float)pos * inv;
    const double ang = (double)angf, k = __builtin_rint(ang * 0.15915494309189535), r = ang - k * 6.283185307179586476925287, r2 = r * r;
    double sn = r, cs = 1.0, ts = r, tc = 1.0;
#pragma unroll 1
    for (int q = 1; q <= 14; ++q) { tc = -tc * r2 / (double)((2 * q - 1) * (2 * q)); cs += tc; ts = -ts * r2 / (double)((2 * q) * (2 * q + 1)); sn += ts; }
    *dstp = make_float2((float)cs, (float)sn);
  }
}
__device__ __forceinline__ void phase_modfin(const Params& p, const int tid) {
  const float* part = (const float*)(p.ws + OFF_MODP); float* mod = (float*)(p.ws + OFF_MOD);
  for (int i = blockIdx.x * NTHREADS + tid; i < 4 * 5 * 3072; i += gridDim.x * NTHREADS) {
    const int n = i % 3072, layer = i / (5 * 3072);
    float a = p.mod_b[layer * 3072 + n];
#pragma unroll
    for (int kc = 0; kc < 16; ++kc) a += part[(size_t)kc * (4 * 5 * 3072) + i];
    mod[i] = a;
  }
}
__device__ __forceinline__ void phase_norm(const Params& p, int layer, const int tid) {
  const int lane = tid & 63, gw = blockIdx.x * 8 + (tid >> 6), nw = gridDim.x * 8;
  const float* mod = (const float*)(p.ws + OFF_MOD) + (size_t)layer * 5 * 3072; const float* g = p.norm_g + layer * DM; bf16_t* hb = (bf16_t*)(p.ws + OFF_HB);
  for (int row = gw; row < T; row += nw) {
    const float* xr = res_src(p, layer, row);
    const int b = row / TPB, j = row - b * TPB; const float* m = mod + (j < CTX ? 4 : b) * 3072;
    f32x4 v[4]; float ss = 0;
#pragma unroll
    for (int i = 0; i < 4; ++i) { v[i] = *(const f32x4*)(xr + i * 256 + lane * 4); ss += v[i][0] * v[i][0] + v[i][1] * v[i][1] + v[i][2] * v[i][2] + v[i][3] * v[i][3]; }
    ss = wave_sum(ss); const float rstd = rsqrtf(ss * (1.f / DM) + EPS);
#pragma unroll
    for (int i = 0; i < 4; ++i) { const int col = i * 256 + lane * 4; const f32x4 gg = *(const f32x4*)(g + col), sh = *(const f32x4*)(m + col), scl = *(const f32x4*)(m + 1024 + col);
      float y[4];
#pragma unroll
      for (int e = 0; e < 4; ++e) y[e] = v[i][e] * rstd * gg[e] * (1.f + scl[e]) + sh[e];
      u32x2 w = {cvtpk(y[0], y[1]), cvtpk(y[2], y[3])}; *(u32x2*)(hb + (size_t)row * DM + col) = w; }
  }
}
__device__ __forceinline__ void phase_final(const Params& p, const int tid) {
  const int lane = tid & 63, gw = blockIdx.x * 8 + (tid >> 6), nw = gridDim.x * 8;
  for (int row = gw; row < NB * SEQ; row += nw) {
    float* xr = p.out + (size_t)row * DM; f32x4 v[4]; float ss = 0;
#pragma unroll
    for (int i = 0; i < 4; ++i) { v[i] = *(const f32x4*)(xr + i * 256 + lane * 4); ss += v[i][0] * v[i][0] + v[i][1] * v[i][1] + v[i][2] * v[i][2] + v[i][3] * v[i][3]; }
    ss = wave_sum(ss); const float rstd = rsqrtf(ss * (1.f / DM) + EPS);
#pragma unroll
    for (int i = 0; i < 4; ++i) { const int col = i * 256 + lane * 4; const f32x4 gg = *(const f32x4*)(p.final_g + col); *(f32x4*)(xr + col) = v[i] * rstd * gg; }
  }
}
__device__ __forceinline__ void phase_gqa_post(const Params& p, int j, const int tid) {
  const int lane = tid & 63, gw = blockIdx.x * 8 + (tid >> 6), nw = gridDim.x * 8, g4 = lane >> 4, i = lane & 15;
  bf16_t* pj = (bf16_t*)(p.ws + OFF_PJ); const float2* tab = (const float2*)(p.ws + OFF_TABA);
  const float* qg = p.ga_q_g + j * 128; const float* kg = p.ga_k_g + j * 128;
  for (int wi = gw; wi < T * 10 / 4; wi += nw) {
    const int hv = wi * 4 + g4, row = hv / 10, h = hv - row * 10;
    bf16_t* ptr = pj + (size_t)row * 2560 + h * 128 + i * 8;
    const bf16x8 raw = *(const bf16x8*)ptr; float x[8]; float ss = 0;
#pragma unroll
    for (int e = 0; e < 8; ++e) { x[e] = bf2f(raw[e]); ss += x[e] * x[e]; }
    ss += __shfl_xor(ss, 1); ss += __shfl_xor(ss, 2); ss += __shfl_xor(ss, 4); ss += __shfl_xor(ss, 8);
    const float rstd = rsqrtf(ss * (1.f / 128.f) + EPS); const float* gn = (h < 8 ? qg : kg) + i * 8;
#pragma unroll
    for (int e = 0; e < 8; ++e) x[e] = x[e] * rstd * gn[e];
    const int b = row / TPB, jj = row - b * TPB; const bool lat = jj >= CTX; const int t = jj - CTX;
    const int axis = i >> 3, half = (i >> 2) & 1, pos = lat ? (axis ? (t & 63) : (t >> 6)) : 0;
    float y[8];
#pragma unroll
    for (int e = 0; e < 8; ++e) { const float xp = __shfl_xor(x[e], 4); const float2 cs = tab[pos * 32 + (i & 3) * 8 + e];
      y[e] = lat ? (half ? x[e] * cs.x + xp * cs.y : x[e] * cs.x - xp * cs.y) : x[e]; }
    *(bf16x8*)ptr = pack8(y);
  }
}
__device__ __forceinline__ void phase_mla_post1(const Params& p, const int tid) {
  const int lane = tid & 63, gw = blockIdx.x * 8 + (tid >> 6), nw = gridDim.x * 8;
  bf16_t* pj = (bf16_t*)(p.ws + OFF_PJ); const float2* tab = (const float2*)(p.ws + OFF_TABM);
  for (int row = gw; row < T; row += nw) {
    bf16_t* pr = pj + (size_t)row * 2048;
    { const bf16x8 raw = *(const bf16x8*)(pr + lane * 8); float x[8]; float ss = 0;
#pragma unroll
      for (int e = 0; e < 8; ++e) { x[e] = bf2f(raw[e]); ss += x[e] * x[e]; }
      ss = wave_sum(ss); const float rstd = rsqrtf(ss * (1.f / 512.f) + EPS);
#pragma unroll
      for (int e = 0; e < 8; ++e) x[e] = x[e] * rstd * p.mla_q_g[lane * 8 + e];
      *(bf16x8*)(pr + lane * 8) = pack8(x); }
    { const int l2 = lane & 31; const bf16x8 raw = *(const bf16x8*)(pr + 512 + l2 * 8); float x[8]; float ss = 0;
#pragma unroll
      for (int e = 0; e < 8; ++e) { x[e] = bf2f(raw[e]); ss += x[e] * x[e]; }
      ss = wave_sum(ss) * 0.5f; const float rstd = rsqrtf(ss * (1.f / 256.f) + EPS);
#pragma unroll
      for (int e = 0; e < 8; ++e) x[e] = x[e] * rstd * p.mla_kv_g[l2 * 8 + e];
      if (lane < 32) *(bf16x8*)(pr + 512 + l2 * 8) = pack8(x); }
    { const int b = row / TPB, jj = row - b * TPB; const bool lat = jj >= CTX; const int t = jj - CTX;
      const int l3 = lane & 7; const bf16x8 raw = *(const bf16x8*)(pr + 768 + l3 * 8);
      const int axis = l3 >> 2, half = (l3 >> 1) & 1, pos = lat ? (axis ? (t & 63) : (t >> 6)) : 0; float y[8];
#pragma unroll
      for (int e = 0; e < 8; ++e) { const float x = bf2f(raw[e]); const float xp = __shfl_xor(x, 2); const float2 cs = tab[pos * 16 + (l3 & 1) * 8 + e];
        y[e] = half ? x * cs.x + xp * cs.y : x * cs.x - xp * cs.y; }
      if (lat && lane < 8) *(bf16x8*)(pr + 768 + l3 * 8) = pack8(y); }
  }
}
__device__ __forceinline__ void phase_mla_post2(const Params& p, const int tid) {
  const int lane = tid & 63, gw = blockIdx.x * 8 + (tid >> 6), nw = gridDim.x * 8, h = lane >> 3, i = lane & 7;
  bf16_t* qm = (bf16_t*)(p.ws + OFF_QM); const float2* tab = (const float2*)(p.ws + OFF_TABM);
  for (int lr = gw; lr < NB * SEQ; lr += nw) {
    const int b = lr >> 13, t = lr & 8191; const size_t row = (size_t)b * TPB + CTX + t;
    bf16_t* ptr = qm + row * 1536 + h * 192 + 128 + i * 8; const bf16x8 raw = *(const bf16x8*)ptr;
    const int axis = i >> 2, half = (i >> 1) & 1, pos = axis ? (t & 63) : (t >> 6); float y[8];
#pragma unroll
    for (int e = 0; e < 8; ++e) { const float x = bf2f(raw[e]); const float xp = __shfl_xor(x, 2); const float2 cs = tab[pos * 16 + (i & 1) * 8 + e];
      y[e] = half ? x * cs.x + xp * cs.y : x * cs.x - xp * cs.y; }
    *(bf16x8*)ptr = pack8(y);
  }
}
__device__ __forceinline__ void phase_att_gqa(const Params& p, int need_ctx, char* lds, const int tid) {
  bf16_t* pj = (bf16_t*)(p.ws + OFF_PJ);
  const int nit = 1024 + (need_ctx ? 32 : 0);
  for (int it = blockIdx.x; it < nit; it += gridDim.x) {
    int b, h, row0, nt;
    if (it < 1024) { b = it >> 8; h = (it >> 5) & 7; row0 = b * TPB + CTX + (it & 31) * 256; nt = TPB / 64; }
    else { const int q = it - 1024; b = q >> 3; h = q & 7; row0 = b * TPB; nt = CTX / 64; }
    __syncthreads();
    attn_body<128, 128, 0, 2>(pj + (size_t)row0 * 2560 + h * 128, 2560, pj + 1024 + (h >> 2) * 128, nullptr, pj + 1280 + (h >> 2) * 128, 2560, b * TPB,
                           pj + (size_t)row0 * 2560 + 1536 + h * 128, 2560, nt, 0, lds, tid);
  }
}
__device__ __forceinline__ void phase_att_mla(const Params& p, int need_ctx, char* lds, const int tid) {
  bf16_t* pj = (bf16_t*)(p.ws + OFF_PJ); bf16_t* kvm = pj + (size_t)T * 2048; bf16_t* qm = (bf16_t*)(p.ws + OFF_QM);
  const int nit = 1024 + (need_ctx ? 32 : 0);
  for (int it = blockIdx.x; it < nit; it += gridDim.x) {
    int b, h, row0, nt;
    if (it < 1024) { b = it >> 8; h = (it >> 5) & 7; row0 = b * TPB + CTX + (it & 31) * 256; nt = TPB / 64; }
    else { const int q = it - 1024; b = q >> 3; h = q & 7; row0 = b * TPB; nt = CTX / 64; }
    __syncthreads();
    attn_body_seq<192, 128>(qm + (size_t)row0 * 1536 + h * 192, 1536, kvm + h * 256, pj + 768, kvm + h * 256 + 128, 2048, b * TPB,
                            pj + (size_t)row0 * 2048 + 832 + h * 128, 2048, nt, lds, tid);
  }
}
__device__ __forceinline__ void phase_att_na(const Params& p, int need_ctx, char* lds, const int tid) {
  bf16_t* pj = (bf16_t*)(p.ws + OFF_PJ);
  float* bias_l = (float*)(lds + 2 * 8192 + 2 * 8192 + 8 * 64 * 4);
  const int nit = 2048 + (need_ctx ? 64 : 0);
  for (int it = blockIdx.x; it < nit; it += gridDim.x) {
    __syncthreads();
    if (it < 2048) {
      const int b = it >> 9, h = (it >> 5) & 15, r0 = (it & 31) * 4, row0 = b * TPB + CTX + r0 * 64;
      if (tid < 15 * 32) { const int ro = tid >> 5, co = tid & 31; bias_l[tid] = co < 31 ? p.na_rpb[(h * 15 + ro) * 31 + co] * 8.f : 0.f; }
      attn_body<64, 64, 1, 2>(pj + (size_t)row0 * 4096 + h * 64, 4096, pj + 1024 + h * 64, nullptr, pj + 2048 + h * 64, 4096, b * TPB,
                           pj + (size_t)row0 * 4096 + 3072 + h * 64, 4096, 16, r0, lds, tid);
    } else {
      const int q = it - 2048, b = q >> 4, h = q & 15, row0 = b * TPB;
      attn_body<64, 64, 0, 2>(pj + (size_t)row0 * 4096 + h * 64, 4096, pj + 1024 + h * 64, nullptr, pj + 2048 + h * 64, 4096, b * TPB,
                           pj + (size_t)row0 * 4096 + 3072 + h * 64, 4096, 4, 0, lds, tid);
    }
  }
}

__global__ void __launch_bounds__(NTHREADS, 2) fwd_megakernel(const Params p) {
  extern __shared__ __attribute__((aligned(16))) unsigned char shm[];
  cg::grid_group grid = cg::this_grid();
  char* lds = (char*)shm;
  for (int oi = 0; oi < p.nops; ++oi) {
    const Op op = p.ops[oi];
    int tid = threadIdx.x; asm volatile("" : "+v"(tid));
#ifndef PHM
#define PHM 0xffff
#endif
#define PH(k) if constexpr (((PHM) >> (k)) & 1)
    switch (op.type) {
      case OP_PRE: PH(0) phase_pre(p, lds, tid); break;
      case OP_MODFIN: PH(1) phase_modfin(p, tid); break;
      case OP_NORM: PH(2) phase_norm(p, op.i0, tid); break;
      case OP_GEMM_BF: case OP_GEMM_BF_NOSYNC: PH(3) {
        pg8::Gemm g{(const bf16_t*)op.p0, (const bf16_t*)op.p1, T, op.i0, op.i1, op.i2};
        pg8::StaticOrder S; S.init(T, op.i0, (int)gridDim.x, (int)blockIdx.x);
        pg8::EpiBf16 E{(bf16_t*)op.p2, op.i0};
        pg8::gemm_phase<pg8::EpiBf16>((LAS unsigned char*)shm, g, S, E, tid);
      } break;
      case OP_GEMM_RES: PH(4) {
        pg8::Gemm g{(const bf16_t*)op.p0, (const bf16_t*)op.p1, T, DM, DM, op.i2};
        pg8::StaticOrder S; S.init(T, DM, (int)gridDim.x, (int)blockIdx.x);
        float* xsc = (float*)(p.ws + OFF_XSC);
        pg8::EpiResid E{op.i0 == 0 ? p.x : (const float*)p.out, op.i0 == 0 ? p.ctx : (const float*)xsc, p.out, xsc, (const float*)(p.ws + OFF_MOD) + (size_t)op.i0 * 5 * 3072};
        pg8::gemm_phase<pg8::EpiResid>((LAS unsigned char*)shm, g, S, E, tid);
      } break;
      case OP_GQA_POST: PH(5) phase_gqa_post(p, op.i0, tid); break;
      case OP_ATT_GQA: PH(6) phase_att_gqa(p, op.i0, lds, tid); break;
      case OP_ATT_NA: PH(7) phase_att_na(p, op.i0, lds, tid); break;
      case OP_MLA_POST1: PH(8) phase_mla_post1(p, tid); break;
      case OP_MLA_POST2: PH(9) phase_mla_post2(p, tid); break;
      case OP_ATT_MLA: PH(10) phase_att_mla(p, op.i0, lds, tid); break;
      case OP_FINAL: PH(11) phase_final(p, tid); break;
      default: break;
    }
    if (op.type != OP_GEMM_BF_NOSYNC) grid.sync(); else __syncthreads();
  }
}

extern "C" void kernel_launch(void* const* d_in, const int* in_sizes, int n_in, void* d_out, int out_size, void* d_ws, size_t ws_size, hipStream_t stream) {
  static int grid_blocks = 0;
  if (!grid_blocks) {
    if (ws_size < WS_END) { fprintf(stderr, "kernel_launch: workspace too small: %zu < %zu\n", ws_size, (size_t)WS_END); return; }
    if (hipFuncSetAttribute((const void*)fwd_megakernel, hipFuncAttributeMaxDynamicSharedMemorySize, LDS_BYTES) != hipSuccess) { fprintf(stderr, "kernel_launch: hipFuncSetAttribute failed\n"); return; }
    int dev = 0, cus = 0, per_cu = 0;
    hipGetDevice(&dev);
    hipDeviceGetAttribute(&cus, hipDeviceAttributeMultiprocessorCount, dev);
    hipOccupancyMaxActiveBlocksPerMultiprocessor(&per_cu, fwd_megakernel, NTHREADS, LDS_BYTES);
    if (per_cu < 1) { fprintf(stderr, "kernel_launch: occupancy query returned %d\n", per_cu); return; }
    grid_blocks = cus;
  }
  Params p; memset(&p, 0, sizeof(p));
  const float* const* in = (const float* const*)d_in;
  p.x = in[0]; p.c = in[1]; p.ctx = in[2]; p.c_ctx = in[3]; p.mod_w = in[4]; p.mod_b = in[5]; p.norm_g = in[6]; p.final_g = in[7];
  const float* ga_w_in = in[8]; p.ga_q_g = in[9]; p.ga_k_g = in[10]; const float* ga_w_out = in[11];
  const float* na_w_in = in[12]; p.na_rpb = in[13]; const float* na_w_out = in[14];
  const float* mla_w_in = in[15]; p.mla_q_g = in[16]; p.mla_kv_g = in[17]; const float* mla_w_uq = in[18]; const float* mla_w_ukv = in[19]; const float* mla_w_out = in[20];
  p.out = (float*)d_out; p.ws = (char*)d_ws;
  int nt = 0, wi = 0;
  auto addw = [&](const float* src, size_t dst, int K, int N, int Npad) { WDesc& w = p.wd[wi++]; w.src = src; w.dst = dst; w.K = K; w.N = N; w.Npad = Npad; w.tile0 = nt; nt += (K / 64) * (Npad / 64); };
  addw(ga_w_in, W_GA_IN, 1024, 2560, 2560); addw(ga_w_in + 1024ull * 2560, W_GA_IN + 2560ull * 1024, 1024, 2560, 2560);
  addw(ga_w_out, W_GA_OUT, 1024, 1024, 1024); addw(ga_w_out + 1024ull * 1024, W_GA_OUT + 1024ull * 1024, 1024, 1024, 1024);
  addw(na_w_in, W_NA_IN, 1024, 4096, 4096); addw(na_w_out, W_NA_OUT, 1024, 1024, 1024);
  addw(mla_w_in, W_ML_IN, 1024, 1856, 2048); addw(mla_w_uq, W_ML_UQ, 512, 1536, 1536); addw(mla_w_ukv, W_ML_UKV, 256, 2048, 2048); addw(mla_w_out, W_ML_OUT, 1024, 1024, 1024);
  p.ntiles_w = nt;
  char* ws = (char*)d_ws; bf16_t* W = (bf16_t*)(ws + OFF_W); bf16_t* hb = (bf16_t*)(ws + OFF_HB); bf16_t* pj = (bf16_t*)(ws + OFF_PJ); bf16_t* qm = (bf16_t*)(ws + OFF_QM);
  int no = 0;
  auto add = [&](int type, int i0, int i1, int i2, const void* p0, const void* p1, const void* p2) { Op& o = p.ops[no++]; o.type = type; o.i0 = i0; o.i1 = i1; o.i2 = i2;
    o.p0 = (unsigned long long)(uintptr_t)p0; o.p1 = (unsigned long long)(uintptr_t)p1; o.p2 = (unsigned long long)(uintptr_t)p2; o.p3 = 0; };
  add(OP_PRE, 0, 0, 0, nullptr, nullptr, nullptr);
  add(OP_MODFIN, 0, 0, 0, nullptr, nullptr, nullptr);
  for (int i = 0; i < DEPTH; ++i) {
    const int kind = i % 3, j = i / 3, need_ctx = i < DEPTH - 1;
    add(OP_NORM, i, 0, 0, nullptr, nullptr, nullptr);
    if (kind == 0) {
      add(OP_GEMM_BF, 2560, 1024, 1024, hb, W + W_GA_IN + (size_t)j * 2560 * 1024, pj);
      add(OP_GQA_POST, j, 0, 0, nullptr, nullptr, nullptr);
      add(OP_ATT_GQA, need_ctx, 0, 0, nullptr, nullptr, nullptr);
      add(OP_GEMM_RES, i, 0, 2560, pj + 1536, W + W_GA_OUT + (size_t)j * 1024 * 1024, nullptr);
    } else if (kind == 1) {
      add(OP_GEMM_BF, 4096, 1024, 1024, hb, W + W_NA_IN, pj);
      add(OP_ATT_NA, need_ctx, 0, 0, nullptr, nullptr, nullptr);
      add(OP_GEMM_RES, i, 0, 4096, pj + 3072, W + W_NA_OUT, nullptr);
    } else {
      add(OP_GEMM_BF, 2048, 1024, 1024, hb, W + W_ML_IN, pj);
      add(OP_MLA_POST1, 0, 0, 0, nullptr, nullptr, nullptr);
      add(OP_GEMM_BF_NOSYNC, 1536, 512, 2048, pj, W + W_ML_UQ, qm);
      add(OP_GEMM_BF, 2048, 256, 2048, pj + 512, W + W_ML_UKV, pj + (size_t)T * 2048);
      add(OP_MLA_POST2, 0, 0, 0, nullptr, nullptr, nullptr);
      add(OP_ATT_MLA, need_ctx, 0, 0, nullptr, nullptr, nullptr);
      add(OP_GEMM_RES, i, 0, 2048, pj + 832, W + W_ML_OUT, nullptr);
    }
  }
  add(OP_FINAL, 0, 0, 0, nullptr, nullptr, nullptr);
  p.nops = no;
  void* args[] = {&p};
  hipError_t e = hipLaunchCooperativeKernel((const void*)fwd_megakernel, dim3(grid_blocks), dim3(NTHREADS), args, LDS_BYTES, stream);
  if (e != hipSuccess) fprintf(stderr, "kernel_launch: cooperative launch failed: %s (grid %d)\n", hipGetErrorString(e), grid_blocks);
}
```

```cpp
#include <hip/hip_runtime.h>
#include <hip/hip_cooperative_groups.h>
#include <cstdio>
#include <cstring>
namespace cg = cooperative_groups;

#define LAS __attribute__((address_space(3)))
typedef unsigned short bf16_t;
typedef short bf16x8 __attribute__((ext_vector_type(8)));
typedef short s16x4 __attribute__((ext_vector_type(4)));
typedef float f32x4 __attribute__((ext_vector_type(4)));
typedef float f32x16 __attribute__((ext_vector_type(16)));
typedef unsigned u32x4 __attribute__((ext_vector_type(4)));
typedef unsigned u32x2 __attribute__((ext_vector_type(2)));

constexpr int NB = 4, SEQ = 8192, CTX = 256, DM = 1024, TPB = SEQ + CTX, T = NB * TPB;
constexpr int DEPTH = 4;
constexpr float EPS = 1e-6f;
constexpr int NTHREADS = 512;
constexpr int LDS_BYTES = 131072;

constexpr size_t OFF_XSC = 0;
constexpr size_t OFF_HB = OFF_XSC + (size_t)NB * CTX * DM * 4;
constexpr size_t OFF_PJ = OFF_HB + (size_t)T * DM * 2;
constexpr size_t OFF_QM = OFF_PJ + (size_t)T * 4096 * 2;
constexpr size_t OFF_W = OFF_QM + (size_t)T * 1536 * 2;
constexpr size_t W_GA_IN = 0, W_GA_OUT = W_GA_IN + 2ull * 2560 * 1024, W_NA_IN = W_GA_OUT + 2ull * 1024 * 1024, W_NA_OUT = W_NA_IN + 4096ull * 1024,
                 W_ML_IN = W_NA_OUT + 1024ull * 1024, W_ML_UQ = W_ML_IN + 2048ull * 1024, W_ML_UKV = W_ML_UQ + 1536ull * 512, W_ML_OUT = W_ML_UKV + 2048ull * 256,
                 W_END = W_ML_OUT + 1024ull * 1024;
constexpr size_t OFF_MODP = OFF_W + W_END * 2;
constexpr size_t OFF_MOD = OFF_MODP + 16ull * 4 * 5 * 3072 * 4;
constexpr size_t OFF_TABA = OFF_MOD + 4ull * 5 * 3072 * 4;
constexpr size_t OFF_TABM = OFF_TABA + 128ull * 32 * 8;
constexpr size_t OFF_BAR = OFF_TABM + 128ull * 16 * 8;
constexpr size_t WS_END = OFF_BAR + 3456ull * 4;

struct Op { int type, i0, i1, i2; unsigned long long a, b, o; };
enum { OP_PRE = 0, OP_MODFIN, OP_NORM, OP_GEMM_BF, OP_GEMM_RES, OP_GQA_POST, OP_ATT_GQA, OP_ATT_NA, OP_MLA_POST1, OP_MLA_POST2, OP_ATT_MLA, OP_FINAL, OP_GEMM_BF_NOSYNC };
enum { IN_X = 0, IN_C, IN_CTX, IN_CCTX, IN_MODW, IN_MODB, IN_NORMG, IN_FINALG, IN_GA_WIN, IN_GA_QG, IN_GA_KG, IN_GA_WOUT, IN_NA_WIN, IN_NA_RPB, IN_NA_WOUT,
       IN_ML_WIN, IN_ML_QG, IN_ML_KVG, IN_ML_WUQ, IN_ML_WUKV, IN_ML_WOUT, N_IN };
struct Params { const float* in[N_IN]; float* out; char* ws; };
#define KAS __attribute__((address_space(4)))
typedef const KAS Params* KP;

#ifndef PROBE_DUP
#define PROBE_DUP 0
#endif
constexpr int MAXOPS = 64;
struct Prog { Op ops[MAXOPS]; int n; };
constexpr void prog_add1(Prog& P, int type, int i0, int i1, int i2, size_t a, size_t b, size_t o) { Op& q = P.ops[P.n++]; q.type = type; q.i0 = i0; q.i1 = i1; q.i2 = i2; q.a = a; q.b = b; q.o = o; }
constexpr void prog_add(Prog& P, int type, int i0, int i1, int i2, size_t a, size_t b, size_t o) {
  const bool gemm = type == OP_GEMM_BF || type == OP_GEMM_BF_NOSYNC;
  if ((PROBE_DUP & 1) && gemm) prog_add1(P, OP_GEMM_BF, i0, i1, i2, a, b, o);
  if ((PROBE_DUP & 2) && type == OP_ATT_GQA) prog_add1(P, type, i0, 1, i2, a, b, o);
  if ((PROBE_DUP & 4) && type == OP_ATT_MLA) prog_add1(P, type, i0, 1, i2, a, b, o);
  if ((PROBE_DUP & 8) && type == OP_ATT_NA) prog_add1(P, type, i0, 1, i2, a, b, o);
  if ((PROBE_DUP & 16) && type == OP_NORM) prog_add1(P, type, i0, i1, i2, a, b, o);
  prog_add1(P, type, i0, i1, i2, a, b, o);
}
constexpr Prog make_prog() {
  Prog P{}; P.n = 0;
  const size_t W = OFF_W, hb = OFF_HB, pj = OFF_PJ, qm = OFF_QM;
  prog_add(P, OP_PRE, 0, 0, 0, 0, 0, 0);
  prog_add(P, OP_MODFIN, 0, 0, 0, 0, 0, 0);
  for (int i = 0; i < DEPTH; ++i) {
    const int kind = i % 3, j = i / 3, need_ctx = i < DEPTH - 1;
    prog_add(P, OP_NORM, i, 0, 0, 0, 0, 0);
    if (kind == 0) {
      prog_add(P, OP_GEMM_BF, 2560, 1024, 1024, hb, W + 2 * (W_GA_IN + (size_t)j * 2560 * 1024), pj);
      prog_add(P, OP_GQA_POST, j, 0, 0, 0, 0, 0);
      prog_add(P, OP_ATT_GQA, need_ctx, 0, 0, 0, 0, 0);
      prog_add(P, OP_GEMM_RES, i, 0, 2560, pj + 2 * 1536, W + 2 * (W_GA_OUT + (size_t)j * 1024 * 1024), 0);
    } else if (kind == 1) {
      prog_add(P, OP_GEMM_BF, 4096, 1024, 1024, hb, W + 2 * W_NA_IN, pj);
      prog_add(P, OP_ATT_NA, need_ctx, 0, 0, 0, 0, 0);
      prog_add(P, OP_GEMM_RES, i, 0, 4096, pj + 2 * 3072, W + 2 * W_NA_OUT, 0);
    } else {
      prog_add(P, OP_GEMM_BF, 2048, 1024, 1024, hb, W + 2 * W_ML_IN, pj);
      prog_add(P, OP_MLA_POST1, 0, 0, 0, 0, 0, 0);
      prog_add(P, OP_GEMM_BF_NOSYNC, 1536, 512, 2048, pj, W + 2 * W_ML_UQ, qm);
      prog_add(P, OP_GEMM_BF, 2048, 256, 2048, pj + 2 * 512, W + 2 * W_ML_UKV, pj + (size_t)T * 2048 * 2);
      prog_add(P, OP_MLA_POST2, 0, 0, 0, 0, 0, 0);
      prog_add(P, OP_ATT_MLA, need_ctx, 0, 0, 0, 0, 0);
      prog_add(P, OP_GEMM_RES, i, 0, 2048, pj + 2 * 832, W + 2 * W_ML_OUT, 0);
    }
  }
  prog_add(P, OP_FINAL, 0, 0, 0, 0, 0, 0);
  return P;
}
__device__ const Prog PROG = make_prog();

struct WDesc { int in_idx; int K, N, Npad, tile0; unsigned src_off, dst_off; int pad_; };
constexpr int NWD = 10;
struct WTab { WDesc d[NWD]; int ntiles; };
constexpr WTab make_wtab() {
  WTab t{}; int nt = 0, wi = 0;
  auto addw = [&](int in_idx, size_t src_off, size_t dst, int K, int N, int Npad) { WDesc& w = t.d[wi++]; w.in_idx = in_idx; w.src_off = (unsigned)src_off; w.dst_off = (unsigned)dst; w.K = K; w.N = N; w.Npad = Npad; w.tile0 = nt; w.pad_ = 0; nt += (K / 64) * (Npad / 64); };
  addw(IN_GA_WIN, 0, W_GA_IN, 1024, 2560, 2560); addw(IN_GA_WIN, 1024ull * 2560, W_GA_IN + 2560ull * 1024, 1024, 2560, 2560);
  addw(IN_GA_WOUT, 0, W_GA_OUT, 1024, 1024, 1024); addw(IN_GA_WOUT, 1024ull * 1024, W_GA_OUT + 1024ull * 1024, 1024, 1024, 1024);
  addw(IN_NA_WIN, 0, W_NA_IN, 1024, 4096, 4096); addw(IN_NA_WOUT, 0, W_NA_OUT, 1024, 1024, 1024);
  addw(IN_ML_WIN, 0, W_ML_IN, 1024, 1856, 2048); addw(IN_ML_WUQ, 0, W_ML_UQ, 512, 1536, 1536); addw(IN_ML_WUKV, 0, W_ML_UKV, 256, 2048, 2048); addw(IN_ML_WOUT, 0, W_ML_OUT, 1024, 1024, 1024);
  t.ntiles = nt; return t;
}
__device__ const WTab WTAB = make_wtab();

__device__ const float INV_A[32] = {1.000000000e+00f, 7.498942614e-01f, 5.623413324e-01f, 4.216965139e-01f, 3.162277639e-01f, 2.371373773e-01f, 1.778279394e-01f, 1.333521307e-01f, 1.000000015e-01f, 7.498941571e-02f, 5.623413250e-02f, 4.216965288e-02f, 3.162277490e-02f, 2.371373773e-02f, 1.778279431e-02f, 1.333521493e-02f, 9.999999776e-03f, 7.498941850e-03f, 5.623413250e-03f, 4.216964822e-03f, 3.162277630e-03f, 2.371373586e-03f, 1.778279431e-03f, 1.333521446e-03f, 1.000000047e-03f, 7.498942432e-04f, 5.623413017e-04f, 4.216965172e-04f, 3.162277571e-04f, 2.371373703e-04f, 1.778279402e-04f, 1.333521504e-04f};
__device__ const float INV_M[16] = {1.000000000e+00f, 5.623413324e-01f, 3.162277639e-01f, 1.778279394e-01f, 1.000000015e-01f, 5.623413250e-02f, 3.162277490e-02f, 1.778279431e-02f, 9.999999776e-03f, 5.623413250e-03f, 3.162277630e-03f, 1.778279431e-03f, 1.000000047e-03f, 5.623413017e-04f, 3.162277571e-04f, 1.778279402e-04f};

__device__ __forceinline__ float bf2f(short b) { return __uint_as_float(((unsigned)(unsigned short)b) << 16); }
__device__ __forceinline__ unsigned cvtpk(float lo, float hi) { unsigned r; asm volatile("v_cvt_pk_bf16_f32 %0, %1, %2" : "=v"(r) : "v"(lo), "v"(hi)); return r; }
__device__ __forceinline__ bf16x8 pack8(const float* v) { u32x4 w = {cvtpk(v[0], v[1]), cvtpk(v[2], v[3]), cvtpk(v[4], v[5]), cvtpk(v[6], v[7])}; return *reinterpret_cast<bf16x8*>(&w); }
__device__ __forceinline__ float silu_f(float g) { return g * __builtin_amdgcn_rcpf(1.f + __builtin_amdgcn_exp2f(-g * 1.4426950408889634f)); }
__device__ __forceinline__ float wave_sum(float v) {
#pragma unroll
  for (int o = 32; o >= 1; o >>= 1) v += __shfl_xor(v, o);
  return v;
}
__device__ __forceinline__ const float* res_src(KP p, int layer, int row) {
  const int b = row / TPB, j = row - b * TPB;
  if (j < CTX) return (layer == 0 ? p->in[IN_CTX] : (const float*)(p->ws + OFF_XSC)) + ((size_t)b * CTX + j) * DM;
  return (layer == 0 ? p->in[IN_X] : (const float*)p->out) + ((size_t)b * SEQ + (j - CTX)) * DM;
}

namespace pg8 {
constexpr int BM = 256, BK = 64, HALF = 128, HTB = HALF * BK * 2, STAGE_BYTES = 8 * HTB, NXCD = 8, WGM = 8;
__device__ __forceinline__ int lds_byte(int r, int c) { const int st = (r >> 4) * 2 + (c >> 5), rr = r & 15, cc = c & 31, ob = rr * 64 + cc * 2; return st * 1024 + (ob ^ (((ob >> 9) & 1) << 5)); }
__device__ __forceinline__ void stage_rc(int b, int& R, int& C) { const int st = b / 1024, sb = b % 1024, swz = sb ^ (((sb >> 9) & 1) << 5); R = (st >> 1) * 16 + swz / 64; C = (st & 1) * 32 + (swz % 64) / 2; }
__device__ __forceinline__ int perm32(int rho) { const int n = rho >> 4, i = rho & 15; return 8 * (i >> 2) + 4 * n + (i & 3); }
struct Unit { int pm, pn; };
struct Gemm { const bf16_t* A; const bf16_t* Bt; int M, N, K, lda; };
struct StaticOrder {
  int nM, nN, nwg, G, c;
  __device__ void init(int M, int N, int G_, int c_) { nM = M / BM; nN = N / BM; nwg = nM * nN; G = G_; c = c_; }
  __device__ bool next(int i, Unit& u) const {
    const long L = (long)i * G + c; if (L >= nwg) return false;
    int wgid = (int)L; { const int q = nwg / NXCD, r = nwg % NXCD, xcd = wgid % NXCD, off = wgid / NXCD; wgid = (xcd < r ? xcd * (q + 1) : r * (q + 1) + (xcd - r) * q) + off; }
    const int nig = WGM * nN, gid = wgid / nig, fm = gid * WGM, gsz = (nM - fm) < WGM ? (nM - fm) : WGM;
    u.pm = fm + ((wgid % nig) % gsz); u.pn = (wgid % nig) / gsz; return true;
  }
};
struct EpiBf16 {
  static constexpr bool PERM = true;
  bf16_t* O; int ldc;
  __device__ __forceinline__ void operator()(const f32x4 (&acc)[2][2][4][2], const Unit& u, int wr, int wc, int fr, int fq) const {
    const int row0 = u.pm * BM + wr * 64 + fr, col0 = u.pn * BM + wc * 32 + 8 * fq;
#pragma unroll
    for (int ai = 0; ai < 2; ++ai)
#pragma unroll
      for (int m = 0; m < 4; ++m) { bf16_t* rowp = O + (size_t)(row0 + ai * HALF + m * 16) * ldc + col0;
#pragma unroll
        for (int bj = 0; bj < 2; ++bj) { const f32x4 v0 = acc[ai][bj][m][0], v1 = acc[ai][bj][m][1];
          u32x4 w; w.x = cvtpk(v0[0], v0[1]); w.y = cvtpk(v0[2], v0[3]); w.z = cvtpk(v1[0], v1[1]); w.w = cvtpk(v1[2], v1[3]);
          *(u32x4*)(rowp + bj * HALF) = w; } }
  }
};
struct EpiResid {
  static constexpr bool PERM = false;
  const float* res_lat; const float* res_ctx; float* out_lat; float* out_ctx; const float* mod;
  __device__ __forceinline__ void operator()(const f32x4 (&acc)[2][2][4][2], const Unit& u, int wr, int wc, int fr, int fq) const {
    const int b = u.pm / 33, lt = u.pm - b * 33;
    const float* rb; float* ob; const float* g;
    if (lt == 0) { rb = res_ctx + (size_t)b * CTX * DM; ob = out_ctx + (size_t)b * CTX * DM; g = mod + 4 * 3072 + 2048; }
    else { const size_t o = ((size_t)b * SEQ + (size_t)(lt - 1) * 256) * DM; rb = res_lat + o; ob = out_lat + o; g = mod + b * 3072 + 2048; }
    const int lr0 = wr * 64 + fr, col0 = u.pn * BM + wc * 32 + 4 * fq;
    f32x4 gv[2][2];
#pragma unroll
    for (int bj = 0; bj < 2; ++bj)
#pragma unroll
      for (int n = 0; n < 2; ++n) gv[bj][n] = *(const f32x4*)(g + col0 + bj * HALF + n * 16);
#pragma unroll
    for (int ai = 0; ai < 2; ++ai)
#pragma unroll
      for (int m = 0; m < 4; ++m) { const size_t ro = (size_t)(lr0 + ai * HALF + m * 16) * DM + col0;
#pragma unroll
        for (int bj = 0; bj < 2; ++bj)
#pragma unroll
          for (int n = 0; n < 2; ++n) { const f32x4 r = *(const f32x4*)(rb + ro + bj * HALF + n * 16);
            *(f32x4*)(ob + ro + bj * HALF + n * 16) = r + gv[bj][n] * acc[ai][bj][m][n]; } }
  }
};

template <class Epi>
__device__ __forceinline__ void gemm_phase(LAS unsigned char* lds, const Gemm g, const StaticOrder& S, const Epi& E, const int tid) {
  const int wid = __builtin_amdgcn_readfirstlane(tid >> 6), lane = tid & 63, wr = wid >> 2, wc = wid & 3, fr = lane & 15, fq = lane >> 4;
  const int K = g.K, nt = K / BK, lda = g.lda;
  unsigned voffA[2], voffB[2];
#pragma unroll
  for (int i = 0; i < 2; ++i) { int R, C; stage_rc(tid * 16 + i * 8192, R, C); const int Rb = Epi::PERM ? ((R & ~31) + perm32(R & 31)) : R;
    voffA[i] = (unsigned)(R * lda + C) * 2u; voffB[i] = (unsigned)(Rb * K + C) * 2u; }
  const size_t kstep = (size_t)(BK * 2);
  const size_t hstepA = (size_t)HALF * lda * 2, hstepB = (size_t)HALF * K * 2;
  const size_t tstepA = 2 * hstepA, tstepB = 2 * hstepB;
  const unsigned ldsw = (unsigned)wid * 1024u;
  const int aoff = lds_byte(wr * 64 + fr, fq * 8), boff = lds_byte(wc * 32 + fr, fq * 8);
#define PG8_SA(b, h) (((b) * 2 + (h)) * HTB)
#define PG8_SB(b, h) ((4 + (b) * 2 + (h)) * HTB)
#define PG8_STAGE(bufoff, gbase, voff) do { _Pragma("unroll") for (int _i = 0; _i < 2; ++_i) \
    __builtin_amdgcn_global_load_lds((const unsigned*)((const char*)(gbase) + (voff)[_i]), (LAS unsigned*)(lds + (bufoff) + ldsw + _i * 8192), 16, 0, 0); } while (0)
#define PG8_LDA(dst, b, h) do { _Pragma("unroll") for (int m = 0; m < 4; ++m) _Pragma("unroll") for (int k = 0; k < 2; ++k) dst[m][k] = *(const LAS bf16x8*)(lds + PG8_SA(b, h) + aoff + m * 2048 + k * 1024); } while (0)
#define PG8_LDB(dst, b, h) do { _Pragma("unroll") for (int n = 0; n < 2; ++n) _Pragma("unroll") for (int k = 0; k < 2; ++k) dst[n][k] = *(const LAS bf16x8*)(lds + PG8_SB(b, h) + boff + n * 2048 + k * 1024); } while (0)
#define PG8_MMA(ai, bj, At, Bt) do { __builtin_amdgcn_s_setprio(1); _Pragma("unroll") for (int m = 0; m < 4; ++m) _Pragma("unroll") for (int n = 0; n < 2; ++n) _Pragma("unroll") for (int k = 0; k < 2; ++k) \
    acc[ai][bj][m][n] = __builtin_amdgcn_mfma_f32_16x16x32_bf16(Bt[n][k], At[m][k], acc[ai][bj][m][n], 0, 0, 0); __builtin_amdgcn_s_setprio(0); } while (0)
#define PG8_WAIT_V(n) asm volatile("s_waitcnt vmcnt(" #n ")" ::: "memory")
#define PG8_WAIT_L(n) asm volatile("s_waitcnt lgkmcnt(" #n ")" ::: "memory")
#define PG8_BAR __builtin_amdgcn_s_barrier()
#define PG8_SCHED __builtin_amdgcn_sched_barrier(0)
  Unit cur, nxt; int ui = 0;
  if (!S.next(0, cur)) return;
  f32x4 acc[2][2][4][2];
#pragma unroll
  for (int a = 0; a < 2; ++a)
#pragma unroll
    for (int b = 0; b < 2; ++b)
#pragma unroll
      for (int m = 0; m < 4; ++m)
#pragma unroll
        for (int n = 0; n < 2; ++n) acc[a][b][m][n] = (f32x4){0.f, 0.f, 0.f, 0.f};
  bf16x8 At[4][2], B0[2][2], B1[2][2];
  const char* cA = (const char*)g.A + (size_t)cur.pm * tstepA; const char* cB = (const char*)g.Bt + (size_t)cur.pn * tstepB;
  PG8_STAGE(PG8_SB(0, 0), cB, voffB); PG8_STAGE(PG8_SA(0, 0), cA, voffA); PG8_STAGE(PG8_SB(0, 1), cB + hstepB, voffB); PG8_STAGE(PG8_SA(0, 1), cA + hstepA, voffA);
  if (wr == 1) PG8_BAR;
  PG8_WAIT_V(4); PG8_BAR;
  PG8_STAGE(PG8_SB(1, 0), cB + kstep, voffB); PG8_STAGE(PG8_SA(1, 0), cA + kstep, voffA); PG8_STAGE(PG8_SB(1, 1), cB + hstepB + kstep, voffB);
  PG8_WAIT_V(6); PG8_BAR;
  for (;;) {
    const bool has_next = S.next(ui + 1, nxt);
    const char* nA = has_next ? (const char*)g.A + (size_t)nxt.pm * tstepA : cA; const char* nB = has_next ? (const char*)g.Bt + (size_t)nxt.pn * tstepB : cB;
    for (int t = 0; t < nt; t += 2) {
      const bool last = (t == nt - 2);
      const char* a1 = cA + (size_t)(t + 1) * kstep;
      const char* a2 = last ? nA : cA + (size_t)(t + 2) * kstep; const char* b2 = last ? nB : cB + (size_t)(t + 2) * kstep;
      const char* a3 = a2 + kstep; const char* b3 = b2 + kstep;
      PG8_LDB(B0, 0, 0); PG8_SCHED; PG8_LDA(At, 0, 0); PG8_STAGE(PG8_SA(1, 1), a1 + hstepA, voffA);
      PG8_WAIT_L(8); PG8_BAR; PG8_WAIT_L(0); PG8_MMA(0, 0, At, B0); PG8_BAR; PG8_SCHED;
      PG8_LDB(B1, 0, 1); PG8_STAGE(PG8_SB(0, 0), b2, voffB);
      PG8_BAR; PG8_WAIT_L(0); PG8_MMA(0, 1, At, B1); PG8_BAR;
      PG8_LDA(At, 0, 1); PG8_STAGE(PG8_SA(0, 0), a2, voffA);
      PG8_BAR; PG8_WAIT_L(0); PG8_MMA(1, 0, At, B0); PG8_BAR; PG8_SCHED;
      PG8_STAGE(PG8_SB(0, 1), b2 + hstepB, voffB);
      PG8_WAIT_V(6); PG8_BAR; PG8_MMA(1, 1, At, B1); PG8_BAR;
      PG8_LDB(B0, 1, 0); PG8_SCHED; PG8_LDA(At, 1, 0); PG8_STAGE(PG8_SA(0, 1), a2 + hstepA, voffA);
      PG8_WAIT_L(8); PG8_BAR; PG8_WAIT_L(0); PG8_MMA(0, 0, At, B0); PG8_BAR; PG8_SCHED;
      PG8_LDB(B1, 1, 1); PG8_STAGE(PG8_SB(1, 0), b3, voffB);
      PG8_BAR; PG8_WAIT_L(0); PG8_MMA(0, 1, At, B1); PG8_BAR;
      PG8_LDA(At, 1, 1); PG8_STAGE(PG8_SA(1, 0), a3, voffA);
      PG8_BAR; PG8_WAIT_L(0); PG8_MMA(1, 0, At, B0); PG8_BAR; PG8_SCHED;
      PG8_STAGE(PG8_SB(1, 1), b3 + hstepB, voffB);
      PG8_WAIT_V(6); PG8_BAR; PG8_MMA(1, 1, At, B1); PG8_BAR;
    }
    E(acc, cur, wr, wc, fr, fq);
    if (!has_next) break;
#pragma unroll
    for (int a = 0; a < 2; ++a)
#pragma unroll
      for (int b = 0; b < 2; ++b)
#pragma unroll
        for (int m = 0; m < 4; ++m)
#pragma unroll
          for (int n = 0; n < 2; ++n) acc[a][b][m][n] = (f32x4){0.f, 0.f, 0.f, 0.f};
    cur = nxt; cA = nA; cB = nB; ++ui;
  }
  PG8_WAIT_V(0);
  if (wr == 0) PG8_BAR;
  PG8_BAR;
#undef PG8_SA
#undef PG8_SB
#undef PG8_STAGE
#undef PG8_LDA
#undef PG8_LDB
#undef PG8_MMA
#undef PG8_WAIT_V
#undef PG8_WAIT_L
#undef PG8_BAR
#undef PG8_SCHED
}
}

#define SBAR() __builtin_amdgcn_sched_barrier(0)
__device__ __forceinline__ int crow(int r, int hi) { return (r & 3) + 8 * (r >> 2) + 4 * hi; }
constexpr float THR = 8.f;
template <int DQK> struct ScaleOf;
template <> struct ScaleOf<64> { static constexpr float v = 0.125f; };
template <> struct ScaleOf<128> { static constexpr float v = 0.088388347648318440f; };
template <> struct ScaleOf<192> { static constexpr float v = 0.072168783648703220f; };

template <int DQK>
__device__ __forceinline__ void partialSM(f32x16& p0, f32x16& p1, float& m_reg, float& mn, float& alpha) {
  constexpr float SCALE = ScaleOf<DQK>::v, C = SCALE * 1.4426950408889634f;
  float pmax = p0[0];
#pragma unroll
  for (int r = 1; r < 16; ++r) pmax = fmaxf(pmax, p0[r]);
#pragma unroll
  for (int r = 0; r < 16; ++r) pmax = fmaxf(pmax, p1[r]);
  { auto rr = __builtin_amdgcn_permlane32_swap(__float_as_uint(pmax), __float_as_uint(pmax), false, false);
    pmax = fmaxf(__uint_as_float(rr[0]), __uint_as_float(rr[1])); }
  if (__builtin_expect(__all(pmax - m_reg <= THR / SCALE), 1)) { mn = m_reg; alpha = 1.f; }
  else { mn = fmaxf(m_reg, pmax); alpha = __builtin_amdgcn_exp2f((m_reg - mn) * C); m_reg = mn; }
  const float mnC = -mn * C;
#pragma unroll
  for (int r = 0; r < 16; ++r) p0[r] = fmaf(p0[r], C, mnC);
#pragma unroll
  for (int r = 0; r < 16; ++r) p1[r] = fmaf(p1[r], C, mnC);
#pragma unroll
  for (int r = 0; r < 16; ++r) p0[r] = __builtin_amdgcn_exp2f(p0[r]);
}
__device__ __forceinline__ void finishSM(f32x16& p0, f32x16& p1, float alpha, float& l_reg, bf16x8& pa0, bf16x8& pa1, bf16x8& pa2, bf16x8& pa3) {
#pragma unroll
  for (int r = 0; r < 16; ++r) p1[r] = __builtin_amdgcn_exp2f(p1[r]);
  float ps = 0;
#pragma unroll
  for (int r = 0; r < 16; ++r) ps += p0[r];
#pragma unroll
  for (int r = 0; r < 16; ++r) ps += p1[r];
  { auto rr = __builtin_amdgcn_permlane32_swap(__float_as_uint(ps), __float_as_uint(ps), false, false);
    ps = __uint_as_float(rr[0]) + __uint_as_float(rr[1]); }
  l_reg = l_reg * alpha + ps;
#define PK4(P, BASE, OUT) do { unsigned a0 = cvtpk(P[BASE + 0], P[BASE + 1]), a1 = cvtpk(P[BASE + 2], P[BASE + 3]);   \
    unsigned b0 = cvtpk(P[BASE + 4], P[BASE + 5]), b1 = cvtpk(P[BASE + 6], P[BASE + 7]);                              \
    auto r0 = __builtin_amdgcn_permlane32_swap(a0, b0, false, false); auto r1 = __builtin_amdgcn_permlane32_swap(a1, b1, false, false); \
    u32x4 w = {r0[0], r1[0], r0[1], r1[1]}; OUT = *reinterpret_cast<bf16x8*>(&w); } while (0)
  PK4(p0, 0, pa0); PK4(p0, 8, pa1); PK4(p1, 0, pa2); PK4(p1, 8, pa3);
#undef PK4
}
template <int DQK>
__device__ __forceinline__ void qkt(f32x16& p0, f32x16& p1, const char* Ks, const bf16x8* qr, int r32, int hi) {
  constexpr int RB = DQK * 2;
  p0 = f32x16{}; p1 = f32x16{};
#pragma unroll
  for (int d0 = 0; d0 < DQK / 16; ++d0) { const int cb = (d0 * 16 + hi * 8) * 2;
    bf16x8 b0 = *reinterpret_cast<const bf16x8*>(Ks + r32 * RB + (cb ^ ((r32 & 7) << 4)));
    bf16x8 b1 = *reinterpret_cast<const bf16x8*>(Ks + (32 + r32) * RB + (cb ^ ((r32 & 7) << 4)));
    p0 = __builtin_amdgcn_mfma_f32_32x32x16_bf16(b0, qr[d0], p0, 0, 0, 0);
    p1 = __builtin_amdgcn_mfma_f32_32x32x16_bf16(b1, qr[d0], p1, 0, 0, 0); }
}
template <int NCB> __device__ __forceinline__ int v_st(int k, int c) { const int kk = (k & ~0xC) | ((k & 4) << 1) | ((k & 8) >> 1); return ((kk >> 3) * NCB + (c >> 5)) * 512 + ((kk & 7) * 32 + (c & 31)) * 2; }
__device__ __forceinline__ int v_rd_base(int lane) { return ((lane & 3) << 3) | (((lane >> 2) & 3) << 6) | (((lane >> 4) & 1) << 5) | (((lane >> 5) & 1) << 8); }
template <int OFF> __device__ __forceinline__ s16x4 tr_read(int vb) {
  s16x4 r; asm volatile("ds_read_b64_tr_b16 %0, %1 offset:%2" : "=&v"(r) : "v"(vb), "i"(OFF) : "memory"); return r;
}
template <int NCB, int D0> __device__ __forceinline__ void pv_one(f32x16& od, int vb, bf16x8 pa0, bf16x8 pa1, bf16x8 pa2, bf16x8 pa3) {
#define VOFF(ks, half) (D0 * 512 + (ks) * (NCB * 1024) + (half) * (NCB * 512))
  const s16x4 l0 = tr_read<VOFF(0, 0)>(vb), h0 = tr_read<VOFF(0, 1)>(vb), l1 = tr_read<VOFF(1, 0)>(vb), h1 = tr_read<VOFF(1, 1)>(vb);
  const s16x4 l2 = tr_read<VOFF(2, 0)>(vb), h2 = tr_read<VOFF(2, 1)>(vb), l3 = tr_read<VOFF(3, 0)>(vb), h3 = tr_read<VOFF(3, 1)>(vb);
#undef VOFF
  asm volatile("s_waitcnt lgkmcnt(0)" ::: "memory"); SBAR();
#define PK(L, H) (bf16x8){L[0], L[1], L[2], L[3], H[0], H[1], H[2], H[3]}
  od = __builtin_amdgcn_mfma_f32_32x32x16_bf16(pa0, PK(l0, h0), od, 0, 0, 0);
  od = __builtin_amdgcn_mfma_f32_32x32x16_bf16(pa1, PK(l1, h1), od, 0, 0, 0);
  od = __builtin_amdgcn_mfma_f32_32x32x16_bf16(pa2, PK(l2, h2), od, 0, 0, 0);
  od = __builtin_amdgcn_mfma_f32_32x32x16_bf16(pa3, PK(l3, h3), od, 0, 0, 0);
#undef PK
}
template <int NCB> __device__ __forceinline__ void pv_all(f32x16* o, int vb, bf16x8 pa0, bf16x8 pa1, bf16x8 pa2, bf16x8 pa3) {
  pv_one<NCB, 0>(o[0], vb, pa0, pa1, pa2, pa3); pv_one<NCB, 1>(o[1], vb, pa0, pa1, pa2, pa3);
  if constexpr (NCB == 4) { pv_one<NCB, 2>(o[2], vb, pa0, pa1, pa2, pa3); pv_one<NCB, 3>(o[3], vb, pa0, pa1, pa2, pa3); }
}

template <int DQK, int DV, int MODE, int SD>
__device__ __forceinline__ void attn_body(const bf16_t* __restrict__ Qb, int ldq, const bf16_t* __restrict__ Kp, const bf16_t* __restrict__ K2p, const bf16_t* __restrict__ Vp, int ldk,
                                          int krow_base, bf16_t* __restrict__ OG, int ldo, int NT, int na_r0, char* lds, int tid, int dummy) {
  constexpr int NQ = DQK / 16, NCB = DV / 32, SHM_K = 64 * DQK * 2, SHM_V = 64 * DV * 2, RB = DQK * 2;
  constexpr int NKC = DQK / 64, NVC = DV / 64;
  constexpr float SCALE = ScaleOf<DQK>::v;
  const int wid = tid >> 6, lane = tid & 63, r32 = lane & 31, hi = lane >> 5;
  constexpr int SE = 0, SO = SD - 1;
  char* V_lds = lds; char* K_lds = lds + 2 * SHM_V;
  float* wsl = (float*)(lds + 2 * SHM_V + 2 * SHM_K) + wid * 64; float* li_l = wsl; float* al_l = wsl + 32;
  const float* bias_l = (const float*)(lds + 2 * SHM_V + 2 * SHM_K + 8 * 64 * 4);
  float m_reg = -1e30f, l_reg = 0; f32x16 o[NCB]; bf16x8 qr[NQ];
#pragma unroll
  for (int d = 0; d < NCB; ++d) o[d] = f32x16{};
  const bf16_t* Qw = Qb + (size_t)(wid * 32 + r32) * ldq + hi * 8;
#pragma unroll
  for (int d0 = 0; d0 < NQ; ++d0) qr[d0] = *reinterpret_cast<const bf16x8*>(Qw + d0 * 16);
  const int sr = tid >> 4, sc = (tid & 15) * 8, sr8 = tid >> 3, sc8 = (tid & 7) * 8;
  const int vb0 = (int)(uintptr_t)V_lds + v_rd_base(lane);
  struct { bf16x8 k[NKC], v[NVC]; } sr_[SD];
  auto tile_row = [&](int j) -> int {
    if constexpr (MODE == 0) return krow_base + j * 64;
    else { if (j < 4) return krow_base + j * 64; int kr = na_r0 - 8 + j; kr = kr < 0 ? 0 : (kr > 127 ? 127 : kr); return krow_base + CTX + kr * 64; }
  };
#define SLOAD(i, j) do { const size_t kr_ = (size_t)tile_row(j);                                                                              \
    if constexpr (DQK >= 128) { sr_[i].k[0] = *reinterpret_cast<const bf16x8*>(Kp + (kr_ + sr) * ldk + sc); sr_[i].k[1] = *reinterpret_cast<const bf16x8*>(Kp + (kr_ + 32 + sr) * ldk + sc); } \
    if constexpr (DQK == 192) sr_[i].k[2] = *reinterpret_cast<const bf16x8*>(K2p + (kr_ + sr8) * ldk + sc8);                                 \
    if constexpr (DQK == 64) sr_[i].k[0] = *reinterpret_cast<const bf16x8*>(Kp + (kr_ + sr8) * ldk + sc8);                                   \
    if constexpr (DV == 128) { sr_[i].v[0] = *reinterpret_cast<const bf16x8*>(Vp + (kr_ + sr) * ldk + sc); sr_[i].v[1] = *reinterpret_cast<const bf16x8*>(Vp + (kr_ + 32 + sr) * ldk + sc); } \
    else sr_[i].v[0] = *reinterpret_cast<const bf16x8*>(Vp + (kr_ + sr8) * ldk + sc8); } while (0)
#define KSW(row, colB) ((row) * RB + ((colB) ^ (((row) & 7) << 4)))
#define SWRITE(b, i) do {                                                                                                                       \
    if constexpr (DV == 128) { *(bf16x8*)(V_lds + (b) * SHM_V + v_st<NCB>(sr, sc)) = sr_[i].v[0]; *(bf16x8*)(V_lds + (b) * SHM_V + v_st<NCB>(32 + sr, sc)) = sr_[i].v[1]; } \
    else *(bf16x8*)(V_lds + (b) * SHM_V + v_st<NCB>(sr8, sc8)) = sr_[i].v[0];                                                                  \
    if constexpr (DQK >= 128) { *(bf16x8*)(K_lds + (b) * SHM_K + KSW(sr, sc * 2)) = sr_[i].k[0]; *(bf16x8*)(K_lds + (b) * SHM_K + KSW(32 + sr, sc * 2)) = sr_[i].k[1]; } \
    if constexpr (DQK == 192) *(bf16x8*)(K_lds + (b) * SHM_K + KSW(sr8, 256 + sc8 * 2)) = sr_[i].k[2];                                        \
    if constexpr (DQK == 64) *(bf16x8*)(K_lds + (b) * SHM_K + KSW(sr8, sc8 * 2)) = sr_[i].k[0]; } while (0)
#define SWAIT() asm volatile("s_waitcnt vmcnt(%0)" :: "n"(SD == 2 ? NKC + NVC : 0) : "memory")
#define RESC(a) do { if (__any((a) < 1.f)) { if (hi == 0) al_l[r32] = (a); asm volatile("s_waitcnt lgkmcnt(0)" ::: "memory"); \
    _Pragma("unroll") for (int d = 0; d < NCB; ++d) _Pragma("unroll") for (int r = 0; r < 16; ++r) o[d][r] *= al_l[crow(r, hi)]; } } while (0)
  auto na_mask = [&](f32x16& p0, f32x16& p1, int j) {
    if constexpr (MODE == 1) {
      if (j >= 4) {
        const int krraw = na_r0 - 8 + j, r = na_r0 + (wid >> 1);
        int rs = r - 4; rs = rs < 0 ? 0 : (rs > 120 ? 120 : rs);
        const float NINF = -__builtin_inff();
        if (krraw < rs || krraw >= rs + 8) {
#pragma unroll
          for (int q = 0; q < 16; ++q) { p0[q] = NINF; p1[q] = NINF; }
        } else {
          const float* brow = bias_l + (krraw - r + 7) * 32;
          const int c = (wid & 1) * 32 + r32; int cs = c - 8; cs = cs < 0 ? 0 : (cs > 48 ? 48 : cs);
#pragma unroll
          for (int q = 0; q < 16; ++q) {
            const int k0 = crow(q, hi), k1 = 32 + k0;
            int i0 = k0 - c + 15, i1 = k1 - c + 15; i0 = i0 < 0 ? 0 : (i0 > 30 ? 30 : i0); i1 = i1 < 0 ? 0 : (i1 > 30 ? 30 : i1);
            const float b0 = brow[i0], b1 = brow[i1];
            p0[q] = (k0 >= cs && k0 < cs + 16) ? p0[q] + b0 : NINF;
            p1[q] = (k1 >= cs && k1 < cs + 16) ? p1[q] + b1 : NINF;
          }
        }
      }
    }
  };
  f32x16 pA0, pA1, pB0, pB1; float mnA, mnB, alA, alB; bf16x8 pa0, pa1, pa2, pa3;
  SLOAD(SE, 0); asm volatile("s_waitcnt vmcnt(0)" ::: "memory"); SWRITE(0, SE); __syncthreads();
  qkt<DQK>(pA0, pA1, K_lds, qr, r32, hi); na_mask(pA0, pA1, 0); partialSM<DQK>(pA0, pA1, m_reg, mnA, alA);
  SLOAD(SO, 1); if constexpr (SD == 2) { if (2 < NT) SLOAD(SE, 2); }
  SWAIT(); SWRITE(1, SO); __syncthreads();
  for (int j = 1; j + 1 < NT; j += 2) {
    SBAR(); qkt<DQK>(pB0, pB1, K_lds + SHM_K, qr, r32, hi);
    finishSM(pA0, pA1, alA, l_reg, pa0, pa1, pa2, pa3); SBAR();
    SLOAD(SO, j + SD); SBAR();
    pv_all<NCB>(o, vb0, pa0, pa1, pa2, pa3); na_mask(pB0, pB1, j); partialSM<DQK>(pB0, pB1, m_reg, mnB, alB);
    __syncthreads(); SWAIT(); SWRITE(0, SE);
    RESC(alB); __syncthreads();
    SBAR(); qkt<DQK>(pA0, pA1, K_lds, qr, r32, hi);
    finishSM(pB0, pB1, alB, l_reg, pa0, pa1, pa2, pa3); SBAR();
    if (SD == 1 || j + 3 < NT) SLOAD(SE, j + 1 + SD); SBAR();
    pv_all<NCB>(o, vb0 + SHM_V, pa0, pa1, pa2, pa3); na_mask(pA0, pA1, j + 1); partialSM<DQK>(pA0, pA1, m_reg, mnA, alA);
    __syncthreads(); SWAIT(); SWRITE(1, SO);
    RESC(alA); __syncthreads();
  }
  SBAR(); qkt<DQK>(pB0, pB1, K_lds + SHM_K, qr, r32, hi);
  finishSM(pA0, pA1, alA, l_reg, pa0, pa1, pa2, pa3); SBAR();
  pv_all<NCB>(o, vb0, pa0, pa1, pa2, pa3); na_mask(pB0, pB1, NT - 1); partialSM<DQK>(pB0, pB1, m_reg, mnB, alB);
  __syncthreads(); RESC(alB);
  finishSM(pB0, pB1, alB, l_reg, pa0, pa1, pa2, pa3); SBAR();
  pv_all<NCB>(o, vb0 + SHM_V, pa0, pa1, pa2, pa3);
  if (dummy) { if (l_reg == 123.456f) OG[tid] = (bf16_t)(cvtpk(o[0][0], o[1][3]) & 0xffffu); return; }
  if (hi == 0) li_l[r32] = l_reg; asm volatile("s_waitcnt lgkmcnt(0)" ::: "memory");
  float rli[16];
#pragma unroll
  for (int r = 0; r < 16; ++r) rli[r] = __builtin_amdgcn_rcpf(li_l[crow(r, hi)]);
  bf16_t* Ow = OG + (size_t)(wid * 32) * ldo;
#pragma unroll
  for (int r = 0; r < 16; ++r) { const int orow = crow(r, hi);
#pragma unroll
    for (int d0 = 0; d0 < NCB; ++d0) { bf16_t* pp = Ow + (size_t)orow * ldo + d0 * 32 + r32;
      const float g = bf2f((short)*pp); const float v = o[d0][r] * rli[r] * silu_f(g);
      *pp = (bf16_t)(cvtpk(v, v) & 0xffffu); } }
#undef SLOAD
#undef SWRITE
#undef SWAIT
#undef RESC
#undef KSW
}

template <int DQK, int DV>
__device__ __forceinline__ void attn_body_seq(const bf16_t* __restrict__ Qb, int ldq, const bf16_t* __restrict__ Kp, const bf16_t* __restrict__ K2p, const bf16_t* __restrict__ Vp, int ldk,
                                              int krow_base, bf16_t* __restrict__ OG, int ldo, int NT, char* lds, int tid, int dummy) {
  constexpr int NQ = DQK / 16, NCB = DV / 32, SHM_K = 64 * DQK * 2, SHM_V = 64 * DV * 2, RB = DQK * 2;
  constexpr int NKC = DQK / 64, NVC = DV / 64;
  const int wid = tid >> 6, lane = tid & 63, r32 = lane & 31, hi = lane >> 5;
  char* V_lds = lds; char* K_lds = lds + 2 * SHM_V;
  float* wsl = (float*)(lds + 2 * SHM_V + 2 * SHM_K) + wid * 64; float* li_l = wsl; float* al_l = wsl + 32;
  float m_reg = -1e30f, l_reg = 0; f32x16 o[NCB]; bf16x8 qr[NQ];
#pragma unroll
  for (int d = 0; d < NCB; ++d) o[d] = f32x16{};
  const bf16_t* Qw = Qb + (size_t)(wid * 32 + r32) * ldq + hi * 8;
#pragma unroll
  for (int d0 = 0; d0 < NQ; ++d0) qr[d0] = *reinterpret_cast<const bf16x8*>(Qw + d0 * 16);
  const int sr = tid >> 4, sc = (tid & 15) * 8, sr8 = tid >> 3, sc8 = (tid & 7) * 8;
  const int vb0 = (int)(uintptr_t)V_lds + v_rd_base(lane);
  bf16x8 sk[NKC], sv[NVC];
#define SLOAD(j) do { const size_t kr_ = (size_t)(krow_base + (j) * 64);                                                                      \
    if constexpr (DQK >= 128) { sk[0] = *reinterpret_cast<const bf16x8*>(Kp + (kr_ + sr) * ldk + sc); sk[1] = *reinterpret_cast<const bf16x8*>(Kp + (kr_ + 32 + sr) * ldk + sc); } \
    if constexpr (DQK == 192) sk[2] = *reinterpret_cast<const bf16x8*>(K2p + (kr_ + sr8) * ldk + sc8);                                       \
    if constexpr (DQK == 64) sk[0] = *reinterpret_cast<const bf16x8*>(Kp + (kr_ + sr8) * ldk + sc8);                                         \
    if constexpr (DV == 128) { sv[0] = *reinterpret_cast<const bf16x8*>(Vp + (kr_ + sr) * ldk + sc); sv[1] = *reinterpret_cast<const bf16x8*>(Vp + (kr_ + 32 + sr) * ldk + sc); } \
    else sv[0] = *reinterpret_cast<const bf16x8*>(Vp + (kr_ + sr8) * ldk + sc8); } while (0)
#define KSW(row, colB) ((row) * RB + ((colB) ^ (((row) & 7) << 4)))
#define SWRITE(b) do {                                                                                                                          \
    if constexpr (DV == 128) { *(bf16x8*)(V_lds + (b) * SHM_V + v_st<NCB>(sr, sc)) = sv[0]; *(bf16x8*)(V_lds + (b) * SHM_V + v_st<NCB>(32 + sr, sc)) = sv[1]; } \
    else *(bf16x8*)(V_lds + (b) * SHM_V + v_st<NCB>(sr8, sc8)) = sv[0];                                                                        \
    if constexpr (DQK >= 128) { *(bf16x8*)(K_lds + (b) * SHM_K + KSW(sr, sc * 2)) = sk[0]; *(bf16x8*)(K_lds + (b) * SHM_K + KSW(32 + sr, sc * 2)) = sk[1]; } \
    if constexpr (DQK == 192) *(bf16x8*)(K_lds + (b) * SHM_K + KSW(sr8, 256 + sc8 * 2)) = sk[2];                                              \
    if constexpr (DQK == 64) *(bf16x8*)(K_lds + (b) * SHM_K + KSW(sr8, sc8 * 2)) = sk[0]; } while (0)
  SLOAD(0); asm volatile("s_waitcnt vmcnt(0)" ::: "memory"); SWRITE(0); __syncthreads();
  for (int j = 0; j < NT; ++j) {
    const int bsel = j & 1;
    if (j + 1 < NT) SLOAD(j + 1);
    SBAR();
    f32x16 p0, p1; float mn, al; bf16x8 pa0, pa1, pa2, pa3;
    qkt<DQK>(p0, p1, K_lds + bsel * SHM_K, qr, r32, hi);
    partialSM<DQK>(p0, p1, m_reg, mn, al);
    finishSM(p0, p1, al, l_reg, pa0, pa1, pa2, pa3);
    if (__any(al < 1.f)) { if (hi == 0) al_l[r32] = al; asm volatile("s_waitcnt lgkmcnt(0)" ::: "memory");
#pragma unroll
      for (int d = 0; d < NCB; ++d)
#pragma unroll
        for (int r = 0; r < 16; ++r) o[d][r] *= al_l[crow(r, hi)]; }
    SBAR();
    pv_all<NCB>(o, vb0 + bsel * SHM_V, pa0, pa1, pa2, pa3);
    if (j + 1 < NT) SWRITE(bsel ^ 1);
    __syncthreads();
  }
  if (dummy) { if (l_reg == 123.456f) OG[tid] = (bf16_t)(cvtpk(o[0][0], o[1][3]) & 0xffffu); return; }
  if (hi == 0) li_l[r32] = l_reg; asm volatile("s_waitcnt lgkmcnt(0)" ::: "memory");
  float rli[16];
#pragma unroll
  for (int r = 0; r < 16; ++r) rli[r] = __builtin_amdgcn_rcpf(li_l[crow(r, hi)]);
  bf16_t* Ow = OG + (size_t)(wid * 32) * ldo;
#pragma unroll
  for (int r = 0; r < 16; ++r) { const int orow = crow(r, hi);
#pragma unroll
    for (int d0 = 0; d0 < NCB; ++d0) { bf16_t* pp = Ow + (size_t)orow * ldo + d0 * 32 + r32;
      const float g = bf2f((short)*pp); const float v = o[d0][r] * rli[r] * silu_f(g);
      *pp = (bf16_t)(cvtpk(v, v) & 0xffffu); } }
#undef SLOAD
#undef SWRITE
#undef KSW
}

__device__ __forceinline__ void phase_pre(KP p, char* lds, const int tid) {
  float* tl = (float*)lds;
  for (int tt = blockIdx.x; tt < WTAB.ntiles; tt += gridDim.x) {
    int di = 0;
    for (int i = 1; i < NWD; ++i) if (tt >= WTAB.d[i].tile0) di = i;
    const WDesc wd = WTAB.d[di];
    const float* src = p->in[wd.in_idx] + wd.src_off; bf16_t* dst = (bf16_t*)(p->ws + OFF_W) + wd.dst_off; const int K = wd.K, N = wd.N, local = tt - wd.tile0;
    const int nkt = K >> 6, kt = local % nkt, ntile = local / nkt;
    const int kk = tid >> 3, n8 = (tid & 7) * 8;
    f32x4 a = {0.f, 0.f, 0.f, 0.f}, b = a;
    if (ntile * 64 < N) { const float* sp = src + (size_t)(kt * 64 + kk) * N + ntile * 64 + n8; a = *(const f32x4*)sp; b = *(const f32x4*)(sp + 4); }
    __syncthreads();
#pragma unroll
    for (int i = 0; i < 4; ++i) { tl[(n8 + i) * 65 + kk] = a[i]; tl[(n8 + 4 + i) * 65 + kk] = b[i]; }
    __syncthreads();
    const int n = tid >> 3, k8 = (tid & 7) * 8; float v[8];
#pragma unroll
    for (int i = 0; i < 8; ++i) v[i] = tl[n * 65 + k8 + i];
    *(bf16x8*)(dst + (size_t)(ntile * 64 + n) * K + kt * 64 + k8) = pack8(v);
  }
  float* part = (float*)(p->ws + OFF_MODP);
  for (int it = blockIdx.x; it < 4 * 16 * 6; it += gridDim.x) {
    const int nb = it % 6, kc = (it / 6) & 15, layer = it / 96;
    __syncthreads();
    if (tid < 320) { const int s = tid >> 6, kk = tid & 63; const float cv = s < 4 ? p->in[IN_C][s * DM + kc * 64 + kk] : p->in[IN_CCTX][kc * 64 + kk]; tl[tid] = silu_f(cv); }
    __syncthreads();
    const int n = nb * 512 + tid; const float* wp = p->in[IN_MODW] + ((size_t)layer * DM + kc * 64) * 3072 + n;
    float a0 = 0, a1 = 0, a2 = 0, a3 = 0, a4 = 0;
#pragma unroll 8
    for (int kk = 0; kk < 64; ++kk) { const float w = wp[(size_t)kk * 3072]; a0 += tl[kk] * w; a1 += tl[64 + kk] * w; a2 += tl[128 + kk] * w; a3 += tl[192 + kk] * w; a4 += tl[256 + kk] * w; }
    float* pp = part + ((size_t)(kc * 4 + layer) * 5) * 3072 + n;
    pp[0] = a0; pp[3072] = a1; pp[2 * 3072] = a2; pp[3 * 3072] = a3; pp[4 * 3072] = a4;
  }
  for (int i = blockIdx.x * NTHREADS + tid; i < 128 * 48; i += gridDim.x * NTHREADS) {
    int pos, f; float inv; float2* dstp;
    if (i < 128 * 32) { pos = i >> 5; f = i & 31; inv = INV_A[f]; dstp = (float2*)(p->ws + OFF_TABA) + i; }
    else { const int q = i - 128 * 32; pos = q >> 4; f = q & 15; inv = INV_M[f]; dstp = (float2*)(p->ws + OFF_TABM) + q; }
    const float angf = (float)pos * inv;
    const double ang = (double)angf, k = __builtin_rint(ang * 0.15915494309189535), r = ang - k * 6.283185307179586476925287, r2 = r * r;
    double sn = r, cs = 1.0, ts = r, tc = 1.0;
#pragma unroll 1
    for (int q = 1; q <= 14; ++q) { tc = -tc * r2 / (double)((2 * q - 1) * (2 * q)); cs += tc; ts = -ts * r2 / (double)((2 * q) * (2 * q + 1)); sn += ts; }
    *dstp = make_float2((float)cs, (float)sn);
  }
}
__device__ __forceinline__ void phase_modfin(KP p, const int tid) {
  const float* part = (const float*)(p->ws + OFF_MODP); float* mod = (float*)(p->ws + OFF_MOD);
  for (int i = blockIdx.x * NTHREADS + tid; i < 4 * 5 * 3072; i += gridDim.x * NTHREADS) {
    const int n = i % 3072, layer = i / (5 * 3072);
    float a = p->in[IN_MODB][layer * 3072 + n];
#pragma unroll
    for (int kc = 0; kc < 16; ++kc) a += part[(size_t)kc * (4 * 5 * 3072) + i];
    mod[i] = a;
  }
}
__device__ __forceinline__ void phase_norm(KP p, int layer, const int tid) {
  const int lane = tid & 63, gw = blockIdx.x * 8 + (tid >> 6), nw = gridDim.x * 8;
  const float* mod = (const float*)(p->ws + OFF_MOD) + (size_t)layer * 5 * 3072; const float* g = p->in[IN_NORMG] + layer * DM; bf16_t* hb = (bf16_t*)(p->ws + OFF_HB);
  for (int row = gw; row < T; row += nw) {
    const float* xr = res_src(p, layer, row);
    const int b = row / TPB, j = row - b * TPB; const float* m = mod + (j < CTX ? 4 : b) * 3072;
    f32x4 v[4]; float ss = 0;
#pragma unroll
    for (int i = 0; i < 4; ++i) { v[i] = *(const f32x4*)(xr + i * 256 + lane * 4); ss += v[i][0] * v[i][0] + v[i][1] * v[i][1] + v[i][2] * v[i][2] + v[i][3] * v[i][3]; }
    ss = wave_sum(ss); const float rstd = rsqrtf(ss * (1.f / DM) + EPS);
#pragma unroll
    for (int i = 0; i < 4; ++i) { const int col = i * 256 + lane * 4; const f32x4 gg = *(const f32x4*)(g + col), sh = *(const f32x4*)(m + col), scl = *(const f32x4*)(m + 1024 + col);
      float y[4];
#pragma unroll
      for (int e = 0; e < 4; ++e) y[e] = v[i][e] * rstd * gg[e] * (1.f + scl[e]) + sh[e];
      u32x2 w = {cvtpk(y[0], y[1]), cvtpk(y[2], y[3])}; *(u32x2*)(hb + (size_t)row * DM + col) = w; }
  }
}
__device__ __forceinline__ void phase_final(KP p, const int tid) {
  const int lane = tid & 63, gw = blockIdx.x * 8 + (tid >> 6), nw = gridDim.x * 8;
  for (int row = gw; row < NB * SEQ; row += nw) {
    float* xr = p->out + (size_t)row * DM; f32x4 v[4]; float ss = 0;
#pragma unroll
    for (int i = 0; i < 4; ++i) { v[i] = *(const f32x4*)(xr + i * 256 + lane * 4); ss += v[i][0] * v[i][0] + v[i][1] * v[i][1] + v[i][2] * v[i][2] + v[i][3] * v[i][3]; }
    ss = wave_sum(ss); const float rstd = rsqrtf(ss * (1.f / DM) + EPS);
#pragma unroll
    for (int i = 0; i < 4; ++i) { const int col = i * 256 + lane * 4; const f32x4 gg = *(const f32x4*)(p->in[IN_FINALG] + col); *(f32x4*)(xr + col) = v[i] * rstd * gg; }
  }
}
__device__ __forceinline__ void phase_gqa_post(KP p, int j, const int tid) {
  const int lane = tid & 63, gw = blockIdx.x * 8 + (tid >> 6), nw = gridDim.x * 8, g4 = lane >> 4, i = lane & 15;
  bf16_t* pj = (bf16_t*)(p->ws + OFF_PJ); const float2* tab = (const float2*)(p->ws + OFF_TABA);
  const float* qg = p->in[IN_GA_QG] + j * 128; const float* kg = p->in[IN_GA_KG] + j * 128;
  for (int wi = gw; wi < T * 10 / 4; wi += nw) {
    const int hv = wi * 4 + g4, row = hv / 10, h = hv - row * 10;
    bf16_t* ptr = pj + (size_t)row * 2560 + h * 128 + i * 8;
    const bf16x8 raw = *(const bf16x8*)ptr; float x[8]; float ss = 0;
#pragma unroll
    for (int e = 0; e < 8; ++e) { x[e] = bf2f(raw[e]); ss += x[e] * x[e]; }
    ss += __shfl_xor(ss, 1); ss += __shfl_xor(ss, 2); ss += __shfl_xor(ss, 4); ss += __shfl_xor(ss, 8);
    const float rstd = rsqrtf(ss * (1.f / 128.f) + EPS); const float* gn = (h < 8 ? qg : kg) + i * 8;
#pragma unroll
    for (int e = 0; e < 8; ++e) x[e] = x[e] * rstd * gn[e];
    const int b = row / TPB, jj = row - b * TPB; const bool lat = jj >= CTX; const int t = jj - CTX;
    const int axis = i >> 3, half = (i >> 2) & 1, pos = lat ? (axis ? (t & 63) : (t >> 6)) : 0;
    float y[8];
#pragma unroll
    for (int e = 0; e < 8; ++e) { const float xp = __shfl_xor(x[e], 4); const float2 cs = tab[pos * 32 + (i & 3) * 8 + e];
      y[e] = lat ? (half ? x[e] * cs.x + xp * cs.y : x[e] * cs.x - xp * cs.y) : x[e]; }
    *(bf16x8*)ptr = pack8(y);
  }
}
__device__ __forceinline__ void phase_mla_post1(KP p, const int tid) {
  const int lane = tid & 63, gw = blockIdx.x * 8 + (tid >> 6), nw = gridDim.x * 8;
  bf16_t* pj = (bf16_t*)(p->ws + OFF_PJ); const float2* tab = (const float2*)(p->ws + OFF_TABM); const float* qgp = p->in[IN_ML_QG]; const float* kvgp = p->in[IN_ML_KVG];
  for (int row = gw; row < T; row += nw) {
    bf16_t* pr = pj + (size_t)row * 2048;
    { const bf16x8 raw = *(const bf16x8*)(pr + lane * 8); float x[8]; float ss = 0;
#pragma unroll
      for (int e = 0; e < 8; ++e) { x[e] = bf2f(raw[e]); ss += x[e] * x[e]; }
      ss = wave_sum(ss); const float rstd = rsqrtf(ss * (1.f / 512.f) + EPS);
#pragma unroll
      for (int e = 0; e < 8; ++e) x[e] = x[e] * rstd * qgp[lane * 8 + e];
      *(bf16x8*)(pr + lane * 8) = pack8(x); }
    { const int l2 = lane & 31; const bf16x8 raw = *(const bf16x8*)(pr + 512 + l2 * 8); float x[8]; float ss = 0;
#pragma unroll
      for (int e = 0; e < 8; ++e) { x[e] = bf2f(raw[e]); ss += x[e] * x[e]; }
      ss = wave_sum(ss) * 0.5f; const float rstd = rsqrtf(ss * (1.f / 256.f) + EPS);
#pragma unroll
      for (int e = 0; e < 8; ++e) x[e] = x[e] * rstd * kvgp[l2 * 8 + e];
      if (lane < 32) *(bf16x8*)(pr + 512 + l2 * 8) = pack8(x); }
    { const int b = row / TPB, jj = row - b * TPB; const bool lat = jj >= CTX; const int t = jj - CTX;
      const int l3 = lane & 7; const bf16x8 raw = *(const bf16x8*)(pr + 768 + l3 * 8);
      const int axis = l3 >> 2, half = (l3 >> 1) & 1, pos = lat ? (axis ? (t & 63) : (t >> 6)) : 0; float y[8];
#pragma unroll
      for (int e = 0; e < 8; ++e) { const float x = bf2f(raw[e]); const float xp = __shfl_xor(x, 2); const float2 cs = tab[pos * 16 + (l3 & 1) * 8 + e];
        y[e] = half ? x * cs.x + xp * cs.y : x * cs.x - xp * cs.y; }
      if (lat && lane < 8) *(bf16x8*)(pr + 768 + l3 * 8) = pack8(y); }
  }
}
__device__ __forceinline__ void phase_mla_post2(KP p, const int tid) {
  const int lane = tid & 63, gw = blockIdx.x * 8 + (tid >> 6), nw = gridDim.x * 8, h = lane >> 3, i = lane & 7;
  bf16_t* qm = (bf16_t*)(p->ws + OFF_QM); const float2* tab = (const float2*)(p->ws + OFF_TABM);
  for (int lr = gw; lr < NB * SEQ; lr += nw) {
    const int b = lr >> 13, t = lr & 8191; const size_t row = (size_t)b * TPB + CTX + t;
    bf16_t* ptr = qm + row * 1536 + h * 192 + 128 + i * 8; const bf16x8 raw = *(const bf16x8*)ptr;
    const int axis = i >> 2, half = (i >> 1) & 1, pos = axis ? (t & 63) : (t >> 6); float y[8];
#pragma unroll
    for (int e = 0; e < 8; ++e) { const float x = bf2f(raw[e]); const float xp = __shfl_xor(x, 2); const float2 cs = tab[pos * 16 + (i & 1) * 8 + e];
      y[e] = half ? x * cs.x + xp * cs.y : x * cs.x - xp * cs.y; }
    *(bf16x8*)ptr = pack8(y);
  }
}
__device__ __forceinline__ void phase_att_gqa(KP p, int need_ctx, int dummy, char* lds, const int tid) {
  bf16_t* pj = (bf16_t*)(p->ws + OFF_PJ);
  const int nit = 1024 + (need_ctx ? 32 : 0);
  for (int it = blockIdx.x; it < nit; it += gridDim.x) {
    int b, h, row0, nt;
    if (it < 1024) { b = it >> 8; h = (it >> 5) & 7; row0 = b * TPB + CTX + (it & 31) * 256; nt = TPB / 64; }
    else { const int q = it - 1024; b = q >> 3; h = q & 7; row0 = b * TPB; nt = CTX / 64; }
    __syncthreads();
    attn_body<128, 128, 0, 2>(pj + (size_t)row0 * 2560 + h * 128, 2560, pj + 1024 + (h >> 2) * 128, nullptr, pj + 1280 + (h >> 2) * 128, 2560, b * TPB,
                           pj + (size_t)row0 * 2560 + 1536 + h * 128, 2560, nt, 0, lds, tid, dummy);
  }
}
__device__ __forceinline__ void phase_att_mla(KP p, int need_ctx, int dummy, char* lds, const int tid) {
  bf16_t* pj = (bf16_t*)(p->ws + OFF_PJ); bf16_t* kvm = pj + (size_t)T * 2048; bf16_t* qm = (bf16_t*)(p->ws + OFF_QM);
  const int nit = 1024 + (need_ctx ? 32 : 0);
  for (int it = blockIdx.x; it < nit; it += gridDim.x) {
    int b, h, row0, nt;
    if (it < 1024) { b = it >> 8; h = (it >> 5) & 7; row0 = b * TPB + CTX + (it & 31) * 256; nt = TPB / 64; }
    else { const int q = it - 1024; b = q >> 3; h = q & 7; row0 = b * TPB; nt = CTX / 64; }
    __syncthreads();
    attn_body_seq<192, 128>(qm + (size_t)row0 * 1536 + h * 192, 1536, kvm + h * 256, pj + 768, kvm + h * 256 + 128, 2048, b * TPB,
                            pj + (size_t)row0 * 2048 + 832 + h * 128, 2048, nt, lds, tid, dummy);
  }
}
__device__ __forceinline__ void phase_att_na(KP p, int need_ctx, int dummy, char* lds, const int tid) {
  bf16_t* pj = (bf16_t*)(p->ws + OFF_PJ);
  float* bias_l = (float*)(lds + 2 * 8192 + 2 * 8192 + 8 * 64 * 4);
  const int nit = 2048 + (need_ctx ? 64 : 0);
  for (int it = blockIdx.x; it < nit; it += gridDim.x) {
    __syncthreads();
    if (it < 2048) {
      const int b = it >> 9, h = (it >> 5) & 15, r0 = (it & 31) * 4, row0 = b * TPB + CTX + r0 * 64;
      if (tid < 15 * 32) { const int ro = tid >> 5, co = tid & 31; bias_l[tid] = co < 31 ? p->in[IN_NA_RPB][(h * 15 + ro) * 31 + co] * 8.f : 0.f; }
      attn_body<64, 64, 1, 2>(pj + (size_t)row0 * 4096 + h * 64, 4096, pj + 1024 + h * 64, nullptr, pj + 2048 + h * 64, 4096, b * TPB,
                           pj + (size_t)row0 * 4096 + 3072 + h * 64, 4096, 16, r0, lds, tid, dummy);
    } else {
      const int q = it - 2048, b = q >> 4, h = q & 15, row0 = b * TPB;
      attn_body<64, 64, 0, 2>(pj + (size_t)row0 * 4096 + h * 64, 4096, pj + 1024 + h * 64, nullptr, pj + 2048 + h * 64, 4096, b * TPB,
                           pj + (size_t)row0 * 4096 + 3072 + h * 64, 4096, 4, 0, lds, tid, dummy);
    }
  }
}

#define XB_TMO      128
#define XB_XCNT(j)  (256  + 64 * (j))
#define XB_XSUB(j)  (1280 + 64 * (j))
#define XB_XGEN(j)  (2304 + 64 * (j))
#define XB_TOP      3328
#define XB_TOPGEN   3392
#define XCD_BAR_WORDS 3456
#define XB_SPIN_CAP (1u << 18)
__device__ __forceinline__ unsigned xb_ld(unsigned* p)              { return __hip_atomic_load(p, __ATOMIC_RELAXED, __HIP_MEMORY_SCOPE_AGENT); }
__device__ __forceinline__ unsigned xb_add(unsigned* p, unsigned v) { return __hip_atomic_fetch_add(p, v, __ATOMIC_RELAXED, __HIP_MEMORY_SCOPE_AGENT); }
__device__ __forceinline__ unsigned xb_xcc_id() { return (unsigned)__builtin_amdgcn_s_getreg((3 << 11) | 20) & 0xFu; }
#define XB_SPIN(cond, bar) do { unsigned _sp = 0; while (cond) { __builtin_amdgcn_s_sleep(1); \
    if ((++_sp & 255u) == 0u) { if (xb_ld(&(bar)[XB_TMO])) break; if (_sp > XB_SPIN_CAP) { atomicAdd(&(bar)[XB_TMO], 1u); break; } } } } while (0)
struct XcdBarrier { unsigned* bar; unsigned x; volatile LAS unsigned* st; };
__device__ __forceinline__ XcdBarrier xcd_barrier_post(unsigned* bar, volatile LAS unsigned* st) {
    XcdBarrier b; b.bar = bar; b.x = xb_xcc_id(); b.st = st;
    if (threadIdx.x == 0) (void)xb_add(&bar[XB_XCNT(b.x)], 1u);
    return b;
}
__device__ __forceinline__ void xcd_barrier_complete(unsigned* bar, unsigned x, unsigned& nloc, unsigned& nx) {
    const unsigned G = gridDim.x * gridDim.y * gridDim.z;
    unsigned sum, cnt, mine, sp = 0u;
    for (;;) {
        sum = 0u; cnt = 0u; mine = 0u;
#pragma unroll
        for (unsigned j = 0; j < 16; ++j) { const unsigned c = xb_ld(&bar[XB_XCNT(j)]); sum += c; cnt += (c > 0u) ? 1u : 0u; mine = (j == x) ? c : mine; }
        if (sum == G) break;
        __builtin_amdgcn_s_sleep(1);
        if ((++sp & 255u) == 0u) { if (xb_ld(&bar[XB_TMO])) break; if (sp > XB_SPIN_CAP) { atomicAdd(&bar[XB_TMO], 1u); break; } }
    }
    nloc = mine > 0u ? mine : 1u; nx = cnt > 0u ? cnt : 1u;
}
__device__ __forceinline__ void xcd_barrier(const XcdBarrier& b) {
    asm volatile("s_waitcnt vmcnt(0)" ::: "memory");
    __syncthreads();
    if (threadIdx.x == 0) {
        unsigned* bar = b.bar;
        __builtin_amdgcn_s_waitcnt(0);
        unsigned nloc = b.st[0], nx = b.st[1];
        if (nloc == 0u) { xcd_barrier_complete(bar, b.x, nloc, nx); b.st[0] = nloc; b.st[1] = nx; }
        const unsigned old = xb_add(&bar[XB_XSUB(b.x)], 1u);
        const unsigned gen = old / nloc;
        if (old + 1u == (gen + 1u) * nloc) {
            __builtin_amdgcn_fence(__ATOMIC_RELEASE, "agent");
            asm volatile("s_waitcnt vmcnt(0)" ::: "memory");
            const unsigned og = xb_add(&bar[XB_TOP], 1u);
            const unsigned tg = og / nx;
            if (og + 1u == (tg + 1u) * nx) xb_add(&bar[XB_TOPGEN], 1u);
            else XB_SPIN(xb_ld(&bar[XB_TOPGEN]) == tg, bar);
            __builtin_amdgcn_fence(__ATOMIC_ACQUIRE, "agent");
            xb_add(&bar[XB_XGEN(b.x)], 1u);
            asm volatile("s_waitcnt vmcnt(0)" ::: "memory");
        } else {
            XB_SPIN(xb_ld(&bar[XB_XGEN(b.x)]) == gen, bar);
            __builtin_amdgcn_fence(__ATOMIC_ACQUIRE, "agent");
            asm volatile("s_waitcnt vmcnt(0)" ::: "memory");
        }
    }
    __syncthreads();
}

__global__ void __launch_bounds__(NTHREADS, 2) fwd_megakernel(const Params p_unused) {
  extern __shared__ __attribute__((aligned(16))) unsigned char shm[];
  cg::grid_group grid = cg::this_grid();
  char* lds = (char*)shm;
  __shared__ uint4 xb_words;
  if (threadIdx.x == 0) xb_words = make_uint4(0u, 0u, 0u, 0u);
  __syncthreads();
  XcdBarrier xb;
  { KP p0 = (KP)__builtin_amdgcn_kernarg_segment_ptr(); xb = xcd_barrier_post((unsigned*)(p0->ws + OFF_BAR), (volatile LAS unsigned*)&xb_words); }
#ifndef PHM
#define PHM 0xffff
#endif
#define PH(k) if constexpr (((PHM) >> (k)) & 1)
  for (int oi = 0; oi < PROG.n; ++oi) {
    const Op op = PROG.ops[oi];
    int tid = threadIdx.x; asm volatile("" : "+v"(tid));
    KP p = (KP)__builtin_amdgcn_kernarg_segment_ptr(); asm volatile("" : "+s"(p));
    char* ws = p->ws;
    switch (op.type) {
      case OP_PRE: PH(0) phase_pre(p, lds, tid); break;
      case OP_MODFIN: PH(1) phase_modfin(p, tid); break;
      case OP_NORM: PH(2) phase_norm(p, op.i0, tid); break;
      case OP_GEMM_BF: case OP_GEMM_BF_NOSYNC: PH(3) {
        pg8::Gemm g{(const bf16_t*)(ws + op.a), (const bf16_t*)(ws + op.b), T, op.i0, op.i1, op.i2};
        pg8::StaticOrder S; S.init(T, op.i0, (int)gridDim.x, (int)blockIdx.x);
        pg8::EpiBf16 E{(bf16_t*)(ws + op.o), op.i0};
        pg8::gemm_phase<pg8::EpiBf16>((LAS unsigned char*)shm, g, S, E, tid);
      } break;
      case OP_GEMM_RES: PH(4) {
        pg8::Gemm g{(const bf16_t*)(ws + op.a), (const bf16_t*)(ws + op.b), T, DM, DM, op.i2};
        pg8::StaticOrder S; S.init(T, DM, (int)gridDim.x, (int)blockIdx.x);
        float* xsc = (float*)(ws + OFF_XSC); float* outp = p->out;
        pg8::EpiResid E{op.i0 == 0 ? p->in[IN_X] : (const float*)outp, op.i0 == 0 ? p->in[IN_CTX] : (const float*)xsc, outp, xsc, (const float*)(ws + OFF_MOD) + (size_t)op.i0 * 5 * 3072};
        pg8::gemm_phase<pg8::EpiResid>((LAS unsigned char*)shm, g, S, E, tid);
      } break;
      case OP_GQA_POST: PH(5) phase_gqa_post(p, op.i0, tid); break;
      case OP_ATT_GQA: PH(6) phase_att_gqa(p, op.i0, op.i1, lds, tid); break;
      case OP_ATT_NA: PH(7) phase_att_na(p, op.i0, op.i1, lds, tid); break;
      case OP_MLA_POST1: PH(8) phase_mla_post1(p, tid); break;
      case OP_MLA_POST2: PH(9) phase_mla_post2(p, tid); break;
      case OP_ATT_MLA: PH(10) phase_att_mla(p, op.i0, op.i1, lds, tid); break;
      case OP_FINAL: PH(11) phase_final(p, tid); break;
      default: break;
    }
    if (op.type == OP_GEMM_BF_NOSYNC) __syncthreads(); else if (oi == 0) grid.sync(); else xcd_barrier(xb);
  }
}

extern "C" void kernel_launch(void* const* d_in, const int* in_sizes, int n_in, void* d_out, int out_size, void* d_ws, size_t ws_size, hipStream_t stream) {
  static int grid_blocks = 0;
  if (!grid_blocks) {
    if (ws_size < WS_END) { fprintf(stderr, "kernel_launch: workspace too small: %zu < %zu\n", ws_size, (size_t)WS_END); return; }
    if (hipFuncSetAttribute((const void*)fwd_megakernel, hipFuncAttributeMaxDynamicSharedMemorySize, LDS_BYTES) != hipSuccess) { fprintf(stderr, "kernel_launch: hipFuncSetAttribute failed\n"); return; }
    int dev = 0, cus = 0, per_cu = 0;
    hipGetDevice(&dev);
    hipDeviceGetAttribute(&cus, hipDeviceAttributeMultiprocessorCount, dev);
    hipOccupancyMaxActiveBlocksPerMultiprocessor(&per_cu, fwd_megakernel, NTHREADS, LDS_BYTES);
    if (per_cu < 1) { fprintf(stderr, "kernel_launch: occupancy query returned %d\n", per_cu); return; }
    grid_blocks = cus;
  }
  Params p; memset(&p, 0, sizeof(p));
  if (n_in != N_IN) { fprintf(stderr, "kernel_launch: expected %d inputs, got %d\n", (int)N_IN, n_in); return; }
  for (int i = 0; i < N_IN; ++i) p.in[i] = (const float*)d_in[i];
  p.out = (float*)d_out; p.ws = (char*)d_ws;
  hipMemsetAsync((char*)d_ws + OFF_BAR, 0, XCD_BAR_WORDS * 4, stream);
  void* args[] = {&p};
  hipError_t e = hipLaunchCooperativeKernel((const void*)fwd_megakernel, dim3(grid_blocks), dim3(NTHREADS), args, LDS_BYTES, stream);
  if (e != hipSuccess) fprintf(stderr, "kernel_launch: cooperative launch failed: %s (grid %d)\n", hipGetErrorString(e), grid_blocks);
}
```

```cpp
#include <hip/hip_runtime.h>
#include <hip/hip_cooperative_groups.h>
#include <cstdio>
#include <cstring>
namespace cg = cooperative_groups;

#define LAS __attribute__((address_space(3)))
typedef unsigned short bf16_t;
typedef short bf16x8 __attribute__((ext_vector_type(8)));
typedef short s16x4 __attribute__((ext_vector_type(4)));
typedef float f32x4 __attribute__((ext_vector_type(4)));
typedef float f32x16 __attribute__((ext_vector_type(16)));
typedef unsigned u32x4 __attribute__((ext_vector_type(4)));
typedef unsigned u32x2 __attribute__((ext_vector_type(2)));

constexpr int NB = 4, SEQ = 8192, CTX = 256, DM = 1024, TPB = SEQ + CTX, T = NB * TPB;
constexpr int DEPTH = 4;
constexpr float EPS = 1e-6f;
constexpr int NTHREADS = 512;
constexpr int LDS_BYTES = 131072;

constexpr size_t OFF_XSC = 0;
constexpr size_t OFF_HB = OFF_XSC + (size_t)NB * CTX * DM * 4;
constexpr size_t OFF_PJ = OFF_HB + (size_t)T * DM * 2;
constexpr size_t OFF_QM = OFF_PJ + (size_t)T * 4096 * 2;
constexpr size_t OFF_W = OFF_QM + (size_t)T * 1536 * 2;
constexpr size_t W_GA_IN = 0, W_GA_OUT = W_GA_IN + 2ull * 2560 * 1024, W_NA_IN = W_GA_OUT + 2ull * 1024 * 1024, W_NA_OUT = W_NA_IN + 4096ull * 1024,
                 W_ML_IN = W_NA_OUT + 1024ull * 1024, W_ML_UQ = W_ML_IN + 2048ull * 1024, W_ML_UKV = W_ML_UQ + 1536ull * 512, W_ML_OUT = W_ML_UKV + 2048ull * 256,
                 W_END = W_ML_OUT + 1024ull * 1024;
constexpr size_t OFF_MODP = OFF_W + W_END * 2;
constexpr size_t OFF_MOD = OFF_MODP + 16ull * 4 * 5 * 3072 * 4;
constexpr size_t OFF_TABA = OFF_MOD + 4ull * 5 * 3072 * 4;
constexpr size_t OFF_TABM = OFF_TABA + 128ull * 32 * 8;
constexpr size_t OFF_BAR = OFF_TABM + 128ull * 16 * 8;
constexpr size_t WS_END = OFF_BAR + 3456ull * 4;

struct Op { int type, i0, i1, i2; unsigned long long a, b, o; };
enum { OP_PRE = 0, OP_MODFIN, OP_NORM, OP_GEMM_BF, OP_GEMM_RES, OP_GQA_POST, OP_ATT_GQA, OP_ATT_NA, OP_MLA_POST1, OP_MLA_POST2, OP_ATT_MLA, OP_FINAL, OP_GEMM_BF_NOSYNC };
enum { IN_X = 0, IN_C, IN_CTX, IN_CCTX, IN_MODW, IN_MODB, IN_NORMG, IN_FINALG, IN_GA_WIN, IN_GA_QG, IN_GA_KG, IN_GA_WOUT, IN_NA_WIN, IN_NA_RPB, IN_NA_WOUT,
       IN_ML_WIN, IN_ML_QG, IN_ML_KVG, IN_ML_WUQ, IN_ML_WUKV, IN_ML_WOUT, N_IN };
struct Params { const float* in[N_IN]; float* out; char* ws; };
#define KAS __attribute__((address_space(4)))
typedef const KAS Params* KP;

#ifndef PROBE_DUP
#define PROBE_DUP 0
#endif
constexpr int MAXOPS = 64;
struct Prog { Op ops[MAXOPS]; int n; };
constexpr void prog_add1(Prog& P, int type, int i0, int i1, int i2, size_t a, size_t b, size_t o) { Op& q = P.ops[P.n++]; q.type = type; q.i0 = i0; q.i1 = i1; q.i2 = i2; q.a = a; q.b = b; q.o = o; }
constexpr void prog_add(Prog& P, int type, int i0, int i1, int i2, size_t a, size_t b, size_t o) {
  const bool gemm = type == OP_GEMM_BF || type == OP_GEMM_BF_NOSYNC;
  if ((PROBE_DUP & 1) && gemm) prog_add1(P, OP_GEMM_BF, i0, i1, i2, a, b, o);
  if ((PROBE_DUP & 2) && type == OP_ATT_GQA) prog_add1(P, type, i0, 1, i2, a, b, o);
  if ((PROBE_DUP & 4) && type == OP_ATT_MLA) prog_add1(P, type, i0, 1, i2, a, b, o);
  if ((PROBE_DUP & 8) && type == OP_ATT_NA) prog_add1(P, type, i0, 1, i2, a, b, o);
  if ((PROBE_DUP & 16) && type == OP_NORM) prog_add1(P, type, i0, i1, i2, a, b, o);
  if ((PROBE_DUP & 32) && type == OP_GEMM_RES && i0 == 0) prog_add1(P, type, i0, i1, i2, a, b, o);
  if ((PROBE_DUP & 128) && type == OP_GQA_POST) prog_add1(P, type, i0, 1, i2, a, b, o);
  if ((PROBE_DUP & 256) && (type == OP_MLA_POST1 || type == OP_FINAL)) prog_add1(P, type, i0, 1, i2, a, b, o);
  if ((PROBE_DUP & 64) && type == OP_PRE) prog_add1(P, type, i0, i1, i2, a, b, o);
  prog_add1(P, type, i0, i1, i2, a, b, o);
}
constexpr Prog make_prog() {
  Prog P{}; P.n = 0;
  const size_t W = OFF_W, hb = OFF_HB, pj = OFF_PJ, qm = OFF_QM;
  prog_add(P, OP_PRE, 0, 0, 0, 0, 0, 0);
  prog_add(P, OP_MODFIN, 0, 0, 0, 0, 0, 0);
  for (int i = 0; i < DEPTH; ++i) {
    const int kind = i % 3, j = i / 3, need_ctx = i < DEPTH - 1;
    prog_add(P, OP_NORM, i, 0, 0, 0, 0, 0);
    if (kind == 0) {
      prog_add(P, OP_GEMM_BF, 2560, 1024, 1024, hb, W + 2 * (W_GA_IN + (size_t)j * 2560 * 1024), pj);
      prog_add(P, OP_GQA_POST, j, 0, 0, 0, 0, 0);
      prog_add(P, OP_ATT_GQA, need_ctx, 0, j, 0, 0, 0);
      prog_add(P, OP_GEMM_RES, i, 0, 2560, pj + 2 * 1536, W + 2 * (W_GA_OUT + (size_t)j * 1024 * 1024), 0);
    } else if (kind == 1) {
      prog_add(P, OP_GEMM_BF, 4096, 1024, 1024, hb, W + 2 * W_NA_IN, pj);
      prog_add(P, OP_ATT_NA, need_ctx, 0, 0, 0, 0, 0);
      prog_add(P, OP_GEMM_RES, i, 0, 4096, pj + 2 * 3072, W + 2 * W_NA_OUT, 0);
    } else {
      prog_add(P, OP_GEMM_BF, 2048, 1024, 1024, hb, W + 2 * W_ML_IN, pj);
      prog_add(P, OP_MLA_POST1, 0, 0, 0, 0, 0, 0);
      prog_add(P, OP_GEMM_BF_NOSYNC, 1536, 512, 2048, pj, W + 2 * W_ML_UQ, qm);
      prog_add(P, OP_GEMM_BF, 2048, 256, 2048, pj + 2 * 512, W + 2 * W_ML_UKV, pj + (size_t)T * 2048 * 2);
      prog_add(P, OP_ATT_MLA, need_ctx, 0, 0, 0, 0, 0);
      prog_add(P, OP_GEMM_RES, i, 0, 2048, pj + 2 * 832, W + 2 * W_ML_OUT, 0);
    }
  }
  prog_add(P, OP_FINAL, 0, 0, 0, 0, 0, 0);
  return P;
}
__device__ const Prog PROG = make_prog();

struct WDesc { int in_idx; int K, N, Npad, tile0; unsigned src_off, dst_off; int pad_; };
constexpr int NWD = 10;
struct WTab { WDesc d[NWD]; int ntiles; };
constexpr WTab make_wtab() {
  WTab t{}; int nt = 0, wi = 0;
  auto addw = [&](int in_idx, size_t src_off, size_t dst, int K, int N, int Npad) { WDesc& w = t.d[wi++]; w.in_idx = in_idx; w.src_off = (unsigned)src_off; w.dst_off = (unsigned)dst; w.K = K; w.N = N; w.Npad = Npad; w.tile0 = nt; w.pad_ = 0; nt += (K / 64) * (Npad / 64); };
  addw(IN_GA_WIN, 0, W_GA_IN, 1024, 2560, 2560); addw(IN_GA_WIN, 1024ull * 2560, W_GA_IN + 2560ull * 1024, 1024, 2560, 2560);
  addw(IN_GA_WOUT, 0, W_GA_OUT, 1024, 1024, 1024); addw(IN_GA_WOUT, 1024ull * 1024, W_GA_OUT + 1024ull * 1024, 1024, 1024, 1024);
  addw(IN_NA_WIN, 0, W_NA_IN, 1024, 4096, 4096); addw(IN_NA_WOUT, 0, W_NA_OUT, 1024, 1024, 1024);
  addw(IN_ML_WIN, 0, W_ML_IN, 1024, 1856, 2048); addw(IN_ML_WUQ, 0, W_ML_UQ, 512, 1536, 1536); addw(IN_ML_WUKV, 0, W_ML_UKV, 256, 2048, 2048); addw(IN_ML_WOUT, 0, W_ML_OUT, 1024, 1024, 1024);
  t.ntiles = nt; return t;
}
__device__ const WTab WTAB = make_wtab();

__device__ const float INV_A[32] = {1.000000000e+00f, 7.498942614e-01f, 5.623413324e-01f, 4.216965139e-01f, 3.162277639e-01f, 2.371373773e-01f, 1.778279394e-01f, 1.333521307e-01f, 1.000000015e-01f, 7.498941571e-02f, 5.623413250e-02f, 4.216965288e-02f, 3.162277490e-02f, 2.371373773e-02f, 1.778279431e-02f, 1.333521493e-02f, 9.999999776e-03f, 7.498941850e-03f, 5.623413250e-03f, 4.216964822e-03f, 3.162277630e-03f, 2.371373586e-03f, 1.778279431e-03f, 1.333521446e-03f, 1.000000047e-03f, 7.498942432e-04f, 5.623413017e-04f, 4.216965172e-04f, 3.162277571e-04f, 2.371373703e-04f, 1.778279402e-04f, 1.333521504e-04f};
__device__ const float INV_M[16] = {1.000000000e+00f, 5.623413324e-01f, 3.162277639e-01f, 1.778279394e-01f, 1.000000015e-01f, 5.623413250e-02f, 3.162277490e-02f, 1.778279431e-02f, 9.999999776e-03f, 5.623413250e-03f, 3.162277630e-03f, 1.778279431e-03f, 1.000000047e-03f, 5.623413017e-04f, 3.162277571e-04f, 1.778279402e-04f};

__device__ __forceinline__ float bf2f(short b) { return __uint_as_float(((unsigned)(unsigned short)b) << 16); }
__device__ __forceinline__ unsigned cvtpk(float lo, float hi) { unsigned r; asm volatile("v_cvt_pk_bf16_f32 %0, %1, %2" : "=v"(r) : "v"(lo), "v"(hi)); return r; }
__device__ __forceinline__ bf16x8 pack8(const float* v) { u32x4 w = {cvtpk(v[0], v[1]), cvtpk(v[2], v[3]), cvtpk(v[4], v[5]), cvtpk(v[6], v[7])}; return *reinterpret_cast<bf16x8*>(&w); }
__device__ __forceinline__ float silu_f(float g) { return g * __builtin_amdgcn_rcpf(1.f + __builtin_amdgcn_exp2f(-g * 1.4426950408889634f)); }
__device__ __forceinline__ float wave_sum(float v) {
#pragma unroll
  for (int o = 32; o >= 1; o >>= 1) v += __shfl_xor(v, o);
  return v;
}
__device__ __forceinline__ const float* res_src(KP p, int layer, int row) {
  const int b = row / TPB, j = row - b * TPB;
  if (j < CTX) return (layer == 0 ? p->in[IN_CTX] : (const float*)(p->ws + OFF_XSC)) + ((size_t)b * CTX + j) * DM;
  return (layer == 0 ? p->in[IN_X] : (const float*)p->out) + ((size_t)b * SEQ + (j - CTX)) * DM;
}

namespace pg8 {
constexpr int BM = 256, BK = 64, HALF = 128, HTB = HALF * BK * 2, STAGE_BYTES = 8 * HTB, NXCD = 8, WGM = 8;
__device__ __forceinline__ int lds_byte(int r, int c) { const int st = (r >> 4) * 2 + (c >> 5), rr = r & 15, cc = c & 31, ob = rr * 64 + cc * 2; return st * 1024 + (ob ^ (((ob >> 9) & 1) << 5)); }
__device__ __forceinline__ void stage_rc(int b, int& R, int& C) { const int st = b / 1024, sb = b % 1024, swz = sb ^ (((sb >> 9) & 1) << 5); R = (st >> 1) * 16 + swz / 64; C = (st & 1) * 32 + (swz % 64) / 2; }
__device__ __forceinline__ int perm32(int rho) { const int n = rho >> 4, i = rho & 15; return 8 * (i >> 2) + 4 * n + (i & 3); }
struct Unit { int pm, pn; };
struct Gemm { const bf16_t* A; const bf16_t* Bt; int M, N, K, lda; };
struct StaticOrder {
  int nM, nN, nwg, G, c;
  __device__ void init(int M, int N, int G_, int c_) { nM = M / BM; nN = N / BM; nwg = nM * nN; G = G_; c = c_; }
  __device__ bool next(int i, Unit& u) const {
    const long L = (long)i * G + c; if (L >= nwg) return false;
    int wgid = (int)L; { const int q = nwg / NXCD, r = nwg % NXCD, xcd = wgid % NXCD, off = wgid / NXCD; wgid = (xcd < r ? xcd * (q + 1) : r * (q + 1) + (xcd - r) * q) + off; }
    const int nig = WGM * nN, gid = wgid / nig, fm = gid * WGM, gsz = (nM - fm) < WGM ? (nM - fm) : WGM;
    u.pm = fm + ((wgid % nig) % gsz); u.pn = (wgid % nig) / gsz; return true;
  }
};
struct EpiBf16 {
  static constexpr bool PERM = true;
  bf16_t* O; int ldc;
  __device__ __forceinline__ void operator()(const f32x4 (&acc)[2][2][4][2], const Unit& u, int wr, int wc, int fr, int fq) const {
    const int row0 = u.pm * BM + wr * 64 + fr, col0 = u.pn * BM + wc * 32 + 8 * fq;
#pragma unroll
    for (int ai = 0; ai < 2; ++ai)
#pragma unroll
      for (int m = 0; m < 4; ++m) { bf16_t* rowp = O + (size_t)(row0 + ai * HALF + m * 16) * ldc + col0;
#pragma unroll
        for (int bj = 0; bj < 2; ++bj) { const f32x4 v0 = acc[ai][bj][m][0], v1 = acc[ai][bj][m][1];
          u32x4 w; w.x = cvtpk(v0[0], v0[1]); w.y = cvtpk(v0[2], v0[3]); w.z = cvtpk(v1[0], v1[1]); w.w = cvtpk(v1[2], v1[3]);
          *(u32x4*)(rowp + bj * HALF) = w; } }
  }
};
struct EpiResid {
  static constexpr bool PERM = true;
  const float* res_lat; const float* res_ctx; float* out_lat; float* out_ctx; const float* mod;
  __device__ __forceinline__ void operator()(const f32x4 (&acc)[2][2][4][2], const Unit& u, int wr, int wc, int fr, int fq) const {
    const int b = u.pm / 33, lt = u.pm - b * 33;
    const float* rb; float* ob; const float* g;
    if (lt == 0) { rb = res_ctx + (size_t)b * CTX * DM; ob = out_ctx + (size_t)b * CTX * DM; g = mod + 4 * 3072 + 2048; }
    else { const size_t o = ((size_t)b * SEQ + (size_t)(lt - 1) * 256) * DM; rb = res_lat + o; ob = out_lat + o; g = mod + b * 3072 + 2048; }
    const int lr0 = wr * 64 + fr, col0 = u.pn * BM + wc * 32 + 8 * fq;
    f32x4 gv[2][2];
#pragma unroll
    for (int bj = 0; bj < 2; ++bj)
#pragma unroll
      for (int n = 0; n < 2; ++n) gv[bj][n] = *(const f32x4*)(g + col0 + bj * HALF + n * 4);
#pragma unroll
    for (int ai = 0; ai < 2; ++ai)
#pragma unroll
      for (int m = 0; m < 4; ++m) { const size_t ro = (size_t)(lr0 + ai * HALF + m * 16) * DM + col0;
#pragma unroll
        for (int bj = 0; bj < 2; ++bj)
#pragma unroll
          for (int n = 0; n < 2; ++n) { const f32x4 r = *(const f32x4*)(rb + ro + bj * HALF + n * 4);
            *(f32x4*)(ob + ro + bj * HALF + n * 4) = r + gv[bj][n] * acc[ai][bj][m][n]; } }
  }
};

template <class Epi>
__device__ __forceinline__ void gemm_phase(LAS unsigned char* lds, const Gemm g, const StaticOrder& S, const Epi& E, const int tid) {
  const int wid = __builtin_amdgcn_readfirstlane(tid >> 6), lane = tid & 63, wr = wid >> 2, wc = wid & 3, fr = lane & 15, fq = lane >> 4;
  const int K = g.K, nt = K / BK, lda = g.lda;
  unsigned voffA[2], voffB[2];
#pragma unroll
  for (int i = 0; i < 2; ++i) { int R, C; stage_rc(tid * 16 + i * 8192, R, C); const int Rb = Epi::PERM ? ((R & ~31) + perm32(R & 31)) : R;
    voffA[i] = (unsigned)(R * lda + C) * 2u; voffB[i] = (unsigned)(Rb * K + C) * 2u; }
  const size_t kstep = (size_t)(BK * 2);
  const size_t hstepA = (size_t)HALF * lda * 2, hstepB = (size_t)HALF * K * 2;
  const size_t tstepA = 2 * hstepA, tstepB = 2 * hstepB;
  const unsigned ldsw = (unsigned)wid * 1024u;
  const int aoff = lds_byte(wr * 64 + fr, fq * 8), boff = lds_byte(wc * 32 + fr, fq * 8);
#define PG8_SA(b, h) (((b) * 2 + (h)) * HTB)
#define PG8_SB(b, h) ((4 + (b) * 2 + (h)) * HTB)
#define PG8_STAGE(bufoff, gbase, voff) do { _Pragma("unroll") for (int _i = 0; _i < 2; ++_i) \
    __builtin_amdgcn_global_load_lds((const unsigned*)((const char*)(gbase) + (voff)[_i]), (LAS unsigned*)(lds + (bufoff) + ldsw + _i * 8192), 16, 0, 0); } while (0)
#define PG8_LDA(dst, b, h) do { _Pragma("unroll") for (int m = 0; m < 4; ++m) _Pragma("unroll") for (int k = 0; k < 2; ++k) dst[m][k] = *(const LAS bf16x8*)(lds + PG8_SA(b, h) + aoff + m * 2048 + k * 1024); } while (0)
#define PG8_LDB(dst, b, h) do { _Pragma("unroll") for (int n = 0; n < 2; ++n) _Pragma("unroll") for (int k = 0; k < 2; ++k) dst[n][k] = *(const LAS bf16x8*)(lds + PG8_SB(b, h) + boff + n * 2048 + k * 1024); } while (0)
#define PG8_MMA(ai, bj, At, Bt) do { __builtin_amdgcn_s_setprio(1); _Pragma("unroll") for (int m = 0; m < 4; ++m) _Pragma("unroll") for (int n = 0; n < 2; ++n) _Pragma("unroll") for (int k = 0; k < 2; ++k) \
    acc[ai][bj][m][n] = __builtin_amdgcn_mfma_f32_16x16x32_bf16(Bt[n][k], At[m][k], acc[ai][bj][m][n], 0, 0, 0); __builtin_amdgcn_s_setprio(0); } while (0)
#define PG8_WAIT_V(n) asm volatile("s_waitcnt vmcnt(" #n ")" ::: "memory")
#define PG8_WAIT_L(n) asm volatile("s_waitcnt lgkmcnt(" #n ")" ::: "memory")
#define PG8_BAR __builtin_amdgcn_s_barrier()
#define PG8_SCHED __builtin_amdgcn_sched_barrier(0)
  Unit cur, nxt; int ui = 0;
  if (!S.next(0, cur)) return;
  f32x4 acc[2][2][4][2];
#pragma unroll
  for (int a = 0; a < 2; ++a)
#pragma unroll
    for (int b = 0; b < 2; ++b)
#pragma unroll
      for (int m = 0; m < 4; ++m)
#pragma unroll
        for (int n = 0; n < 2; ++n) acc[a][b][m][n] = (f32x4){0.f, 0.f, 0.f, 0.f};
  bf16x8 At[4][2], B0[2][2], B1[2][2];
  const char* cA = (const char*)g.A + (size_t)cur.pm * tstepA; const char* cB = (const char*)g.Bt + (size_t)cur.pn * tstepB;
  PG8_STAGE(PG8_SB(0, 0), cB, voffB); PG8_STAGE(PG8_SA(0, 0), cA, voffA); PG8_STAGE(PG8_SB(0, 1), cB + hstepB, voffB); PG8_STAGE(PG8_SA(0, 1), cA + hstepA, voffA);
  if (wr == 1) PG8_BAR;
  PG8_WAIT_V(4); PG8_BAR;
  PG8_STAGE(PG8_SB(1, 0), cB + kstep, voffB); PG8_STAGE(PG8_SA(1, 0), cA + kstep, voffA); PG8_STAGE(PG8_SB(1, 1), cB + hstepB + kstep, voffB);
  PG8_WAIT_V(6); PG8_BAR;
  for (;;) {
    const bool has_next = S.next(ui + 1, nxt);
    const char* nA = has_next ? (const char*)g.A + (size_t)nxt.pm * tstepA : cA; const char* nB = has_next ? (const char*)g.Bt + (size_t)nxt.pn * tstepB : cB;
    for (int t = 0; t < nt; t += 2) {
      const bool last = (t == nt - 2);
      const char* a1 = cA + (size_t)(t + 1) * kstep;
      const char* a2 = last ? nA : cA + (size_t)(t + 2) * kstep; const char* b2 = last ? nB : cB + (size_t)(t + 2) * kstep;
      const char* a3 = a2 + kstep; const char* b3 = b2 + kstep;
      PG8_LDB(B0, 0, 0); PG8_SCHED; PG8_LDA(At, 0, 0); PG8_STAGE(PG8_SA(1, 1), a1 + hstepA, voffA);
      PG8_WAIT_L(8); PG8_BAR; PG8_WAIT_L(0); PG8_MMA(0, 0, At, B0); PG8_BAR; PG8_SCHED;
      PG8_LDB(B1, 0, 1); PG8_STAGE(PG8_SB(0, 0), b2, voffB);
      PG8_BAR; PG8_WAIT_L(0); PG8_MMA(0, 1, At, B1); PG8_BAR;
      PG8_LDA(At, 0, 1); PG8_STAGE(PG8_SA(0, 0), a2, voffA);
      PG8_BAR; PG8_WAIT_L(0); PG8_MMA(1, 0, At, B0); PG8_BAR; PG8_SCHED;
      PG8_STAGE(PG8_SB(0, 1), b2 + hstepB, voffB);
      PG8_WAIT_V(6); PG8_BAR; PG8_MMA(1, 1, At, B1); PG8_BAR;
      PG8_LDB(B0, 1, 0); PG8_SCHED; PG8_LDA(At, 1, 0); PG8_STAGE(PG8_SA(0, 1), a2 + hstepA, voffA);
      PG8_WAIT_L(8); PG8_BAR; PG8_WAIT_L(0); PG8_MMA(0, 0, At, B0); PG8_BAR; PG8_SCHED;
      PG8_LDB(B1, 1, 1); PG8_STAGE(PG8_SB(1, 0), b3, voffB);
      PG8_BAR; PG8_WAIT_L(0); PG8_MMA(0, 1, At, B1); PG8_BAR;
      PG8_LDA(At, 1, 1); PG8_STAGE(PG8_SA(1, 0), a3, voffA);
      PG8_BAR; PG8_WAIT_L(0); PG8_MMA(1, 0, At, B0); PG8_BAR; PG8_SCHED;
      PG8_STAGE(PG8_SB(1, 1), b3 + hstepB, voffB);
      PG8_WAIT_V(6); PG8_BAR; PG8_MMA(1, 1, At, B1); PG8_BAR;
    }
    E(acc, cur, wr, wc, fr, fq);
    if (!has_next) break;
#pragma unroll
    for (int a = 0; a < 2; ++a)
#pragma unroll
      for (int b = 0; b < 2; ++b)
#pragma unroll
        for (int m = 0; m < 4; ++m)
#pragma unroll
          for (int n = 0; n < 2; ++n) acc[a][b][m][n] = (f32x4){0.f, 0.f, 0.f, 0.f};
    cur = nxt; cA = nA; cB = nB; ++ui;
  }
  PG8_WAIT_V(0);
  if (wr == 0) PG8_BAR;
  PG8_BAR;
#undef PG8_SA
#undef PG8_SB
#undef PG8_STAGE
#undef PG8_LDA
#undef PG8_LDB
#undef PG8_MMA
#undef PG8_WAIT_V
#undef PG8_WAIT_L
#undef PG8_BAR
#undef PG8_SCHED
}
}

#define SBAR() __builtin_amdgcn_sched_barrier(0)
__device__ __forceinline__ int crow(int r, int hi) { return (r & 3) + 8 * (r >> 2) + 4 * hi; }
constexpr float THR = 8.f;
template <int DQK> struct ScaleOf;
template <> struct ScaleOf<64> { static constexpr float v = 0.125f; };
template <> struct ScaleOf<128> { static constexpr float v = 0.088388347648318440f; };
template <> struct ScaleOf<192> { static constexpr float v = 0.072168783648703220f; };

template <int DQK>
__device__ __forceinline__ void partialSM(f32x16& p0, f32x16& p1, float& m_reg, float& mn, float& alpha) {
  constexpr float SCALE = ScaleOf<DQK>::v, C = SCALE * 1.4426950408889634f;
  float pmax = p0[0];
#pragma unroll
  for (int r = 1; r < 16; ++r) pmax = fmaxf(pmax, p0[r]);
#pragma unroll
  for (int r = 0; r < 16; ++r) pmax = fmaxf(pmax, p1[r]);
  { auto rr = __builtin_amdgcn_permlane32_swap(__float_as_uint(pmax), __float_as_uint(pmax), false, false);
    pmax = fmaxf(__uint_as_float(rr[0]), __uint_as_float(rr[1])); }
  if (__builtin_expect(__all(pmax - m_reg <= THR / SCALE), 1)) { mn = m_reg; alpha = 1.f; }
  else { mn = fmaxf(m_reg, pmax); alpha = __builtin_amdgcn_exp2f((m_reg - mn) * C); m_reg = mn; }
  const float mnC = -mn * C;
#pragma unroll
  for (int r = 0; r < 16; ++r) p0[r] = fmaf(p0[r], C, mnC);
#pragma unroll
  for (int r = 0; r < 16; ++r) p1[r] = fmaf(p1[r], C, mnC);
#pragma unroll
  for (int r = 0; r < 16; ++r) p0[r] = __builtin_amdgcn_exp2f(p0[r]);
}
__device__ __forceinline__ void finishSM(f32x16& p0, f32x16& p1, float alpha, float& l_reg, bf16x8& pa0, bf16x8& pa1, bf16x8& pa2, bf16x8& pa3) {
#pragma unroll
  for (int r = 0; r < 16; ++r) p1[r] = __builtin_amdgcn_exp2f(p1[r]);
  float ps = 0;
#pragma unroll
  for (int r = 0; r < 16; ++r) ps += p0[r];
#pragma unroll
  for (int r = 0; r < 16; ++r) ps += p1[r];
  { auto rr = __builtin_amdgcn_permlane32_swap(__float_as_uint(ps), __float_as_uint(ps), false, false);
    ps = __uint_as_float(rr[0]) + __uint_as_float(rr[1]); }
  l_reg = l_reg * alpha + ps;
#define PK4(P, BASE, OUT) do { unsigned a0 = cvtpk(P[BASE + 0], P[BASE + 1]), a1 = cvtpk(P[BASE + 2], P[BASE + 3]);   \
    unsigned b0 = cvtpk(P[BASE + 4], P[BASE + 5]), b1 = cvtpk(P[BASE + 6], P[BASE + 7]);                              \
    auto r0 = __builtin_amdgcn_permlane32_swap(a0, b0, false, false); auto r1 = __builtin_amdgcn_permlane32_swap(a1, b1, false, false); \
    u32x4 w = {r0[0], r1[0], r0[1], r1[1]}; OUT = *reinterpret_cast<bf16x8*>(&w); } while (0)
  PK4(p0, 0, pa0); PK4(p0, 8, pa1); PK4(p1, 0, pa2); PK4(p1, 8, pa3);
#undef PK4
}
template <int DQK>
__device__ __forceinline__ void qkt(f32x16& p0, f32x16& p1, const char* Ks, const bf16x8* qr, int r32, int hi) {
  constexpr int RB = DQK * 2;
  p0 = f32x16{}; p1 = f32x16{};
#pragma unroll
  for (int d0 = 0; d0 < DQK / 16; ++d0) { const int cb = (d0 * 16 + hi * 8) * 2;
    bf16x8 b0 = *reinterpret_cast<const bf16x8*>(Ks + r32 * RB + (cb ^ ((r32 & 7) << 4)));
    bf16x8 b1 = *reinterpret_cast<const bf16x8*>(Ks + (32 + r32) * RB + (cb ^ ((r32 & 7) << 4)));
    p0 = __builtin_amdgcn_mfma_f32_32x32x16_bf16(b0, qr[d0], p0, 0, 0, 0);
    p1 = __builtin_amdgcn_mfma_f32_32x32x16_bf16(b1, qr[d0], p1, 0, 0, 0); }
}
template <int NCB> __device__ __forceinline__ int v_st(int k, int c) { const int kk = (k & ~0xC) | ((k & 4) << 1) | ((k & 8) >> 1); return ((kk >> 3) * NCB + (c >> 5)) * 512 + ((kk & 7) * 32 + (c & 31)) * 2; }
__device__ __forceinline__ int v_rd_base(int lane) { return ((lane & 3) << 3) | (((lane >> 2) & 3) << 6) | (((lane >> 4) & 1) << 5) | (((lane >> 5) & 1) << 8); }
template <int OFF> __device__ __forceinline__ s16x4 tr_read(int vb) {
  s16x4 r; asm volatile("ds_read_b64_tr_b16 %0, %1 offset:%2" : "=&v"(r) : "v"(vb), "i"(OFF) : "memory"); return r;
}
template <int NCB, int D0> __device__ __forceinline__ void pv_one(f32x16& od, int vb, bf16x8 pa0, bf16x8 pa1, bf16x8 pa2, bf16x8 pa3) {
#define VOFF(ks, half) (D0 * 512 + (ks) * (NCB * 1024) + (half) * (NCB * 512))
  const s16x4 l0 = tr_read<VOFF(0, 0)>(vb), h0 = tr_read<VOFF(0, 1)>(vb), l1 = tr_read<VOFF(1, 0)>(vb), h1 = tr_read<VOFF(1, 1)>(vb);
  const s16x4 l2 = tr_read<VOFF(2, 0)>(vb), h2 = tr_read<VOFF(2, 1)>(vb), l3 = tr_read<VOFF(3, 0)>(vb), h3 = tr_read<VOFF(3, 1)>(vb);
#undef VOFF
  asm volatile("s_waitcnt lgkmcnt(0)" ::: "memory"); SBAR();
#define PK(L, H) (bf16x8){L[0], L[1], L[2], L[3], H[0], H[1], H[2], H[3]}
  od = __builtin_amdgcn_mfma_f32_32x32x16_bf16(pa0, PK(l0, h0), od, 0, 0, 0);
  od = __builtin_amdgcn_mfma_f32_32x32x16_bf16(pa1, PK(l1, h1), od, 0, 0, 0);
  od = __builtin_amdgcn_mfma_f32_32x32x16_bf16(pa2, PK(l2, h2), od, 0, 0, 0);
  od = __builtin_amdgcn_mfma_f32_32x32x16_bf16(pa3, PK(l3, h3), od, 0, 0, 0);
#undef PK
}
template <int NCB> __device__ __forceinline__ void pv_all(f32x16* o, int vb, bf16x8 pa0, bf16x8 pa1, bf16x8 pa2, bf16x8 pa3) {
  pv_one<NCB, 0>(o[0], vb, pa0, pa1, pa2, pa3); pv_one<NCB, 1>(o[1], vb, pa0, pa1, pa2, pa3);
  if constexpr (NCB == 4) { pv_one<NCB, 2>(o[2], vb, pa0, pa1, pa2, pa3); pv_one<NCB, 3>(o[3], vb, pa0, pa1, pa2, pa3); }
}

template <int DQK, int DV, int MODE, int QPOST, int ldq, int ldk, int ldo>
__device__ __forceinline__ void attn_body_seq(const bf16_t* __restrict__ Qb, const bf16_t* __restrict__ Kp, const bf16_t* __restrict__ K2p, const bf16_t* __restrict__ Vp,
                                              int krow_base, bf16_t* __restrict__ OG, int NT, int na_r0, char* lds, int tid, int dummy, const float* qgain, const float2* qtab, int q_t0) {
  constexpr int NQ = DQK / 16, NCB = DV / 32, SHM_K = 64 * DQK * 2, SHM_V = 64 * DV * 2, RB = DQK * 2;
  constexpr int NKC = DQK / 64, NVC = DV / 64;
  const int wid = tid >> 6, lane = tid & 63, r32 = lane & 31, hi = lane >> 5;
  char* V_lds = lds; char* K_lds = lds + 2 * SHM_V;
  float* wsl = (float*)(lds + 2 * SHM_V + 2 * SHM_K) + wid * 64; float* li_l = wsl; float* al_l = wsl + 32;
  const float* bias_l = (const float*)(lds + 2 * SHM_V + 2 * SHM_K + 8 * 64 * 4);
  float m_reg = -1e30f, l_reg = 0; f32x16 o[NCB]; bf16x8 qr[NQ];
#pragma unroll
  for (int d = 0; d < NCB; ++d) o[d] = f32x16{};
  const bf16_t* Qw = Qb + (size_t)(wid * 32 + r32) * ldq + hi * 8;
#pragma unroll
  for (int d0 = 0; d0 < NQ; ++d0) qr[d0] = *reinterpret_cast<const bf16x8*>(Qw + d0 * 16);
  if constexpr (QPOST == 1) {
    float xq[8][8]; float ss = 0;
#pragma unroll
    for (int d0 = 0; d0 < 8; ++d0)
#pragma unroll
      for (int j = 0; j < 8; ++j) { xq[d0][j] = bf2f(qr[d0][j]); ss += xq[d0][j] * xq[d0][j]; }
    { auto rr = __builtin_amdgcn_permlane32_swap(__float_as_uint(ss), __float_as_uint(ss), false, false); ss = __uint_as_float(rr[0]) + __uint_as_float(rr[1]); }
    const float rstd = rsqrtf(ss * (1.f / 128.f) + EPS);
#pragma unroll
    for (int d0 = 0; d0 < 8; ++d0) { const f32x4 g0 = *(const f32x4*)(qgain + d0 * 16 + hi * 8), g1 = *(const f32x4*)(qgain + d0 * 16 + hi * 8 + 4);
#pragma unroll
      for (int j = 0; j < 4; ++j) { xq[d0][j] *= rstd * g0[j]; xq[d0][4 + j] *= rstd * g1[j]; } }
    if (q_t0 >= 0) { const int t = q_t0 + wid * 32 + r32, prow = t >> 6, pcol = t & 63;
#pragma unroll
      for (int dd = 0; dd < 4; ++dd) { const int d0 = (dd & 1) + (dd >> 1) * 4, pos = (dd >> 1) ? pcol : prow; const float2* tp = qtab + pos * 32 + (d0 & 1) * 16 + hi * 8;
#pragma unroll
        for (int j = 0; j < 8; ++j) { const float2 cs = tp[j]; const float x0 = xq[d0][j], x1 = xq[d0 + 2][j]; xq[d0][j] = x0 * cs.x - x1 * cs.y; xq[d0 + 2][j] = x1 * cs.x + x0 * cs.y; } } }
#pragma unroll
    for (int d0 = 0; d0 < 8; ++d0) qr[d0] = pack8(xq[d0]);
  }
  if constexpr (DQK == 192) {
    if (q_t0 >= 0) { const int t = q_t0 + wid * 32 + r32, prow = t >> 6, pcol = t & 63;
#pragma unroll
      for (int ax = 0; ax < 2; ++ax) { const float2* tp = qtab + (ax ? pcol : prow) * 16 + hi * 8; float y0[8], y1[8];
#pragma unroll
        for (int j = 0; j < 8; ++j) { const float2 cs = tp[j]; const float x0 = bf2f(qr[8 + 2 * ax][j]), x1 = bf2f(qr[9 + 2 * ax][j]); y0[j] = x0 * cs.x - x1 * cs.y; y1[j] = x1 * cs.x + x0 * cs.y; }
        qr[8 + 2 * ax] = pack8(y0); qr[9 + 2 * ax] = pack8(y1); } }
  }
  const int sr = tid >> 4, sc = (tid & 15) * 8, sr8 = tid >> 3, sc8 = (tid & 7) * 8;
  const int vb0 = (int)(uintptr_t)V_lds + v_rd_base(lane);
  auto tile_row = [&](int j) -> int {
    if constexpr (MODE == 0) return krow_base + j * 64;
    else { if (j < 4) return krow_base + j * 64; int kr = na_r0 - 8 + j; kr = kr < 0 ? 0 : (kr > 127 ? 127 : kr); return krow_base + CTX + kr * 64; }
  };
  auto na_mask = [&](f32x16& p0, f32x16& p1, int j) {
    if constexpr (MODE == 1) {
      if (j >= 4) {
        const int krraw = na_r0 - 8 + j, r = na_r0 + (wid >> 1);
        int rs = r - 4; rs = rs < 0 ? 0 : (rs > 120 ? 120 : rs);
        const float NINF = -__builtin_inff();
        if (krraw < rs || krraw >= rs + 8) {
#pragma unroll
          for (int q = 0; q < 16; ++q) { p0[q] = NINF; p1[q] = NINF; }
        } else {
          const float* brow = bias_l + (krraw - r + 7) * 32;
          const int c = (wid & 1) * 32 + r32; int cs = c - 8; cs = cs < 0 ? 0 : (cs > 48 ? 48 : cs);
#pragma unroll
          for (int q = 0; q < 16; ++q) {
            const int k0 = crow(q, hi), k1 = 32 + k0;
            int i0 = k0 - c + 15, i1 = k1 - c + 15; i0 = i0 < 0 ? 0 : (i0 > 30 ? 30 : i0); i1 = i1 < 0 ? 0 : (i1 > 30 ? 30 : i1);
            const float b0 = brow[i0], b1 = brow[i1];
            p0[q] = (k0 >= cs && k0 < cs + 16) ? p0[q] + b0 : NINF;
            p1[q] = (k1 >= cs && k1 < cs + 16) ? p1[q] + b1 : NINF;
          }
        }
      }
    }
  };
  bf16x8 sk[NKC], sv[NVC];
#define SLOAD(j) do { const size_t kr_ = (size_t)tile_row(j);                                                                      \
    if constexpr (DQK >= 128) { sk[0] = *reinterpret_cast<const bf16x8*>(Kp + (kr_ + sr) * ldk + sc); sk[1] = *reinterpret_cast<const bf16x8*>(Kp + (kr_ + 32 + sr) * ldk + sc); } \
    if constexpr (DQK == 192) sk[2] = *reinterpret_cast<const bf16x8*>(K2p + (kr_ + sr8) * ldk + sc8);                                       \
    if constexpr (DQK == 64) sk[0] = *reinterpret_cast<const bf16x8*>(Kp + (kr_ + sr8) * ldk + sc8);                                         \
    if constexpr (DV == 128) { sv[0] = *reinterpret_cast<const bf16x8*>(Vp + (kr_ + sr) * ldk + sc); sv[1] = *reinterpret_cast<const bf16x8*>(Vp + (kr_ + 32 + sr) * ldk + sc); } \
    else sv[0] = *reinterpret_cast<const bf16x8*>(Vp + (kr_ + sr8) * ldk + sc8); } while (0)
#define KSW(row, colB) ((row) * RB + ((colB) ^ (((row) & 7) << 4)))
#define SWRITE(b) do {                                                                                                                          \
    if constexpr (DV == 128) { *(bf16x8*)(V_lds + (b) * SHM_V + v_st<NCB>(sr, sc)) = sv[0]; *(bf16x8*)(V_lds + (b) * SHM_V + v_st<NCB>(32 + sr, sc)) = sv[1]; } \
    else *(bf16x8*)(V_lds + (b) * SHM_V + v_st<NCB>(sr8, sc8)) = sv[0];                                                                        \
    if constexpr (DQK >= 128) { *(bf16x8*)(K_lds + (b) * SHM_K + KSW(sr, sc * 2)) = sk[0]; *(bf16x8*)(K_lds + (b) * SHM_K + KSW(32 + sr, sc * 2)) = sk[1]; } \
    if constexpr (DQK == 192) *(bf16x8*)(K_lds + (b) * SHM_K + KSW(sr8, 256 + sc8 * 2)) = sk[2];                                              \
    if constexpr (DQK == 64) *(bf16x8*)(K_lds + (b) * SHM_K + KSW(sr8, sc8 * 2)) = sk[0]; } while (0)
  SLOAD(0); asm volatile("s_waitcnt vmcnt(0)" ::: "memory"); SWRITE(0); __syncthreads();
  for (int j = 0; j < NT; ++j) {
    const int bsel = j & 1;
    if (j + 1 < NT) SLOAD(j + 1);
    SBAR();
    bool skip = false;
    if constexpr (MODE == 1) { if (j >= 4) { const int krraw = na_r0 - 8 + j, r = na_r0 + (wid >> 1); int rs = r - 4; rs = rs < 0 ? 0 : (rs > 120 ? 120 : rs); skip = (krraw < rs) || (krraw >= rs + 8); } }
    if (!skip) {
    f32x16 p0, p1; float mn, al; bf16x8 pa0, pa1, pa2, pa3;
    qkt<DQK>(p0, p1, K_lds + bsel * SHM_K, qr, r32, hi);
    na_mask(p0, p1, j);
    partialSM<DQK>(p0, p1, m_reg, mn, al);
    finishSM(p0, p1, al, l_reg, pa0, pa1, pa2, pa3);
    if (__any(al < 1.f)) { if (hi == 0) al_l[r32] = al; asm volatile("s_waitcnt lgkmcnt(0)" ::: "memory");
#pragma unroll
      for (int d = 0; d < NCB; ++d)
#pragma unroll
        for (int r = 0; r < 16; ++r) o[d][r] *= al_l[crow(r, hi)]; }
    SBAR();
    pv_all<NCB>(o, vb0 + bsel * SHM_V, pa0, pa1, pa2, pa3);
    }
    if (j + 1 < NT) SWRITE(bsel ^ 1);
    __syncthreads();
  }
  if (dummy) { if (l_reg == 123.456f) OG[tid] = (bf16_t)(cvtpk(o[0][0], o[1][3]) & 0xffffu); return; }
  if (hi == 0) li_l[r32] = l_reg; asm volatile("s_waitcnt lgkmcnt(0)" ::: "memory");
  float rli[16];
#pragma unroll
  for (int r = 0; r < 16; ++r) rli[r] = __builtin_amdgcn_rcpf(li_l[crow(r, hi)]);
  bf16_t* Ow = OG + (size_t)(wid * 32) * ldo;
#pragma unroll
  for (int r = 0; r < 16; ++r) { const int orow = crow(r, hi);
#pragma unroll
    for (int d0 = 0; d0 < NCB; ++d0) { bf16_t* pp = Ow + (size_t)orow * ldo + d0 * 32 + r32;
      const float g = bf2f((short)*pp); const float v = o[d0][r] * rli[r] * silu_f(g);
      *pp = (bf16_t)(cvtpk(v, v) & 0xffffu); } }
#undef SLOAD
#undef SWRITE
#undef KSW
}

__device__ __forceinline__ void phase_pre(KP p, char* lds, const int tid) {
  float* tl = (float*)lds;
  for (int tt = blockIdx.x; tt < WTAB.ntiles; tt += gridDim.x) {
    int di = 0;
    for (int i = 1; i < NWD; ++i) if (tt >= WTAB.d[i].tile0) di = i;
    const WDesc wd = WTAB.d[di];
    const float* src = p->in[wd.in_idx] + wd.src_off; bf16_t* dst = (bf16_t*)(p->ws + OFF_W) + wd.dst_off; const int K = wd.K, N = wd.N, local = tt - wd.tile0;
    const int nkt = K >> 6, kt = local % nkt, ntile = local / nkt;
    const int kk = tid >> 3, n8 = (tid & 7) * 8;
    f32x4 a = {0.f, 0.f, 0.f, 0.f}, b = a;
    if (ntile * 64 < N) { const float* sp = src + (size_t)(kt * 64 + kk) * N + ntile * 64 + n8; a = *(const f32x4*)sp; b = *(const f32x4*)(sp + 4); }
    __syncthreads();
#pragma unroll
    for (int i = 0; i < 4; ++i) { tl[(n8 + i) * 65 + kk] = a[i]; tl[(n8 + 4 + i) * 65 + kk] = b[i]; }
    __syncthreads();
    const int n = tid >> 3, k8 = (tid & 7) * 8; float v[8];
#pragma unroll
    for (int i = 0; i < 8; ++i) v[i] = tl[n * 65 + k8 + i];
    *(bf16x8*)(dst + (size_t)(ntile * 64 + n) * K + kt * 64 + k8) = pack8(v);
  }
  float* part = (float*)(p->ws + OFF_MODP);
  for (int it = blockIdx.x; it < 4 * 16 * 6; it += gridDim.x) {
    const int nb = it % 6, kc = (it / 6) & 15, layer = it / 96;
    __syncthreads();
    if (tid < 320) { const int s = tid >> 6, kk = tid & 63; const float cv = s < 4 ? p->in[IN_C][s * DM + kc * 64 + kk] : p->in[IN_CCTX][kc * 64 + kk]; tl[tid] = silu_f(cv); }
    __syncthreads();
    const int n = nb * 512 + tid; const float* wp = p->in[IN_MODW] + ((size_t)layer * DM + kc * 64) * 3072 + n;
    float a0 = 0, a1 = 0, a2 = 0, a3 = 0, a4 = 0;
#pragma unroll 8
    for (int kk = 0; kk < 64; ++kk) { const float w = wp[(size_t)kk * 3072]; a0 += tl[kk] * w; a1 += tl[64 + kk] * w; a2 += tl[128 + kk] * w; a3 += tl[192 + kk] * w; a4 += tl[256 + kk] * w; }
    float* pp = part + ((size_t)(kc * 4 + layer) * 5) * 3072 + n;
    pp[0] = a0; pp[3072] = a1; pp[2 * 3072] = a2; pp[3 * 3072] = a3; pp[4 * 3072] = a4;
  }
  for (int i = blockIdx.x * NTHREADS + tid; i < 128 * 48; i += gridDim.x * NTHREADS) {
    int pos, f; float inv; float2* dstp;
    if (i < 128 * 32) { pos = i >> 5; f = i & 31; inv = INV_A[f]; dstp = (float2*)(p->ws + OFF_TABA) + i; }
    else { const int q = i - 128 * 32; pos = q >> 4; f = q & 15; inv = INV_M[f]; dstp = (float2*)(p->ws + OFF_TABM) + q; }
    const float angf = (float)pos * inv;
    const double ang = (double)angf, k = __builtin_rint(ang * 0.15915494309189535), r = ang - k * 6.283185307179586476925287, r2 = r * r;
    double sn = r, cs = 1.0, ts = r, tc = 1.0;
#pragma unroll 1
    for (int q = 1; q <= 14; ++q) { tc = -tc * r2 / (double)((2 * q - 1) * (2 * q)); cs += tc; ts = -ts * r2 / (double)((2 * q) * (2 * q + 1)); sn += ts; }
    *dstp = make_float2((float)cs, (float)sn);
  }
}
__device__ __forceinline__ void phase_modfin(KP p, const int tid) {
  const float* part = (const float*)(p->ws + OFF_MODP); float* mod = (float*)(p->ws + OFF_MOD);
  for (int i = blockIdx.x * NTHREADS + tid; i < 4 * 5 * 3072; i += gridDim.x * NTHREADS) {
    const int n = i % 3072, layer = i / (5 * 3072);
    float a = p->in[IN_MODB][layer * 3072 + n];
#pragma unroll
    for (int kc = 0; kc < 16; ++kc) a += part[(size_t)kc * (4 * 5 * 3072) + i];
    mod[i] = a;
  }
}
__device__ __forceinline__ void phase_norm(KP p, int layer, const int tid) {
  const int lane = tid & 63, gw = blockIdx.x * 8 + (tid >> 6), nw = gridDim.x * 8;
  const float* mod = (const float*)(p->ws + OFF_MOD) + (size_t)layer * 5 * 3072; const float* g = p->in[IN_NORMG] + layer * DM; bf16_t* hb = (bf16_t*)(p->ws + OFF_HB);
  for (int row0 = gw * 4; row0 < T; row0 += nw * 4) {
    f32x4 v[4][4];
#pragma unroll
    for (int r = 0; r < 4; ++r) { const float* xr = res_src(p, layer, row0 + r);
#pragma unroll
      for (int i = 0; i < 4; ++i) v[r][i] = *(const f32x4*)(xr + i * 256 + lane * 4); }
    const int b = row0 / TPB, j = row0 - b * TPB; const float* m = mod + (j < CTX ? 4 : b) * 3072;
    f32x4 gm[4], sh[4];
#pragma unroll
    for (int i = 0; i < 4; ++i) { const int col = i * 256 + lane * 4; const f32x4 gg = *(const f32x4*)(g + col), scl = *(const f32x4*)(m + 1024 + col); sh[i] = *(const f32x4*)(m + col); gm[i] = gg * (1.f + scl); }
#pragma unroll
    for (int r = 0; r < 4; ++r) {
      float ss = 0;
#pragma unroll
      for (int i = 0; i < 4; ++i) ss += v[r][i][0] * v[r][i][0] + v[r][i][1] * v[r][i][1] + v[r][i][2] * v[r][i][2] + v[r][i][3] * v[r][i][3];
      ss = wave_sum(ss); const float rstd = rsqrtf(ss * (1.f / DM) + EPS);
#pragma unroll
      for (int i = 0; i < 4; ++i) { const int col = i * 256 + lane * 4; const f32x4 y = v[r][i] * rstd * gm[i] + sh[i];
        u32x2 w = {cvtpk(y[0], y[1]), cvtpk(y[2], y[3])}; *(u32x2*)(hb + (size_t)(row0 + r) * DM + col) = w; }
    }
  }
}
__device__ __forceinline__ void phase_final(KP p, int dummy, const int tid) {
  const int lane = tid & 63, gw = blockIdx.x * 8 + (tid >> 6), nw = gridDim.x * 8;
  const float* outp = p->out; float* dstp = dummy ? (float*)(p->ws + OFF_PJ) : p->out; const float* fg = p->in[IN_FINALG];
  f32x4 gg[4];
#pragma unroll
  for (int i = 0; i < 4; ++i) gg[i] = *(const f32x4*)(fg + i * 256 + lane * 4);
  for (int row0 = gw * 4; row0 < NB * SEQ; row0 += nw * 4) {
    f32x4 v[4][4];
#pragma unroll
    for (int r = 0; r < 4; ++r)
#pragma unroll
      for (int i = 0; i < 4; ++i) v[r][i] = *(const f32x4*)(outp + (size_t)(row0 + r) * DM + i * 256 + lane * 4);
#pragma unroll
    for (int r = 0; r < 4; ++r) {
      float ss = 0;
#pragma unroll
      for (int i = 0; i < 4; ++i) ss += v[r][i][0] * v[r][i][0] + v[r][i][1] * v[r][i][1] + v[r][i][2] * v[r][i][2] + v[r][i][3] * v[r][i][3];
      ss = wave_sum(ss); const float rstd = rsqrtf(ss * (1.f / DM) + EPS);
#pragma unroll
      for (int i = 0; i < 4; ++i) *(f32x4*)(dstp + (size_t)(row0 + r) * DM + i * 256 + lane * 4) = v[r][i] * rstd * gg[i];
    }
  }
}
__device__ __forceinline__ void phase_gqa_post(KP p, int j, int dummy, const int tid) {
  const int lane = tid & 63, gw = blockIdx.x * 8 + (tid >> 6), nw = gridDim.x * 8, g4 = lane >> 4, i = lane & 15;
  bf16_t* pj = (bf16_t*)(p->ws + (dummy ? OFF_QM : OFF_PJ)); const int ldp = dummy ? 1280 : 2560; const float2* tab = (const float2*)(p->ws + OFF_TABA);
  const float* kg = p->in[IN_GA_KG] + j * 128 + i * 8;
  float gk[8];
#pragma unroll
  for (int e = 0; e < 8; ++e) gk[e] = kg[e];
  const int axis = i >> 3, half = (i >> 2) & 1;
  for (int wi0 = gw * 4; wi0 < T * 2 / 4; wi0 += nw * 4) {
    bf16x8 raw[4]; bf16_t* ptr[4]; int rw[4];
#pragma unroll
    for (int u = 0; u < 4; ++u) { const int hv = (wi0 + u) * 4 + g4; rw[u] = hv >> 1; ptr[u] = pj + (size_t)rw[u] * ldp + 1024 + (hv & 1) * 128 + i * 8; raw[u] = *(const bf16x8*)ptr[u]; }
#pragma unroll
    for (int u = 0; u < 4; ++u) {
      float x[8]; float ss = 0;
#pragma unroll
      for (int e = 0; e < 8; ++e) { x[e] = bf2f(raw[u][e]); ss += x[e] * x[e]; }
      ss += __shfl_xor(ss, 1); ss += __shfl_xor(ss, 2); ss += __shfl_xor(ss, 4); ss += __shfl_xor(ss, 8);
      const float rstd = rsqrtf(ss * (1.f / 128.f) + EPS);
#pragma unroll
      for (int e = 0; e < 8; ++e) x[e] = x[e] * rstd * gk[e];
      const int b = rw[u] / TPB, jj = rw[u] - b * TPB; const bool lat = jj >= CTX; const int t = jj - CTX;
      const int pos = lat ? (axis ? (t & 63) : (t >> 6)) : 0;
      float y[8];
#pragma unroll
      for (int e = 0; e < 8; ++e) { const float xp = __shfl_xor(x[e], 4); const float2 cs = tab[pos * 32 + (i & 3) * 8 + e];
        y[e] = lat ? (half ? x[e] * cs.x + xp * cs.y : x[e] * cs.x - xp * cs.y) : x[e]; }
      *(bf16x8*)ptr[u] = pack8(y);
    }
  }
}
__device__ __forceinline__ void phase_mla_post1(KP p, int dummy, const int tid) {
  const int lane = tid & 63, gw = blockIdx.x * 8 + (tid >> 6), nw = gridDim.x * 8;
  bf16_t* pj = (bf16_t*)(p->ws + (dummy ? OFF_HB : OFF_PJ)); const int ldp = dummy ? 1024 : 2048; const float2* tab = (const float2*)(p->ws + OFF_TABM); const float* qgp = p->in[IN_ML_QG]; const float* kvgp = p->in[IN_ML_KVG];
  const int l2 = lane & 31, l3 = lane & 7;
  float gq[8], gkv[8];
#pragma unroll
  for (int e = 0; e < 8; ++e) { gq[e] = qgp[lane * 8 + e]; gkv[e] = kvgp[l2 * 8 + e]; }
  for (int row0 = gw * 2; row0 < T; row0 += nw * 2) {
    bf16x8 rq[2], rkv[2], rr[2];
#pragma unroll
    for (int u = 0; u < 2; ++u) { bf16_t* pr = pj + (size_t)(row0 + u) * ldp; rq[u] = *(const bf16x8*)(pr + lane * 8); rkv[u] = *(const bf16x8*)(pr + 512 + l2 * 8); rr[u] = *(const bf16x8*)(pr + 768 + l3 * 8); }
#pragma unroll
    for (int u = 0; u < 2; ++u) {
      const int row = row0 + u; bf16_t* pr = pj + (size_t)row * ldp;
      { float x[8]; float ss = 0;
#pragma unroll
        for (int e = 0; e < 8; ++e) { x[e] = bf2f(rq[u][e]); ss += x[e] * x[e]; }
        ss = wave_sum(ss); const float rstd = rsqrtf(ss * (1.f / 512.f) + EPS);
#pragma unroll
        for (int e = 0; e < 8; ++e) x[e] = x[e] * rstd * gq[e];
        *(bf16x8*)(pr + lane * 8) = pack8(x); }
      { float x[8]; float ss = 0;
#pragma unroll
        for (int e = 0; e < 8; ++e) { x[e] = bf2f(rkv[u][e]); ss += x[e] * x[e]; }
        ss = wave_sum(ss) * 0.5f; const float rstd = rsqrtf(ss * (1.f / 256.f) + EPS);
#pragma unroll
        for (int e = 0; e < 8; ++e) x[e] = x[e] * rstd * gkv[e];
        if (lane < 32) *(bf16x8*)(pr + 512 + l2 * 8) = pack8(x); }
      { const int b = row / TPB, jj = row - b * TPB; const bool lat = jj >= CTX; const int t = jj - CTX;
        const int axis = l3 >> 2, half = (l3 >> 1) & 1, pos = lat ? (axis ? (t & 63) : (t >> 6)) : 0; float y[8];
#pragma unroll
        for (int e = 0; e < 8; ++e) { const float x = bf2f(rr[u][e]); const float xp = __shfl_xor(x, 2); const float2 cs = tab[pos * 16 + (l3 & 1) * 8 + e];
          y[e] = half ? x * cs.x + xp * cs.y : x * cs.x - xp * cs.y; }
        if (lat && lane < 8) *(bf16x8*)(pr + 768 + l3 * 8) = pack8(y); }
    }
  }
}
__device__ __forceinline__ void phase_mla_post2(KP p, const int tid) {
  const int lane = tid & 63, gw = blockIdx.x * 8 + (tid >> 6), nw = gridDim.x * 8, h = lane >> 3, i = lane & 7;
  bf16_t* qm = (bf16_t*)(p->ws + OFF_QM); const float2* tab = (const float2*)(p->ws + OFF_TABM);
  const int axis = i >> 2, half = (i >> 1) & 1;
  for (int lr0 = gw * 4; lr0 < NB * SEQ; lr0 += nw * 4) {
    bf16x8 raw[4]; bf16_t* ptr[4];
#pragma unroll
    for (int u = 0; u < 4; ++u) { const int lr = lr0 + u, b = lr >> 13, t = lr & 8191; ptr[u] = qm + ((size_t)b * TPB + CTX + t) * 1536 + h * 192 + 128 + i * 8; raw[u] = *(const bf16x8*)ptr[u]; }
#pragma unroll
    for (int u = 0; u < 4; ++u) { const int t = (lr0 + u) & 8191, pos = axis ? (t & 63) : (t >> 6); float y[8];
#pragma unroll
      for (int e = 0; e < 8; ++e) { const float x = bf2f(raw[u][e]); const float xp = __shfl_xor(x, 2); const float2 cs = tab[pos * 16 + (i & 1) * 8 + e];
        y[e] = half ? x * cs.x + xp * cs.y : x * cs.x - xp * cs.y; }
      *(bf16x8*)ptr[u] = pack8(y); }
  }
}
__device__ __forceinline__ void phase_att_gqa(KP p, int need_ctx, int dummy, int jl, char* lds, const int tid) {
  bf16_t* pj = (bf16_t*)(p->ws + OFF_PJ); const float* qgain = p->in[IN_GA_QG] + jl * 128;
  const int nit = 1024 + (need_ctx ? 32 : 0);
  for (int it = blockIdx.x; it < nit; it += gridDim.x) {
    int b, h, row0, nt, qt0;
    if (it < 1024) { b = it >> 8; h = (it >> 5) & 7; row0 = b * TPB + CTX + (it & 31) * 256; nt = TPB / 64; qt0 = (it & 31) * 256; }
    else { const int q = it - 1024; b = q >> 3; h = q & 7; row0 = b * TPB; nt = CTX / 64; qt0 = -1; }
    __syncthreads();
    attn_body_seq<128, 128, 0, 1, 2560, 2560, 2560>(pj + (size_t)row0 * 2560 + h * 128, pj + 1024 + (h >> 2) * 128, nullptr, pj + 1280 + (h >> 2) * 128, b * TPB,
                           pj + (size_t)row0 * 2560 + 1536 + h * 128, nt, 0, lds, tid, dummy, qgain, (const float2*)(p->ws + OFF_TABA), qt0);
  }
}
__device__ __forceinline__ void phase_att_mla(KP p, int need_ctx, int dummy, char* lds, const int tid) {
  bf16_t* pj = (bf16_t*)(p->ws + OFF_PJ); bf16_t* kvm = pj + (size_t)T * 2048; bf16_t* qm = (bf16_t*)(p->ws + OFF_QM);
  const int nit = 1024 + (need_ctx ? 32 : 0);
  for (int it = blockIdx.x; it < nit; it += gridDim.x) {
    int b, h, row0, nt, qt0;
    if (it < 1024) { b = it >> 8; h = (it >> 5) & 7; row0 = b * TPB + CTX + (it & 31) * 256; nt = TPB / 64; qt0 = (it & 31) * 256; }
    else { const int q = it - 1024; b = q >> 3; h = q & 7; row0 = b * TPB; nt = CTX / 64; qt0 = -1; }
    __syncthreads();
    attn_body_seq<192, 128, 0, 0, 1536, 2048, 2048>(qm + (size_t)row0 * 1536 + h * 192, kvm + h * 256, pj + 768, kvm + h * 256 + 128, b * TPB,
                            pj + (size_t)row0 * 2048 + 832 + h * 128, nt, 0, lds, tid, dummy, nullptr, (const float2*)(p->ws + OFF_TABM), qt0);
  }
}
__device__ __forceinline__ void phase_att_na(KP p, int need_ctx, int dummy, char* lds, const int tid) {
  bf16_t* pj = (bf16_t*)(p->ws + OFF_PJ);
  float* bias_l = (float*)(lds + 2 * 8192 + 2 * 8192 + 8 * 64 * 4);
  const int nit = 2048 + (need_ctx ? 64 : 0);
  for (int it = blockIdx.x; it < nit; it += gridDim.x) {
    __syncthreads();
    int ntl = it < 2048 ? 16 : 4; asm volatile("" : "+s"(ntl));
    if (it < 2048) {
      const int b = it >> 9, h = (it >> 5) & 15, r0 = (it & 31) * 4, row0 = b * TPB + CTX + r0 * 64;
      if (tid < 15 * 32) { const int ro = tid >> 5, co = tid & 31; bias_l[tid] = co < 31 ? p->in[IN_NA_RPB][(h * 15 + ro) * 31 + co] * 8.f : 0.f; }
      attn_body_seq<64, 64, 1, 0, 4096, 4096, 4096>(pj + (size_t)row0 * 4096 + h * 64, pj + 1024 + h * 64, nullptr, pj + 2048 + h * 64, b * TPB,
                           pj + (size_t)row0 * 4096 + 3072 + h * 64, ntl, r0, lds, tid, dummy, nullptr, nullptr, -1);
    } else {
      const int q = it - 2048, b = q >> 4, h = q & 15, row0 = b * TPB;
      attn_body_seq<64, 64, 0, 0, 4096, 4096, 4096>(pj + (size_t)row0 * 4096 + h * 64, pj + 1024 + h * 64, nullptr, pj + 2048 + h * 64, b * TPB,
                           pj + (size_t)row0 * 4096 + 3072 + h * 64, ntl, 0, lds, tid, dummy, nullptr, nullptr, -1);
    }
  }
}

#define XB_TMO      128
#define XB_XCNT(j)  (256  + 64 * (j))
#define XB_XSUB(j)  (1280 + 64 * (j))
#define XB_XGEN(j)  (2304 + 64 * (j))
#define XB_TOP      3328
#define XB_TOPGEN   3392
#define XCD_BAR_WORDS 3456
#define XB_SPIN_CAP (1u << 18)
__device__ __forceinline__ unsigned xb_ld(unsigned* p)              { return __hip_atomic_load(p, __ATOMIC_RELAXED, __HIP_MEMORY_SCOPE_AGENT); }
__device__ __forceinline__ unsigned xb_add(unsigned* p, unsigned v) { return __hip_atomic_fetch_add(p, v, __ATOMIC_RELAXED, __HIP_MEMORY_SCOPE_AGENT); }
__device__ __forceinline__ unsigned xb_xcc_id() { return (unsigned)__builtin_amdgcn_s_getreg((3 << 11) | 20) & 0xFu; }
#define XB_SPIN(cond, bar) do { unsigned _sp = 0; while (cond) { __builtin_amdgcn_s_sleep(1); \
    if ((++_sp & 255u) == 0u) { if (xb_ld(&(bar)[XB_TMO])) break; if (_sp > XB_SPIN_CAP) { atomicAdd(&(bar)[XB_TMO], 1u); break; } } } } while (0)
struct XcdBarrier { unsigned* bar; unsigned x; volatile LAS unsigned* st; };
__device__ __forceinline__ XcdBarrier xcd_barrier_post(unsigned* bar, volatile LAS unsigned* st) {
    XcdBarrier b; b.bar = bar; b.x = xb_xcc_id(); b.st = st;
    if (threadIdx.x == 0) (void)xb_add(&bar[XB_XCNT(b.x)], 1u);
    return b;
}
__device__ __forceinline__ void xcd_barrier_complete(unsigned* bar, unsigned x, unsigned& nloc, unsigned& nx) {
    const unsigned G = gridDim.x * gridDim.y * gridDim.z;
    unsigned sum, cnt, mine, sp = 0u;
    for (;;) {
        sum = 0u; cnt = 0u; mine = 0u;
#pragma unroll
        for (unsigned j = 0; j < 16; ++j) { const unsigned c = xb_ld(&bar[XB_XCNT(j)]); sum += c; cnt += (c > 0u) ? 1u : 0u; mine = (j == x) ? c : mine; }
        if (sum == G) break;
        __builtin_amdgcn_s_sleep(1);
        if ((++sp & 255u) == 0u) { if (xb_ld(&bar[XB_TMO])) break; if (sp > XB_SPIN_CAP) { atomicAdd(&bar[XB_TMO], 1u); break; } }
    }
    nloc = mine > 0u ? mine : 1u; nx = cnt > 0u ? cnt : 1u;
}
__device__ __forceinline__ void xcd_barrier(const XcdBarrier& b, const int tid) {
    asm volatile("s_waitcnt vmcnt(0)" ::: "memory");
    __syncthreads();
    if (tid == 0) {
        unsigned* bar = b.bar;
        __builtin_amdgcn_s_waitcnt(0);
        unsigned nloc = b.st[0], nx = b.st[1];
        if (nloc == 0u) { xcd_barrier_complete(bar, b.x, nloc, nx); b.st[0] = nloc; b.st[1] = nx; }
        const unsigned old = xb_add(&bar[XB_XSUB(b.x)], 1u);
        const unsigned gen = old / nloc;
        if (old + 1u == (gen + 1u) * nloc) {
            __builtin_amdgcn_fence(__ATOMIC_RELEASE, "agent");
            asm volatile("s_waitcnt vmcnt(0)" ::: "memory");
            const unsigned og = xb_add(&bar[XB_TOP], 1u);
            const unsigned tg = og / nx;
            if (og + 1u == (tg + 1u) * nx) xb_add(&bar[XB_TOPGEN], 1u);
            else XB_SPIN(xb_ld(&bar[XB_TOPGEN]) == tg, bar);
            __builtin_amdgcn_fence(__ATOMIC_ACQUIRE, "agent");
            xb_add(&bar[XB_XGEN(b.x)], 1u);
            asm volatile("s_waitcnt vmcnt(0)" ::: "memory");
        } else {
            XB_SPIN(xb_ld(&bar[XB_XGEN(b.x)]) == gen, bar);
            __builtin_amdgcn_fence(__ATOMIC_ACQUIRE, "agent");
            asm volatile("s_waitcnt vmcnt(0)" ::: "memory");
        }
    }
    __syncthreads();
}

__global__ void __launch_bounds__(NTHREADS, 2) fwd_megakernel(const Params p_unused) {
  extern __shared__ __attribute__((aligned(16))) unsigned char shm[];
  cg::grid_group grid = cg::this_grid();
  char* lds = (char*)shm;
  __shared__ uint4 xb_words;
  const int wave_s = __builtin_amdgcn_readfirstlane((int)(threadIdx.x >> 6));
  if (threadIdx.x == 0) xb_words = make_uint4(0u, 0u, 0u, 0u);
  __syncthreads();
  { KP p0 = (KP)__builtin_amdgcn_kernarg_segment_ptr(); (void)xcd_barrier_post((unsigned*)(p0->ws + OFF_BAR), (volatile LAS unsigned*)&xb_words);
    phase_pre(p0, lds, (int)threadIdx.x); }
  grid.sync();
#ifndef PHM
#define PHM 0xffff
#endif
#define PH(k) if constexpr (((PHM) >> (k)) & 1)
  for (int oi = 1; oi < PROG.n; ++oi) {
    const Op op = PROG.ops[oi];
    unsigned zz = 0u; asm volatile("" : "+v"(zz));
    int tid = wave_s * 64 + (int)__builtin_amdgcn_mbcnt_hi(~0u, __builtin_amdgcn_mbcnt_lo(~0u, zz)); asm volatile("" : "+v"(tid));
    KP p = (KP)__builtin_amdgcn_kernarg_segment_ptr(); asm volatile("" : "+s"(p));
    char* ws = p->ws;
    switch (op.type) {
      case OP_MODFIN: PH(1) phase_modfin(p, tid); break;
      case OP_NORM: PH(2) phase_norm(p, op.i0, tid); break;
      case OP_GEMM_BF: case OP_GEMM_BF_NOSYNC: PH(3) {
        pg8::Gemm g{(const bf16_t*)(ws + op.a), (const bf16_t*)(ws + op.b), T, op.i0, op.i1, op.i2};
        pg8::StaticOrder S; S.init(T, op.i0, (int)gridDim.x, (int)blockIdx.x);
        pg8::EpiBf16 E{(bf16_t*)(ws + op.o), op.i0};
        pg8::gemm_phase<pg8::EpiBf16>((LAS unsigned char*)shm, g, S, E, tid);
      } break;
      case OP_GEMM_RES: PH(4) {
        pg8::Gemm g{(const bf16_t*)(ws + op.a), (const bf16_t*)(ws + op.b), T, DM, DM, op.i2};
        pg8::StaticOrder S; S.init(T, DM, (int)gridDim.x, (int)blockIdx.x);
        float* xsc = (float*)(ws + OFF_XSC); float* outp = p->out;
        pg8::EpiResid E{op.i0 == 0 ? p->in[IN_X] : (const float*)outp, op.i0 == 0 ? p->in[IN_CTX] : (const float*)xsc, outp, xsc, (const float*)(ws + OFF_MOD) + (size_t)op.i0 * 5 * 3072};
        pg8::gemm_phase<pg8::EpiResid>((LAS unsigned char*)shm, g, S, E, tid);
      } break;
      case OP_GQA_POST: PH(5) phase_gqa_post(p, op.i0, op.i1, tid); break;
      case OP_ATT_GQA: PH(6) phase_att_gqa(p, op.i0, op.i1, op.i2, lds, tid); break;
      case OP_ATT_NA: PH(7) phase_att_na(p, op.i0, op.i1, lds, tid); break;
      case OP_MLA_POST1: PH(8) phase_mla_post1(p, op.i1, tid); break;
      case OP_MLA_POST2: PH(9) phase_mla_post2(p, tid); break;
      case OP_ATT_MLA: PH(10) phase_att_mla(p, op.i0, op.i1, lds, tid); break;
      case OP_FINAL: PH(11) phase_final(p, op.i1, tid); break;
      default: break;
    }
    if (op.type == OP_GEMM_BF_NOSYNC) __syncthreads(); else { XcdBarrier xb; xb.bar = (unsigned*)(ws + OFF_BAR); xb.x = xb_xcc_id(); xb.st = (volatile LAS unsigned*)&xb_words; xcd_barrier(xb, tid);
      if (PROBE_DUP & 512) { xcd_barrier(xb, tid); xcd_barrier(xb, tid); } }
  }
}

extern "C" void kernel_launch(void* const* d_in, const int* in_sizes, int n_in, void* d_out, int out_size, void* d_ws, size_t ws_size, hipStream_t stream) {
  static int grid_blocks = 0;
  if (!grid_blocks) {
    if (ws_size < WS_END) { fprintf(stderr, "kernel_launch: workspace too small: %zu < %zu\n", ws_size, (size_t)WS_END); return; }
    if (hipFuncSetAttribute((const void*)fwd_megakernel, hipFuncAttributeMaxDynamicSharedMemorySize, LDS_BYTES) != hipSuccess) { fprintf(stderr, "kernel_launch: hipFuncSetAttribute failed\n"); return; }
    int dev = 0, cus = 0, per_cu = 0;
    hipGetDevice(&dev);
    hipDeviceGetAttribute(&cus, hipDeviceAttributeMultiprocessorCount, dev);
    hipOccupancyMaxActiveBlocksPerMultiprocessor(&per_cu, fwd_megakernel, NTHREADS, LDS_BYTES);
    if (per_cu < 1) { fprintf(stderr, "kernel_launch: occupancy query returned %d\n", per_cu); return; }
    grid_blocks = cus;
  }
  Params p; memset(&p, 0, sizeof(p));
  if (n_in != N_IN) { fprintf(stderr, "kernel_launch: expected %d inputs, got %d\n", (int)N_IN, n_in); return; }
  for (int i = 0; i < N_IN; ++i) p.in[i] = (const float*)d_in[i];
  p.out = (float*)d_out; p.ws = (char*)d_ws;
  hipMemsetAsync((char*)d_ws + OFF_BAR, 0, XCD_BAR_WORDS * 4, stream);
  void* args[] = {&p};
  hipError_t e = hipLaunchCooperativeKernel((const void*)fwd_megakernel, dim3(grid_blocks), dim3(NTHREADS), args, LDS_BYTES, stream);
  if (e != hipSuccess) fprintf(stderr, "kernel_launch: cooperative launch failed: %s (grid %d)\n", hipGetErrorString(e), grid_blocks);
}
```

```cpp
#include <hip/hip_runtime.h>
#include <hip/hip_cooperative_groups.h>
#include <cstdio>
#include <cstring>
namespace cg = cooperative_groups;

#define LAS __attribute__((address_space(3)))
typedef unsigned short bf16_t;
typedef short bf16x8 __attribute__((ext_vector_type(8)));
typedef short s16x4 __attribute__((ext_vector_type(4)));
typedef float f32x4 __attribute__((ext_vector_type(4)));
typedef float f32x16 __attribute__((ext_vector_type(16)));
typedef unsigned u32x4 __attribute__((ext_vector_type(4)));
typedef unsigned u32x2 __attribute__((ext_vector_type(2)));

constexpr int NB = 4, SEQ = 8192, CTX = 256, DM = 1024, TPB = SEQ + CTX, T = NB * TPB;
constexpr int DEPTH = 4;
constexpr float EPS = 1e-6f;
constexpr int NTHREADS = 512;
constexpr int LDS_BYTES = 131072;

constexpr size_t OFF_XSC = 0;
constexpr size_t OFF_HB = OFF_XSC + (size_t)NB * CTX * DM * 4;
constexpr size_t OFF_PJ = OFF_HB + (size_t)T * DM * 2;
constexpr size_t OFF_QM = OFF_PJ + (size_t)T * 4096 * 2;
constexpr size_t OFF_W = OFF_QM + (size_t)T * 1536 * 2;
constexpr size_t W_GA_IN = 0, W_GA_OUT = W_GA_IN + 2ull * 2560 * 1024, W_NA_IN = W_GA_OUT + 2ull * 1024 * 1024, W_NA_OUT = W_NA_IN + 4096ull * 1024,
                 W_ML_IN = W_NA_OUT + 1024ull * 1024, W_ML_UQ = W_ML_IN + 2048ull * 1024, W_ML_UKV = W_ML_UQ + 1536ull * 512, W_ML_OUT = W_ML_UKV + 2048ull * 256,
                 W_END = W_ML_OUT + 1024ull * 1024;
constexpr size_t OFF_MODP = OFF_W + W_END * 2;
constexpr size_t OFF_MOD = OFF_MODP + 16ull * 4 * 5 * 3072 * 4;
constexpr size_t OFF_TABA = OFF_MOD + 4ull * 5 * 3072 * 4;
constexpr size_t OFF_TABM = OFF_TABA + 128ull * 32 * 8;
constexpr size_t OFF_BAR = OFF_TABM + 128ull * 16 * 8;
constexpr size_t WS_END = OFF_BAR + 3456ull * 4;

struct Op { int type, i0, i1, i2; unsigned long long a, b, o; };
enum { OP_PRE = 0, OP_MODFIN, OP_NORM, OP_GEMM_BF, OP_GEMM_RES, OP_GQA_POST, OP_ATT_GQA, OP_ATT_NA, OP_MLA_POST1, OP_MLA_POST2, OP_ATT_MLA, OP_FINAL, OP_GEMM_BF_NOSYNC };
enum { IN_X = 0, IN_C, IN_CTX, IN_CCTX, IN_MODW, IN_MODB, IN_NORMG, IN_FINALG, IN_GA_WIN, IN_GA_QG, IN_GA_KG, IN_GA_WOUT, IN_NA_WIN, IN_NA_RPB, IN_NA_WOUT,
       IN_ML_WIN, IN_ML_QG, IN_ML_KVG, IN_ML_WUQ, IN_ML_WUKV, IN_ML_WOUT, N_IN };
struct Params { const float* in[N_IN]; float* out; char* ws; };
#define KAS __attribute__((address_space(4)))
typedef const KAS Params* KP;

#ifndef PROBE_DUP
#define PROBE_DUP 0
#endif
constexpr int MAXOPS = 64;
struct Prog { Op ops[MAXOPS]; int n; };
constexpr void prog_add1(Prog& P, int type, int i0, int i1, int i2, size_t a, size_t b, size_t o) { Op& q = P.ops[P.n++]; q.type = type; q.i0 = i0; q.i1 = i1; q.i2 = i2; q.a = a; q.b = b; q.o = o; }
constexpr void prog_add(Prog& P, int type, int i0, int i1, int i2, size_t a, size_t b, size_t o) {
  const bool gemm = type == OP_GEMM_BF || type == OP_GEMM_BF_NOSYNC;
  if ((PROBE_DUP & 1) && gemm) prog_add1(P, OP_GEMM_BF, i0, i1, i2, a, b, o);
  if ((PROBE_DUP & 2) && type == OP_ATT_GQA) prog_add1(P, type, i0, 1, i2, a, b, o);
  if ((PROBE_DUP & 4) && type == OP_ATT_MLA) prog_add1(P, type, i0, 1, i2, a, b, o);
  if ((PROBE_DUP & 8) && type == OP_ATT_NA) prog_add1(P, type, i0, 1, i2, a, b, o);
  if ((PROBE_DUP & 16) && type == OP_NORM) prog_add1(P, type, i0, i1, i2, a, b, o);
  if ((PROBE_DUP & 32) && type == OP_GEMM_RES && i0 == 0) prog_add1(P, type, i0, i1, i2, a, b, o);
  if ((PROBE_DUP & 128) && type == OP_GQA_POST) prog_add1(P, type, i0, 1, i2, a, b, o);
  if ((PROBE_DUP & 256) && (type == OP_MLA_POST1 || type == OP_FINAL)) prog_add1(P, type, i0, 1, i2, a, b, o);
  if ((PROBE_DUP & 64) && type == OP_PRE) prog_add1(P, type, i0, i1, i2, a, b, o);
  prog_add1(P, type, i0, i1, i2, a, b, o);
}
constexpr Prog make_prog() {
  Prog P{}; P.n = 0;
  const size_t W = OFF_W, hb = OFF_HB, pj = OFF_PJ, qm = OFF_QM;
  prog_add(P, OP_PRE, 0, 0, 0, 0, 0, 0);
  prog_add(P, OP_MODFIN, 0, 0, 0, 0, 0, 0);
  for (int i = 0; i < DEPTH; ++i) {
    const int kind = i % 3, j = i / 3, need_ctx = i < DEPTH - 1;
    prog_add(P, OP_NORM, i, 0, 0, 0, 0, 0);
    if (kind == 0) {
      prog_add(P, OP_GEMM_BF, 2560, 1024, 1024, hb, W + 2 * (W_GA_IN + (size_t)j * 2560 * 1024), pj);
      prog_add(P, OP_GQA_POST, j, 0, 0, 0, 0, 0);
      prog_add(P, OP_ATT_GQA, need_ctx, 0, j, 0, 0, 0);
      prog_add(P, OP_GEMM_RES, i, 0, 2560, pj + 2 * 1536, W + 2 * (W_GA_OUT + (size_t)j * 1024 * 1024), 0);
    } else if (kind == 1) {
      prog_add(P, OP_GEMM_BF, 4096, 1024, 1024, hb, W + 2 * W_NA_IN, pj);
      prog_add(P, OP_ATT_NA, need_ctx, 0, 0, 0, 0, 0);
      prog_add(P, OP_GEMM_RES, i, 0, 4096, pj + 2 * 3072, W + 2 * W_NA_OUT, 0);
    } else {
      prog_add(P, OP_GEMM_BF, 2048, 1024, 1024, hb, W + 2 * W_ML_IN, pj);
      prog_add(P, OP_MLA_POST1, 0, 0, 0, 0, 0, 0);
      prog_add(P, OP_GEMM_BF_NOSYNC, 1536, 512, 2048, pj, W + 2 * W_ML_UQ, qm);
      prog_add(P, OP_GEMM_BF, 2048, 256, 2048, pj + 2 * 512, W + 2 * W_ML_UKV, pj + (size_t)T * 2048 * 2);
      prog_add(P, OP_ATT_MLA, need_ctx, 0, 0, 0, 0, 0);
      prog_add(P, OP_GEMM_RES, i, 0, 2048, pj + 2 * 832, W + 2 * W_ML_OUT, 0);
    }
  }
  prog_add(P, OP_FINAL, 0, 0, 0, 0, 0, 0);
  return P;
}
__device__ const Prog PROG = make_prog();

struct WDesc { int in_idx; int K, N, Npad, tile0; unsigned src_off, dst_off; int pad_; };
constexpr int NWD = 10;
struct WTab { WDesc d[NWD]; int ntiles; };
constexpr WTab make_wtab() {
  WTab t{}; int nt = 0, wi = 0;
  auto addw = [&](int in_idx, size_t src_off, size_t dst, int K, int N, int Npad) { WDesc& w = t.d[wi++]; w.in_idx = in_idx; w.src_off = (unsigned)src_off; w.dst_off = (unsigned)dst; w.K = K; w.N = N; w.Npad = Npad; w.tile0 = nt; w.pad_ = 0; nt += (K / 64) * (Npad / 64); };
  addw(IN_GA_WIN, 0, W_GA_IN, 1024, 2560, 2560); addw(IN_GA_WIN, 1024ull * 2560, W_GA_IN + 2560ull * 1024, 1024, 2560, 2560);
  addw(IN_GA_WOUT, 0, W_GA_OUT, 1024, 1024, 1024); addw(IN_GA_WOUT, 1024ull * 1024, W_GA_OUT + 1024ull * 1024, 1024, 1024, 1024);
  addw(IN_NA_WIN, 0, W_NA_IN, 1024, 4096, 4096); addw(IN_NA_WOUT, 0, W_NA_OUT, 1024, 1024, 1024);
  addw(IN_ML_WIN, 0, W_ML_IN, 1024, 1856, 2048); addw(IN_ML_WUQ, 0, W_ML_UQ, 512, 1536, 1536); addw(IN_ML_WUKV, 0, W_ML_UKV, 256, 2048, 2048); addw(IN_ML_WOUT, 0, W_ML_OUT, 1024, 1024, 1024);
  t.ntiles = nt; return t;
}
__device__ const WTab WTAB = make_wtab();

__device__ const float INV_A[32] = {1.000000000e+00f, 7.498942614e-01f, 5.623413324e-01f, 4.216965139e-01f, 3.162277639e-01f, 2.371373773e-01f, 1.778279394e-01f, 1.333521307e-01f, 1.000000015e-01f, 7.498941571e-02f, 5.623413250e-02f, 4.216965288e-02f, 3.162277490e-02f, 2.371373773e-02f, 1.778279431e-02f, 1.333521493e-02f, 9.999999776e-03f, 7.498941850e-03f, 5.623413250e-03f, 4.216964822e-03f, 3.162277630e-03f, 2.371373586e-03f, 1.778279431e-03f, 1.333521446e-03f, 1.000000047e-03f, 7.498942432e-04f, 5.623413017e-04f, 4.216965172e-04f, 3.162277571e-04f, 2.371373703e-04f, 1.778279402e-04f, 1.333521504e-04f};
__device__ const float INV_M[16] = {1.000000000e+00f, 5.623413324e-01f, 3.162277639e-01f, 1.778279394e-01f, 1.000000015e-01f, 5.623413250e-02f, 3.162277490e-02f, 1.778279431e-02f, 9.999999776e-03f, 5.623413250e-03f, 3.162277630e-03f, 1.778279431e-03f, 1.000000047e-03f, 5.623413017e-04f, 3.162277571e-04f, 1.778279402e-04f};

__device__ __forceinline__ float bf2f(short b) { return __uint_as_float(((unsigned)(unsigned short)b) << 16); }
__device__ __forceinline__ unsigned cvtpk(float lo, float hi) { unsigned r; asm volatile("v_cvt_pk_bf16_f32 %0, %1, %2" : "=v"(r) : "v"(lo), "v"(hi)); return r; }
__device__ __forceinline__ bf16x8 pack8(const float* v) { u32x4 w = {cvtpk(v[0], v[1]), cvtpk(v[2], v[3]), cvtpk(v[4], v[5]), cvtpk(v[6], v[7])}; return *reinterpret_cast<bf16x8*>(&w); }
__device__ __forceinline__ float silu_f(float g) { return g * __builtin_amdgcn_rcpf(1.f + __builtin_amdgcn_exp2f(-g * 1.4426950408889634f)); }
__device__ __forceinline__ float wave_sum(float v) {
#pragma unroll
  for (int o = 32; o >= 1; o >>= 1) v += __shfl_xor(v, o);
  return v;
}
__device__ __forceinline__ const float* res_src(KP p, int layer, int row) {
  const int b = row / TPB, j = row - b * TPB;
  if (j < CTX) return (layer == 0 ? p->in[IN_CTX] : (const float*)(p->ws + OFF_XSC)) + ((size_t)b * CTX + j) * DM;
  return (layer == 0 ? p->in[IN_X] : (const float*)p->out) + ((size_t)b * SEQ + (j - CTX)) * DM;
}

namespace pg8 {
constexpr int BM = 256, BK = 64, HALF = 128, HTB = HALF * BK * 2, STAGE_BYTES = 8 * HTB, NXCD = 8, WGM = 8;
__device__ __forceinline__ int lds_byte(int r, int c) { const int st = (r >> 4) * 2 + (c >> 5), rr = r & 15, cc = c & 31, ob = rr * 64 + cc * 2; return st * 1024 + (ob ^ (((ob >> 9) & 1) << 5)); }
__device__ __forceinline__ void stage_rc(int b, int& R, int& C) { const int st = b / 1024, sb = b % 1024, swz = sb ^ (((sb >> 9) & 1) << 5); R = (st >> 1) * 16 + swz / 64; C = (st & 1) * 32 + (swz % 64) / 2; }
__device__ __forceinline__ int perm32(int rho) { const int n = rho >> 4, i = rho & 15; return 8 * (i >> 2) + 4 * n + (i & 3); }
struct Unit { int pm, pn; };
struct Gemm { const bf16_t* A; const bf16_t* Bt; int M, N, K, lda; };
struct StaticOrder {
  int nM, nN, nwg, G, c, latonly;
  __device__ void init(int M, int N, int G_, int c_, int latonly_ = 0) { latonly = latonly_; nM = latonly ? 128 : M / BM; nN = N / BM; nwg = nM * nN; G = G_; c = c_; }
  __device__ bool next(int i, Unit& u) const {
    const long L = (long)i * G + c; if (L >= nwg) return false;
    int wgid = (int)L; { const int q = nwg / NXCD, r = nwg % NXCD, xcd = wgid % NXCD, off = wgid / NXCD; wgid = (xcd < r ? xcd * (q + 1) : r * (q + 1) + (xcd - r) * q) + off; }
    const int nig = WGM * nN, gid = wgid / nig, fm = gid * WGM, gsz = (nM - fm) < WGM ? (nM - fm) : WGM;
    u.pm = fm + ((wgid % nig) % gsz); u.pn = (wgid % nig) / gsz; if (latonly) u.pm += (u.pm >> 5) + 1; return true;
  }
};
struct EpiBf16 {
  static constexpr bool PERM = true;
  bf16_t* O; int ldc;
  __device__ __forceinline__ void operator()(const f32x4 (&acc)[2][2][4][2], const Unit& u, int wr, int wc, int fr, int fq) const {
    const int row0 = u.pm * BM + wr * 64 + fr, col0 = u.pn * BM + wc * 32 + 8 * fq;
#pragma unroll
    for (int ai = 0; ai < 2; ++ai)
#pragma unroll
      for (int m = 0; m < 4; ++m) { bf16_t* rowp = O + (size_t)(row0 + ai * HALF + m * 16) * ldc + col0;
#pragma unroll
        for (int bj = 0; bj < 2; ++bj) { const f32x4 v0 = acc[ai][bj][m][0], v1 = acc[ai][bj][m][1];
          u32x4 w; w.x = cvtpk(v0[0], v0[1]); w.y = cvtpk(v0[2], v0[3]); w.z = cvtpk(v1[0], v1[1]); w.w = cvtpk(v1[2], v1[3]);
          *(u32x4*)(rowp + bj * HALF) = w; } }
  }
};
struct EpiResid {
  static constexpr bool PERM = true;
  const float* res_lat; const float* res_ctx; float* out_lat; float* out_ctx; const float* mod;
  __device__ __forceinline__ void operator()(const f32x4 (&acc)[2][2][4][2], const Unit& u, int wr, int wc, int fr, int fq) const {
    const int b = u.pm / 33, lt = u.pm - b * 33;
    const float* rb; float* ob; const float* g;
    if (lt == 0) { rb = res_ctx + (size_t)b * CTX * DM; ob = out_ctx + (size_t)b * CTX * DM; g = mod + 4 * 3072 + 2048; }
    else { const size_t o = ((size_t)b * SEQ + (size_t)(lt - 1) * 256) * DM; rb = res_lat + o; ob = out_lat + o; g = mod + b * 3072 + 2048; }
    const int lr0 = wr * 64 + fr, col0 = u.pn * BM + wc * 32 + 8 * fq;
    f32x4 gv[2][2];
#pragma unroll
    for (int bj = 0; bj < 2; ++bj)
#pragma unroll
      for (int n = 0; n < 2; ++n) gv[bj][n] = *(const f32x4*)(g + col0 + bj * HALF + n * 4);
#pragma unroll
    for (int ai = 0; ai < 2; ++ai)
#pragma unroll
      for (int m = 0; m < 4; ++m) { const size_t ro = (size_t)(lr0 + ai * HALF + m * 16) * DM + col0;
#pragma unroll
        for (int bj = 0; bj < 2; ++bj)
#pragma unroll
          for (int n = 0; n < 2; ++n) { const f32x4 r = *(const f32x4*)(rb + ro + bj * HALF + n * 4);
            *(f32x4*)(ob + ro + bj * HALF + n * 4) = r + gv[bj][n] * acc[ai][bj][m][n]; } }
  }
};

template <class Epi>
__device__ __forceinline__ void gemm_phase(LAS unsigned char* lds, const Gemm g, const StaticOrder& S, const Epi& E, const int tid) {
  const int wid = __builtin_amdgcn_readfirstlane(tid >> 6), lane = tid & 63, wr = wid >> 2, wc = wid & 3, fr = lane & 15, fq = lane >> 4;
  const int K = g.K, nt = K / BK, lda = g.lda;
  unsigned voffA[2], voffB[2];
#pragma unroll
  for (int i = 0; i < 2; ++i) { int R, C; stage_rc(tid * 16 + i * 8192, R, C); const int Rb = Epi::PERM ? ((R & ~31) + perm32(R & 31)) : R;
    voffA[i] = (unsigned)(R * lda + C) * 2u; voffB[i] = (unsigned)(Rb * K + C) * 2u; }
  const size_t kstep = (size_t)(BK * 2);
  const size_t hstepA = (size_t)HALF * lda * 2, hstepB = (size_t)HALF * K * 2;
  const size_t tstepA = 2 * hstepA, tstepB = 2 * hstepB;
  const unsigned ldsw = (unsigned)wid * 1024u;
  const int aoff = lds_byte(wr * 64 + fr, fq * 8), boff = lds_byte(wc * 32 + fr, fq * 8);
#define PG8_SA(b, h) (((b) * 2 + (h)) * HTB)
#define PG8_SB(b, h) ((4 + (b) * 2 + (h)) * HTB)
#define PG8_STAGE(bufoff, gbase, voff) do { _Pragma("unroll") for (int _i = 0; _i < 2; ++_i) \
    __builtin_amdgcn_global_load_lds((const unsigned*)((const char*)(gbase) + (voff)[_i]), (LAS unsigned*)(lds + (bufoff) + ldsw + _i * 8192), 16, 0, 0); } while (0)
#define PG8_LDA(dst, b, h) do { _Pragma("unroll") for (int m = 0; m < 4; ++m) _Pragma("unroll") for (int k = 0; k < 2; ++k) dst[m][k] = *(const LAS bf16x8*)(lds + PG8_SA(b, h) + aoff + m * 2048 + k * 1024); } while (0)
#define PG8_LDB(dst, b, h) do { _Pragma("unroll") for (int n = 0; n < 2; ++n) _Pragma("unroll") for (int k = 0; k < 2; ++k) dst[n][k] = *(const LAS bf16x8*)(lds + PG8_SB(b, h) + boff + n * 2048 + k * 1024); } while (0)
#define PG8_MMA(ai, bj, At, Bt) do { __builtin_amdgcn_s_setprio(1); _Pragma("unroll") for (int m = 0; m < 4; ++m) _Pragma("unroll") for (int n = 0; n < 2; ++n) _Pragma("unroll") for (int k = 0; k < 2; ++k) \
    acc[ai][bj][m][n] = __builtin_amdgcn_mfma_f32_16x16x32_bf16(Bt[n][k], At[m][k], acc[ai][bj][m][n], 0, 0, 0); __builtin_amdgcn_s_setprio(0); } while (0)
#define PG8_WAIT_V(n) asm volatile("s_waitcnt vmcnt(" #n ")" ::: "memory")
#define PG8_WAIT_L(n) asm volatile("s_waitcnt lgkmcnt(" #n ")" ::: "memory")
#define PG8_BAR __builtin_amdgcn_s_barrier()
#define PG8_SCHED __builtin_amdgcn_sched_barrier(0)
  Unit cur, nxt; int ui = 0;
  if (!S.next(0, cur)) return;
  f32x4 acc[2][2][4][2];
#pragma unroll
  for (int a = 0; a < 2; ++a)
#pragma unroll
    for (int b = 0; b < 2; ++b)
#pragma unroll
      for (int m = 0; m < 4; ++m)
#pragma unroll
        for (int n = 0; n < 2; ++n) acc[a][b][m][n] = (f32x4){0.f, 0.f, 0.f, 0.f};
  bf16x8 At[4][2], B0[2][2], B1[2][2];
  const char* cA = (const char*)g.A + (size_t)cur.pm * tstepA; const char* cB = (const char*)g.Bt + (size_t)cur.pn * tstepB;
  PG8_STAGE(PG8_SB(0, 0), cB, voffB); PG8_STAGE(PG8_SA(0, 0), cA, voffA); PG8_STAGE(PG8_SB(0, 1), cB + hstepB, voffB); PG8_STAGE(PG8_SA(0, 1), cA + hstepA, voffA);
  if (wr == 1) PG8_BAR;
  PG8_WAIT_V(4); PG8_BAR;
  PG8_STAGE(PG8_SB(1, 0), cB + kstep, voffB); PG8_STAGE(PG8_SA(1, 0), cA + kstep, voffA); PG8_STAGE(PG8_SB(1, 1), cB + hstepB + kstep, voffB);
  PG8_WAIT_V(6); PG8_BAR;
  for (;;) {
    const bool has_next = S.next(ui + 1, nxt);
    const char* nA = has_next ? (const char*)g.A + (size_t)nxt.pm * tstepA : cA; const char* nB = has_next ? (const char*)g.Bt + (size_t)nxt.pn * tstepB : cB;
    for (int t = 0; t < nt; t += 2) {
      const bool last = (t == nt - 2);
      const char* a1 = cA + (size_t)(t + 1) * kstep;
      const char* a2 = last ? nA : cA + (size_t)(t + 2) * kstep; const char* b2 = last ? nB : cB + (size_t)(t + 2) * kstep;
      const char* a3 = a2 + kstep; const char* b3 = b2 + kstep;
      PG8_LDB(B0, 0, 0); PG8_SCHED; PG8_LDA(At, 0, 0); PG8_STAGE(PG8_SA(1, 1), a1 + hstepA, voffA);
      PG8_WAIT_L(8); PG8_BAR; PG8_WAIT_L(0); PG8_MMA(0, 0, At, B0); PG8_BAR; PG8_SCHED;
      PG8_LDB(B1, 0, 1); PG8_STAGE(PG8_SB(0, 0), b2, voffB);
      PG8_BAR; PG8_WAIT_L(0); PG8_MMA(0, 1, At, B1); PG8_BAR;
      PG8_LDA(At, 0, 1); PG8_STAGE(PG8_SA(0, 0), a2, voffA);
      PG8_BAR; PG8_WAIT_L(0); PG8_MMA(1, 0, At, B0); PG8_BAR; PG8_SCHED;
      PG8_STAGE(PG8_SB(0, 1), b2 + hstepB, voffB);
      PG8_WAIT_V(6); PG8_BAR; PG8_MMA(1, 1, At, B1); PG8_BAR;
      PG8_LDB(B0, 1, 0); PG8_SCHED; PG8_LDA(At, 1, 0); PG8_STAGE(PG8_SA(0, 1), a2 + hstepA, voffA);
      PG8_WAIT_L(8); PG8_BAR; PG8_WAIT_L(0); PG8_MMA(0, 0, At, B0); PG8_BAR; PG8_SCHED;
      PG8_LDB(B1, 1, 1); PG8_STAGE(PG8_SB(1, 0), b3, voffB);
      PG8_BAR; PG8_WAIT_L(0); PG8_MMA(0, 1, At, B1); PG8_BAR;
      PG8_LDA(At, 1, 1); PG8_STAGE(PG8_SA(1, 0), a3, voffA);
      PG8_BAR; PG8_WAIT_L(0); PG8_MMA(1, 0, At, B0); PG8_BAR; PG8_SCHED;
      PG8_STAGE(PG8_SB(1, 1), b3 + hstepB, voffB);
      PG8_WAIT_V(6); PG8_BAR; PG8_MMA(1, 1, At, B1); PG8_BAR;
    }
    E(acc, cur, wr, wc, fr, fq);
    if (!has_next) break;
#pragma unroll
    for (int a = 0; a < 2; ++a)
#pragma unroll
      for (int b = 0; b < 2; ++b)
#pragma unroll
        for (int m = 0; m < 4; ++m)
#pragma unroll
          for (int n = 0; n < 2; ++n) acc[a][b][m][n] = (f32x4){0.f, 0.f, 0.f, 0.f};
    cur = nxt; cA = nA; cB = nB; ++ui;
  }
  PG8_WAIT_V(0);
  if (wr == 0) PG8_BAR;
  PG8_BAR;
#undef PG8_SA
#undef PG8_SB
#undef PG8_STAGE
#undef PG8_LDA
#undef PG8_LDB
#undef PG8_MMA
#undef PG8_WAIT_V
#undef PG8_WAIT_L
#undef PG8_BAR
#undef PG8_SCHED
}
}

#define SBAR() __builtin_amdgcn_sched_barrier(0)
__device__ __forceinline__ int crow(int r, int hi) { return (r & 3) + 8 * (r >> 2) + 4 * hi; }
constexpr float THR = 8.f;
template <int DQK> struct ScaleOf;
template <> struct ScaleOf<64> { static constexpr float v = 0.125f; };
template <> struct ScaleOf<128> { static constexpr float v = 0.088388347648318440f; };
template <> struct ScaleOf<192> { static constexpr float v = 0.072168783648703220f; };

template <int DQK>
__device__ __forceinline__ void partialSM(f32x16& p0, f32x16& p1, float& m_reg, float& mn, float& alpha) {
  constexpr float SCALE = ScaleOf<DQK>::v, C = SCALE * 1.4426950408889634f;
  float pmax = p0[0];
#pragma unroll
  for (int r = 1; r < 16; ++r) pmax = fmaxf(pmax, p0[r]);
#pragma unroll
  for (int r = 0; r < 16; ++r) pmax = fmaxf(pmax, p1[r]);
  { auto rr = __builtin_amdgcn_permlane32_swap(__float_as_uint(pmax), __float_as_uint(pmax), false, false);
    pmax = fmaxf(__uint_as_float(rr[0]), __uint_as_float(rr[1])); }
  if (__builtin_expect(__all(pmax - m_reg <= THR / SCALE), 1)) { mn = m_reg; alpha = 1.f; }
  else { mn = fmaxf(m_reg, pmax); alpha = __builtin_amdgcn_exp2f((m_reg - mn) * C); m_reg = mn; }
  const float mnC = -mn * C;
#pragma unroll
  for (int r = 0; r < 16; ++r) p0[r] = fmaf(p0[r], C, mnC);
#pragma unroll
  for (int r = 0; r < 16; ++r) p1[r] = fmaf(p1[r], C, mnC);
#pragma unroll
  for (int r = 0; r < 16; ++r) p0[r] = __builtin_amdgcn_exp2f(p0[r]);
}
__device__ __forceinline__ void finishSM(f32x16& p0, f32x16& p1, float alpha, float& l_reg, bf16x8& pa0, bf16x8& pa1, bf16x8& pa2, bf16x8& pa3) {
#pragma unroll
  for (int r = 0; r < 16; ++r) p1[r] = __builtin_amdgcn_exp2f(p1[r]);
  float ps = 0;
#pragma unroll
  for (int r = 0; r < 16; ++r) ps += p0[r];
#pragma unroll
  for (int r = 0; r < 16; ++r) ps += p1[r];
  { auto rr = __builtin_amdgcn_permlane32_swap(__float_as_uint(ps), __float_as_uint(ps), false, false);
    ps = __uint_as_float(rr[0]) + __uint_as_float(rr[1]); }
  l_reg = l_reg * alpha + ps;
#define PK4(P, BASE, OUT) do { unsigned a0 = cvtpk(P[BASE + 0], P[BASE + 1]), a1 = cvtpk(P[BASE + 2], P[BASE + 3]);   \
    unsigned b0 = cvtpk(P[BASE + 4], P[BASE + 5]), b1 = cvtpk(P[BASE + 6], P[BASE + 7]);                              \
    auto r0 = __builtin_amdgcn_permlane32_swap(a0, b0, false, false); auto r1 = __builtin_amdgcn_permlane32_swap(a1, b1, false, false); \
    u32x4 w = {r0[0], r1[0], r0[1], r1[1]}; OUT = *reinterpret_cast<bf16x8*>(&w); } while (0)
  PK4(p0, 0, pa0); PK4(p0, 8, pa1); PK4(p1, 0, pa2); PK4(p1, 8, pa3);
#undef PK4
}
template <int DQK>
__device__ __forceinline__ void qkt(f32x16& p0, f32x16& p1, const char* Ks, const bf16x8* qr, int r32, int hi) {
  constexpr int RB = DQK * 2;
  p0 = f32x16{}; p1 = f32x16{};
#pragma unroll
  for (int d0 = 0; d0 < DQK / 16; ++d0) { const int cb = (d0 * 16 + hi * 8) * 2;
    const int sw = (DQK >= 128 && d0 < 8) ? ((r32 & 15) << 4) : ((r32 & 7) << 4);
    bf16x8 b0 = *reinterpret_cast<const bf16x8*>(Ks + r32 * RB + (cb ^ sw));
    bf16x8 b1 = *reinterpret_cast<const bf16x8*>(Ks + (32 + r32) * RB + (cb ^ sw));
    p0 = __builtin_amdgcn_mfma_f32_32x32x16_bf16(b0, qr[d0], p0, 0, 0, 0);
    p1 = __builtin_amdgcn_mfma_f32_32x32x16_bf16(b1, qr[d0], p1, 0, 0, 0); }
}
template <int NCB> __device__ __forceinline__ int v_st(int k, int c) { const int kk = (k & ~0xC) | ((k & 4) << 1) | ((k & 8) >> 1); return ((kk >> 3) * NCB + (c >> 5)) * 512 + ((kk & 7) * 32 + (c & 31)) * 2; }
__device__ __forceinline__ int v_rd_base(int lane) { return ((lane & 3) << 3) | (((lane >> 2) & 3) << 6) | (((lane >> 4) & 1) << 5) | (((lane >> 5) & 1) << 8); }
template <int OFF> __device__ __forceinline__ s16x4 tr_read(int vb) {
  s16x4 r; asm volatile("ds_read_b64_tr_b16 %0, %1 offset:%2" : "=&v"(r) : "v"(vb), "i"(OFF) : "memory"); return r;
}
template <int NCB, int D0> __device__ __forceinline__ void pv_one(f32x16& od, int vb, bf16x8 pa0, bf16x8 pa1, bf16x8 pa2, bf16x8 pa3) {
#define VOFF(ks, half) (D0 * 512 + (ks) * (NCB * 1024) + (half) * (NCB * 512))
  const s16x4 l0 = tr_read<VOFF(0, 0)>(vb), h0 = tr_read<VOFF(0, 1)>(vb), l1 = tr_read<VOFF(1, 0)>(vb), h1 = tr_read<VOFF(1, 1)>(vb);
  const s16x4 l2 = tr_read<VOFF(2, 0)>(vb), h2 = tr_read<VOFF(2, 1)>(vb), l3 = tr_read<VOFF(3, 0)>(vb), h3 = tr_read<VOFF(3, 1)>(vb);
#undef VOFF
  asm volatile("s_waitcnt lgkmcnt(0)" ::: "memory"); SBAR();
#define PK(L, H) (bf16x8){L[0], L[1], L[2], L[3], H[0], H[1], H[2], H[3]}
  od = __builtin_amdgcn_mfma_f32_32x32x16_bf16(pa0, PK(l0, h0), od, 0, 0, 0);
  od = __builtin_amdgcn_mfma_f32_32x32x16_bf16(pa1, PK(l1, h1), od, 0, 0, 0);
  od = __builtin_amdgcn_mfma_f32_32x32x16_bf16(pa2, PK(l2, h2), od, 0, 0, 0);
  od = __builtin_amdgcn_mfma_f32_32x32x16_bf16(pa3, PK(l3, h3), od, 0, 0, 0);
#undef PK
}
template <int NCB> __device__ __forceinline__ void pv_all(f32x16* o, int vb, bf16x8 pa0, bf16x8 pa1, bf16x8 pa2, bf16x8 pa3) {
  pv_one<NCB, 0>(o[0], vb, pa0, pa1, pa2, pa3); pv_one<NCB, 1>(o[1], vb, pa0, pa1, pa2, pa3);
  if constexpr (NCB == 4) { pv_one<NCB, 2>(o[2], vb, pa0, pa1, pa2, pa3); pv_one<NCB, 3>(o[3], vb, pa0, pa1, pa2, pa3); }
}

template <int DQK, int DV, int MODE, int QPOST, int ldq, int ldk, int ldo>
__device__ __forceinline__ void attn_body_seq(const bf16_t* __restrict__ Qb, const bf16_t* __restrict__ Kp, const bf16_t* __restrict__ K2p, const bf16_t* __restrict__ Vp,
                                              int krow_base, bf16_t* __restrict__ OG, int NT, int na_r0, char* lds, int tid, int dummy, const float* qgain, const float2* qtab, int q_t0) {
  constexpr int NQ = DQK / 16, NCB = DV / 32, SHM_K = 64 * DQK * 2, SHM_V = 64 * DV * 2, RB = DQK * 2;
  constexpr int NKC = DQK / 64, NVC = DV / 64;
  const int wid = tid >> 6, lane = tid & 63, r32 = lane & 31, hi = lane >> 5;
  char* V_lds = lds; char* K_lds = lds + 2 * SHM_V;
  float* wsl = (float*)(lds + 2 * SHM_V + 2 * SHM_K) + wid * 64; float* li_l = wsl; float* al_l = wsl + 32;
  const float* bias_l = (const float*)(lds + 2 * SHM_V + 2 * SHM_K + 8 * 64 * 4);
  float m_reg = -1e30f, l_reg = 0; f32x16 o[NCB]; bf16x8 qr[NQ];
#pragma unroll
  for (int d = 0; d < NCB; ++d) o[d] = f32x16{};
  const bf16_t* Qw = Qb + (size_t)(wid * 32 + r32) * ldq + hi * 8;
#pragma unroll
  for (int d0 = 0; d0 < NQ; ++d0) qr[d0] = *reinterpret_cast<const bf16x8*>(Qw + d0 * 16);
  if constexpr (QPOST == 1) {
    float xq[8][8]; float ss = 0;
#pragma unroll
    for (int d0 = 0; d0 < 8; ++d0)
#pragma unroll
      for (int j = 0; j < 8; ++j) { xq[d0][j] = bf2f(qr[d0][j]); ss += xq[d0][j] * xq[d0][j]; }
    { auto rr = __builtin_amdgcn_permlane32_swap(__float_as_uint(ss), __float_as_uint(ss), false, false); ss = __uint_as_float(rr[0]) + __uint_as_float(rr[1]); }
    const float rstd = rsqrtf(ss * (1.f / 128.f) + EPS);
#pragma unroll
    for (int d0 = 0; d0 < 8; ++d0) { const f32x4 g0 = *(const f32x4*)(qgain + d0 * 16 + hi * 8), g1 = *(const f32x4*)(qgain + d0 * 16 + hi * 8 + 4);
#pragma unroll
      for (int j = 0; j < 4; ++j) { xq[d0][j] *= rstd * g0[j]; xq[d0][4 + j] *= rstd * g1[j]; } }
    if (q_t0 >= 0) { const int t = q_t0 + wid * 32 + r32, prow = t >> 6, pcol = t & 63;
#pragma unroll
      for (int dd = 0; dd < 4; ++dd) { const int d0 = (dd & 1) + (dd >> 1) * 4, pos = (dd >> 1) ? pcol : prow; const float2* tp = qtab + pos * 32 + (d0 & 1) * 16 + hi * 8;
#pragma unroll
        for (int j = 0; j < 8; ++j) { const float2 cs = tp[j]; const float x0 = xq[d0][j], x1 = xq[d0 + 2][j]; xq[d0][j] = x0 * cs.x - x1 * cs.y; xq[d0 + 2][j] = x1 * cs.x + x0 * cs.y; } } }
#pragma unroll
    for (int d0 = 0; d0 < 8; ++d0) qr[d0] = pack8(xq[d0]);
  }
  if constexpr (DQK == 192) {
    if (q_t0 >= 0) { const int t = q_t0 + wid * 32 + r32, prow = t >> 6, pcol = t & 63;
#pragma unroll
      for (int ax = 0; ax < 2; ++ax) { const float2* tp = qtab + (ax ? pcol : prow) * 16 + hi * 8; float y0[8], y1[8];
#pragma unroll
        for (int j = 0; j < 8; ++j) { const float2 cs = tp[j]; const float x0 = bf2f(qr[8 + 2 * ax][j]), x1 = bf2f(qr[9 + 2 * ax][j]); y0[j] = x0 * cs.x - x1 * cs.y; y1[j] = x1 * cs.x + x0 * cs.y; }
        qr[8 + 2 * ax] = pack8(y0); qr[9 + 2 * ax] = pack8(y1); } }
  }
  const int sr = tid >> 4, sc = (tid & 15) * 8, sr8 = tid >> 3, sc8 = (tid & 7) * 8;
  const int vb0 = (int)(uintptr_t)V_lds + v_rd_base(lane);
  auto tile_row = [&](int j) -> int {
    if constexpr (MODE == 0) return krow_base + j * 64;
    else { if (j < 4) return krow_base + j * 64; int kr = na_r0 - 8 + j; kr = kr < 0 ? 0 : (kr > 127 ? 127 : kr); return krow_base + CTX + kr * 64; }
  };
  auto na_mask = [&](f32x16& p0, f32x16& p1, int j) {
    if constexpr (MODE == 1) {
      if (j >= 4) {
        const int krraw = na_r0 - 8 + j, r = na_r0 + (wid >> 1);
        int rs = r - 4; rs = rs < 0 ? 0 : (rs > 120 ? 120 : rs);
        const float NINF = -__builtin_inff();
        if (krraw < rs || krraw >= rs + 8) {
#pragma unroll
          for (int q = 0; q < 16; ++q) { p0[q] = NINF; p1[q] = NINF; }
        } else {
          const float* brow = bias_l + (krraw - r + 7) * 32;
          const int c = (wid & 1) * 32 + r32; int cs = c - 8; cs = cs < 0 ? 0 : (cs > 48 ? 48 : cs);
#pragma unroll
          for (int q = 0; q < 16; ++q) {
            const int k0 = crow(q, hi), k1 = 32 + k0;
            int i0 = k0 - c + 15, i1 = k1 - c + 15; i0 = i0 < 0 ? 0 : (i0 > 30 ? 30 : i0); i1 = i1 < 0 ? 0 : (i1 > 30 ? 30 : i1);
            const float b0 = brow[i0], b1 = brow[i1];
            p0[q] = (k0 >= cs && k0 < cs + 16) ? p0[q] + b0 : NINF;
            p1[q] = (k1 >= cs && k1 < cs + 16) ? p1[q] + b1 : NINF;
          }
        }
      }
    }
  };
  bf16x8 sk[NKC], sv[NVC];
#define SLOAD(j) do { const size_t kr_ = (size_t)tile_row(j);                                                                      \
    if constexpr (DQK >= 128) { sk[0] = *reinterpret_cast<const bf16x8*>(Kp + (kr_ + sr) * ldk + sc); sk[1] = *reinterpret_cast<const bf16x8*>(Kp + (kr_ + 32 + sr) * ldk + sc); } \
    if constexpr (DQK == 192) sk[2] = *reinterpret_cast<const bf16x8*>(K2p + (kr_ + sr8) * ldk + sc8);                                       \
    if constexpr (DQK == 64) sk[0] = *reinterpret_cast<const bf16x8*>(Kp + (kr_ + sr8) * ldk + sc8);                                         \
    if constexpr (DV == 128) { sv[0] = *reinterpret_cast<const bf16x8*>(Vp + (kr_ + sr) * ldk + sc); sv[1] = *reinterpret_cast<const bf16x8*>(Vp + (kr_ + 32 + sr) * ldk + sc); } \
    else sv[0] = *reinterpret_cast<const bf16x8*>(Vp + (kr_ + sr8) * ldk + sc8); } while (0)
#define KSW(row, colB) ((row) * RB + ((colB) ^ ((((DQK >= 128) && ((colB) < 256)) ? ((row) & 15) : ((row) & 7)) << 4)))
#define SWRITE(b) do {                                                                                                                          \
    if constexpr (DV == 128) { *(bf16x8*)(V_lds + (b) * SHM_V + v_st<NCB>(sr, sc)) = sv[0]; *(bf16x8*)(V_lds + (b) * SHM_V + v_st<NCB>(32 + sr, sc)) = sv[1]; } \
    else *(bf16x8*)(V_lds + (b) * SHM_V + v_st<NCB>(sr8, sc8)) = sv[0];                                                                        \
    if constexpr (DQK >= 128) { *(bf16x8*)(K_lds + (b) * SHM_K + KSW(sr, sc * 2)) = sk[0]; *(bf16x8*)(K_lds + (b) * SHM_K + KSW(32 + sr, sc * 2)) = sk[1]; } \
    if constexpr (DQK == 192) *(bf16x8*)(K_lds + (b) * SHM_K + KSW(sr8, 256 + sc8 * 2)) = sk[2];                                              \
    if constexpr (DQK == 64) *(bf16x8*)(K_lds + (b) * SHM_K + KSW(sr8, sc8 * 2)) = sk[0]; } while (0)
  SLOAD(0); asm volatile("s_waitcnt vmcnt(0)" ::: "memory"); SWRITE(0); __syncthreads();
  for (int j = 0; j < NT; ++j) {
    const int bsel = j & 1;
    if (j + 1 < NT) SLOAD(j + 1);
    SBAR();
    bool skip = false;
    if constexpr (MODE == 1) { if (j >= 4) { const int krraw = na_r0 - 8 + j, r = na_r0 + (wid >> 1); int rs = r - 4; rs = rs < 0 ? 0 : (rs > 120 ? 120 : rs); skip = (krraw < rs) || (krraw >= rs + 8); } }
    if (!skip) {
    f32x16 p0, p1; float mn, al; bf16x8 pa0, pa1, pa2, pa3;
    qkt<DQK>(p0, p1, K_lds + bsel * SHM_K, qr, r32, hi);
    na_mask(p0, p1, j);
    partialSM<DQK>(p0, p1, m_reg, mn, al);
    finishSM(p0, p1, al, l_reg, pa0, pa1, pa2, pa3);
    if (__any(al < 1.f)) { if (hi == 0) al_l[r32] = al; asm volatile("s_waitcnt lgkmcnt(0)" ::: "memory");
#pragma unroll
      for (int d = 0; d < NCB; ++d)
#pragma unroll
        for (int r = 0; r < 16; ++r) o[d][r] *= al_l[crow(r, hi)]; }
    SBAR();
    pv_all<NCB>(o, vb0 + bsel * SHM_V, pa0, pa1, pa2, pa3);
    }
    if (j + 1 < NT) SWRITE(bsel ^ 1);
    __syncthreads();
  }
  if (dummy) { if (l_reg == 123.456f) OG[tid] = (bf16_t)(cvtpk(o[0][0], o[1][3]) & 0xffffu); return; }
  if (hi == 0) li_l[r32] = l_reg; asm volatile("s_waitcnt lgkmcnt(0)" ::: "memory");
  float rli[16];
#pragma unroll
  for (int r = 0; r < 16; ++r) rli[r] = __builtin_amdgcn_rcpf(li_l[crow(r, hi)]);
  bf16_t* Ow = OG + (size_t)(wid * 32) * ldo;
#pragma unroll
  for (int r = 0; r < 16; ++r) { const int orow = crow(r, hi);
#pragma unroll
    for (int d0 = 0; d0 < NCB; ++d0) { bf16_t* pp = Ow + (size_t)orow * ldo + d0 * 32 + r32;
      const float g = bf2f((short)*pp); const float v = o[d0][r] * rli[r] * silu_f(g);
      *pp = (bf16_t)(cvtpk(v, v) & 0xffffu); } }
#undef SLOAD
#undef SWRITE
#undef KSW
}

__device__ __forceinline__ void phase_pre(KP p, char* lds, const int tid) {
  float* tl = (float*)lds;
  for (int tt = blockIdx.x; tt < WTAB.ntiles; tt += gridDim.x) {
    int di = 0;
    for (int i = 1; i < NWD; ++i) if (tt >= WTAB.d[i].tile0) di = i;
    const WDesc wd = WTAB.d[di];
    const float* src = p->in[wd.in_idx] + wd.src_off; bf16_t* dst = (bf16_t*)(p->ws + OFF_W) + wd.dst_off; const int K = wd.K, N = wd.N, local = tt - wd.tile0;
    const int nkt = K >> 6, kt = local % nkt, ntile = local / nkt;
    const int kk = tid >> 3, n8 = (tid & 7) * 8;
    f32x4 a = {0.f, 0.f, 0.f, 0.f}, b = a;
    if (ntile * 64 < N) { const float* sp = src + (size_t)(kt * 64 + kk) * N + ntile * 64 + n8; a = *(const f32x4*)sp; b = *(const f32x4*)(sp + 4); }
    __syncthreads();
#pragma unroll
    for (int i = 0; i < 4; ++i) { tl[(n8 + i) * 65 + kk] = a[i]; tl[(n8 + 4 + i) * 65 + kk] = b[i]; }
    __syncthreads();
    const int n = tid >> 3, k8 = (tid & 7) * 8; float v[8];
#pragma unroll
    for (int i = 0; i < 8; ++i) v[i] = tl[n * 65 + k8 + i];
    *(bf16x8*)(dst + (size_t)(ntile * 64 + n) * K + kt * 64 + k8) = pack8(v);
  }
  float* part = (float*)(p->ws + OFF_MODP);
  for (int it = blockIdx.x; it < 4 * 16 * 6; it += gridDim.x) {
    const int nb = it % 6, kc = (it / 6) & 15, layer = it / 96;
    __syncthreads();
    if (tid < 320) { const int s = tid >> 6, kk = tid & 63; const float cv = s < 4 ? p->in[IN_C][s * DM + kc * 64 + kk] : p->in[IN_CCTX][kc * 64 + kk]; tl[tid] = silu_f(cv); }
    __syncthreads();
    const int n = nb * 512 + tid; const float* wp = p->in[IN_MODW] + ((size_t)layer * DM + kc * 64) * 3072 + n;
    float a0 = 0, a1 = 0, a2 = 0, a3 = 0, a4 = 0;
#pragma unroll 8
    for (int kk = 0; kk < 64; ++kk) { const float w = wp[(size_t)kk * 3072]; a0 += tl[kk] * w; a1 += tl[64 + kk] * w; a2 += tl[128 + kk] * w; a3 += tl[192 + kk] * w; a4 += tl[256 + kk] * w; }
    float* pp = part + ((size_t)(kc * 4 + layer) * 5) * 3072 + n;
    pp[0] = a0; pp[3072] = a1; pp[2 * 3072] = a2; pp[3 * 3072] = a3; pp[4 * 3072] = a4;
  }
  for (int i = blockIdx.x * NTHREADS + tid; i < 128 * 48; i += gridDim.x * NTHREADS) {
    int pos, f; float inv; float2* dstp;
    if (i < 128 * 32) { pos = i >> 5; f = i & 31; inv = INV_A[f]; dstp = (float2*)(p->ws + OFF_TABA) + i; }
    else { const int q = i - 128 * 32; pos = q >> 4; f = q & 15; inv = INV_M[f]; dstp = (float2*)(p->ws + OFF_TABM) + q; }
    const float angf = (float)pos * inv;
    const double ang = (double)angf, k = __builtin_rint(ang * 0.15915494309189535), r = ang - k * 6.283185307179586476925287, r2 = r * r;
    double sn = r, cs = 1.0, ts = r, tc = 1.0;
#pragma unroll 1
    for (int q = 1; q <= 14; ++q) { tc = -tc * r2 / (double)((2 * q - 1) * (2 * q)); cs += tc; ts = -ts * r2 / (double)((2 * q) * (2 * q + 1)); sn += ts; }
    *dstp = make_float2((float)cs, (float)sn);
  }
}
__device__ __forceinline__ void phase_modfin(KP p, const int tid) {
  const float* part = (const float*)(p->ws + OFF_MODP); float* mod = (float*)(p->ws + OFF_MOD);
  for (int i = blockIdx.x * NTHREADS + tid; i < 4 * 5 * 3072; i += gridDim.x * NTHREADS) {
    const int n = i % 3072, layer = i / (5 * 3072);
    float a = p->in[IN_MODB][layer * 3072 + n];
#pragma unroll
    for (int kc = 0; kc < 16; ++kc) a += part[(size_t)kc * (4 * 5 * 3072) + i];
    mod[i] = a;
  }
}
__device__ __forceinline__ void phase_norm(KP p, int layer, const int tid) {
  const int lane = tid & 63, gw = blockIdx.x * 8 + (tid >> 6), nw = gridDim.x * 8;
  const float* mod = (const float*)(p->ws + OFF_MOD) + (size_t)layer * 5 * 3072; const float* g = p->in[IN_NORMG] + layer * DM; bf16_t* hb = (bf16_t*)(p->ws + OFF_HB);
  for (int row0 = gw * 4; row0 < T; row0 += nw * 4) {
    f32x4 v[4][4];
#pragma unroll
    for (int r = 0; r < 4; ++r) { const float* xr = res_src(p, layer, row0 + r);
#pragma unroll
      for (int i = 0; i < 4; ++i) v[r][i] = *(const f32x4*)(xr + i * 256 + lane * 4); }
    const int b = row0 / TPB, j = row0 - b * TPB; const float* m = mod + (j < CTX ? 4 : b) * 3072;
    f32x4 gm[4], sh[4];
#pragma unroll
    for (int i = 0; i < 4; ++i) { const int col = i * 256 + lane * 4; const f32x4 gg = *(const f32x4*)(g + col), scl = *(const f32x4*)(m + 1024 + col); sh[i] = *(const f32x4*)(m + col); gm[i] = gg * (1.f + scl); }
#pragma unroll
    for (int r = 0; r < 4; ++r) {
      float ss = 0;
#pragma unroll
      for (int i = 0; i < 4; ++i) ss += v[r][i][0] * v[r][i][0] + v[r][i][1] * v[r][i][1] + v[r][i][2] * v[r][i][2] + v[r][i][3] * v[r][i][3];
      ss = wave_sum(ss); const float rstd = rsqrtf(ss * (1.f / DM) + EPS);
#pragma unroll
      for (int i = 0; i < 4; ++i) { const int col = i * 256 + lane * 4; const f32x4 y = v[r][i] * rstd * gm[i] + sh[i];
        u32x2 w = {cvtpk(y[0], y[1]), cvtpk(y[2], y[3])}; *(u32x2*)(hb + (size_t)(row0 + r) * DM + col) = w; }
    }
  }
}
__device__ __forceinline__ void phase_final(KP p, int dummy, const int tid) {
  const int lane = tid & 63, gw = blockIdx.x * 8 + (tid >> 6), nw = gridDim.x * 8;
  const float* outp = p->out; float* dstp = dummy ? (float*)(p->ws + OFF_PJ) : p->out; const float* fg = p->in[IN_FINALG];
  f32x4 gg[4];
#pragma unroll
  for (int i = 0; i < 4; ++i) gg[i] = *(const f32x4*)(fg + i * 256 + lane * 4);
  for (int row0 = gw * 4; row0 < NB * SEQ; row0 += nw * 4) {
    f32x4 v[4][4];
#pragma unroll
    for (int r = 0; r < 4; ++r)
#pragma unroll
      for (int i = 0; i < 4; ++i) v[r][i] = *(const f32x4*)(outp + (size_t)(row0 + r) * DM + i * 256 + lane * 4);
#pragma unroll
    for (int r = 0; r < 4; ++r) {
      float ss = 0;
#pragma unroll
      for (int i = 0; i < 4; ++i) ss += v[r][i][0] * v[r][i][0] + v[r][i][1] * v[r][i][1] + v[r][i][2] * v[r][i][2] + v[r][i][3] * v[r][i][3];
      ss = wave_sum(ss); const float rstd = rsqrtf(ss * (1.f / DM) + EPS);
#pragma unroll
      for (int i = 0; i < 4; ++i) *(f32x4*)(dstp + (size_t)(row0 + r) * DM + i * 256 + lane * 4) = v[r][i] * rstd * gg[i];
    }
  }
}
__device__ __forceinline__ void phase_gqa_post(KP p, int j, int dummy, const int tid) {
  const int lane = tid & 63, gw = blockIdx.x * 8 + (tid >> 6), nw = gridDim.x * 8, g4 = lane >> 4, i = lane & 15;
  bf16_t* pj = (bf16_t*)(p->ws + (dummy ? OFF_QM : OFF_PJ)); const int ldp = dummy ? 1280 : 2560; const float2* tab = (const float2*)(p->ws + OFF_TABA);
  const float* kg = p->in[IN_GA_KG] + j * 128 + i * 8;
  float gk[8];
#pragma unroll
  for (int e = 0; e < 8; ++e) gk[e] = kg[e];
  const int axis = i >> 3, half = (i >> 2) & 1;
  for (int wi0 = gw * 4; wi0 < T * 2 / 4; wi0 += nw * 4) {
    bf16x8 raw[4]; bf16_t* ptr[4]; int rw[4];
#pragma unroll
    for (int u = 0; u < 4; ++u) { const int hv = (wi0 + u) * 4 + g4; rw[u] = hv >> 1; ptr[u] = pj + (size_t)rw[u] * ldp + 1024 + (hv & 1) * 128 + i * 8; raw[u] = *(const bf16x8*)ptr[u]; }
#pragma unroll
    for (int u = 0; u < 4; ++u) {
      float x[8]; float ss = 0;
#pragma unroll
      for (int e = 0; e < 8; ++e) { x[e] = bf2f(raw[u][e]); ss += x[e] * x[e]; }
      ss += __shfl_xor(ss, 1); ss += __shfl_xor(ss, 2); ss += __shfl_xor(ss, 4); ss += __shfl_xor(ss, 8);
      const float rstd = rsqrtf(ss * (1.f / 128.f) + EPS);
#pragma unroll
      for (int e = 0; e < 8; ++e) x[e] = x[e] * rstd * gk[e];
      const int b = rw[u] / TPB, jj = rw[u] - b * TPB; const bool lat = jj >= CTX; const int t = jj - CTX;
      const int pos = lat ? (axis ? (t & 63) : (t >> 6)) : 0;
      float y[8];
#pragma unroll
      for (int e = 0; e < 8; ++e) { const float xp = __shfl_xor(x[e], 4); const float2 cs = tab[pos * 32 + (i & 3) * 8 + e];
        y[e] = lat ? (half ? x[e] * cs.x + xp * cs.y : x[e] * cs.x - xp * cs.y) : x[e]; }
      *(bf16x8*)ptr[u] = pack8(y);
    }
  }
}
__device__ __forceinline__ void phase_mla_post1(KP p, int dummy, const int tid) {
  const int lane = tid & 63, gw = blockIdx.x * 8 + (tid >> 6), nw = gridDim.x * 8;
  bf16_t* pj = (bf16_t*)(p->ws + (dummy ? OFF_HB : OFF_PJ)); const int ldp = dummy ? 1024 : 2048; const float2* tab = (const float2*)(p->ws + OFF_TABM); const float* qgp = p->in[IN_ML_QG]; const float* kvgp = p->in[IN_ML_KVG];
  const int l2 = lane & 31, l3 = lane & 7;
  float gq[8], gkv[8];
#pragma unroll
  for (int e = 0; e < 8; ++e) { gq[e] = qgp[lane * 8 + e]; gkv[e] = kvgp[l2 * 8 + e]; }
  for (int row0 = gw * 2; row0 < T; row0 += nw * 2) {
    bf16x8 rq[2], rkv[2], rr[2];
#pragma unroll
    for (int u = 0; u < 2; ++u) { bf16_t* pr = pj + (size_t)(row0 + u) * ldp; rq[u] = *(const bf16x8*)(pr + lane * 8); rkv[u] = *(const bf16x8*)(pr + 512 + l2 * 8); rr[u] = *(const bf16x8*)(pr + 768 + l3 * 8); }
#pragma unroll
    for (int u = 0; u < 2; ++u) {
      const int row = row0 + u; bf16_t* pr = pj + (size_t)row * ldp;
      { float x[8]; float ss = 0;
#pragma unroll
        for (int e = 0; e < 8; ++e) { x[e] = bf2f(rq[u][e]); ss += x[e] * x[e]; }
        ss = wave_sum(ss); const float rstd = rsqrtf(ss * (1.f / 512.f) + EPS);
#pragma unroll
        for (int e = 0; e < 8; ++e) x[e] = x[e] * rstd * gq[e];
        *(bf16x8*)(pr + lane * 8) = pack8(x); }
      { float x[8]; float ss = 0;
#pragma unroll
        for (int e = 0; e < 8; ++e) { x[e] = bf2f(rkv[u][e]); ss += x[e] * x[e]; }
        ss = wave_sum(ss) * 0.5f; const float rstd = rsqrtf(ss * (1.f / 256.f) + EPS);
#pragma unroll
        for (int e = 0; e < 8; ++e) x[e] = x[e] * rstd * gkv[e];
        if (lane < 32) *(bf16x8*)(pr + 512 + l2 * 8) = pack8(x); }
      { const int b = row / TPB, jj = row - b * TPB; const bool lat = jj >= CTX; const int t = jj - CTX;
        const int axis = l3 >> 2, half = (l3 >> 1) & 1, pos = lat ? (axis ? (t & 63) : (t >> 6)) : 0; float y[8];
#pragma unroll
        for (int e = 0; e < 8; ++e) { const float x = bf2f(rr[u][e]); const float xp = __shfl_xor(x, 2); const float2 cs = tab[pos * 16 + (l3 & 1) * 8 + e];
          y[e] = half ? x * cs.x + xp * cs.y : x * cs.x - xp * cs.y; }
        if (lat && lane < 8) *(bf16x8*)(pr + 768 + l3 * 8) = pack8(y); }
    }
  }
}
__device__ __forceinline__ void phase_mla_post2(KP p, const int tid) {
  const int lane = tid & 63, gw = blockIdx.x * 8 + (tid >> 6), nw = gridDim.x * 8, h = lane >> 3, i = lane & 7;
  bf16_t* qm = (bf16_t*)(p->ws + OFF_QM); const float2* tab = (const float2*)(p->ws + OFF_TABM);
  const int axis = i >> 2, half = (i >> 1) & 1;
  for (int lr0 = gw * 4; lr0 < NB * SEQ; lr0 += nw * 4) {
    bf16x8 raw[4]; bf16_t* ptr[4];
#pragma unroll
    for (int u = 0; u < 4; ++u) { const int lr = lr0 + u, b = lr >> 13, t = lr & 8191; ptr[u] = qm + ((size_t)b * TPB + CTX + t) * 1536 + h * 192 + 128 + i * 8; raw[u] = *(const bf16x8*)ptr[u]; }
#pragma unroll
    for (int u = 0; u < 4; ++u) { const int t = (lr0 + u) & 8191, pos = axis ? (t & 63) : (t >> 6); float y[8];
#pragma unroll
      for (int e = 0; e < 8; ++e) { const float x = bf2f(raw[u][e]); const float xp = __shfl_xor(x, 2); const float2 cs = tab[pos * 16 + (i & 1) * 8 + e];
        y[e] = half ? x * cs.x + xp * cs.y : x * cs.x - xp * cs.y; }
      *(bf16x8*)ptr[u] = pack8(y); }
  }
}
__device__ __forceinline__ void phase_att_gqa(KP p, int need_ctx, int dummy, int jl, char* lds, const int tid) {
  bf16_t* pj = (bf16_t*)(p->ws + OFF_PJ); const float* qgain = p->in[IN_GA_QG] + jl * 128;
  const int nit = 1024 + (need_ctx ? 32 : 0);
  for (int it = blockIdx.x; it < nit; it += gridDim.x) {
    int b, h, row0, nt, qt0;
    if (it < 1024) { b = it >> 8; h = (it >> 5) & 7; row0 = b * TPB + CTX + (it & 31) * 256; nt = TPB / 64; qt0 = (it & 31) * 256; }
    else { const int q = it - 1024; b = q >> 3; h = q & 7; row0 = b * TPB; nt = CTX / 64; qt0 = -1; }
    __syncthreads();
    attn_body_seq<128, 128, 0, 1, 2560, 2560, 2560>(pj + (size_t)row0 * 2560 + h * 128, pj + 1024 + (h >> 2) * 128, nullptr, pj + 1280 + (h >> 2) * 128, b * TPB,
                           pj + (size_t)row0 * 2560 + 1536 + h * 128, nt, 0, lds, tid, dummy, qgain, (const float2*)(p->ws + OFF_TABA), qt0);
  }
}
__device__ __forceinline__ void phase_att_mla(KP p, int need_ctx, int dummy, char* lds, const int tid) {
  bf16_t* pj = (bf16_t*)(p->ws + OFF_PJ); bf16_t* kvm = pj + (size_t)T * 2048; bf16_t* qm = (bf16_t*)(p->ws + OFF_QM);
  const int nit = 1024 + (need_ctx ? 32 : 0);
  for (int it = blockIdx.x; it < nit; it += gridDim.x) {
    int b, h, row0, nt, qt0;
    if (it < 1024) { b = it >> 8; h = (it >> 5) & 7; row0 = b * TPB + CTX + (it & 31) * 256; nt = TPB / 64; qt0 = (it & 31) * 256; }
    else { const int q = it - 1024; b = q >> 3; h = q & 7; row0 = b * TPB; nt = CTX / 64; qt0 = -1; }
    __syncthreads();
    attn_body_seq<192, 128, 0, 0, 1536, 2048, 2048>(qm + (size_t)row0 * 1536 + h * 192, kvm + h * 256, pj + 768, kvm + h * 256 + 128, b * TPB,
                            pj + (size_t)row0 * 2048 + 832 + h * 128, nt, 0, lds, tid, dummy, nullptr, (const float2*)(p->ws + OFF_TABM), qt0);
  }
}
__device__ __forceinline__ void phase_att_na(KP p, int need_ctx, int dummy, char* lds, const int tid) {
  bf16_t* pj = (bf16_t*)(p->ws + OFF_PJ);
  float* bias_l = (float*)(lds + 2 * 8192 + 2 * 8192 + 8 * 64 * 4);
  const int nit = 2048 + (need_ctx ? 64 : 0);
  for (int it = blockIdx.x; it < nit; it += gridDim.x) {
    __syncthreads();
    int ntl = it < 2048 ? 16 : 4; asm volatile("" : "+s"(ntl));
    if (it < 2048) {
      const int b = it >> 9, h = (it >> 5) & 15, r0 = (it & 31) * 4, row0 = b * TPB + CTX + r0 * 64;
      if (tid < 15 * 32) { const int ro = tid >> 5, co = tid & 31; bias_l[tid] = co < 31 ? p->in[IN_NA_RPB][(h * 15 + ro) * 31 + co] * 8.f : 0.f; }
      attn_body_seq<64, 64, 1, 0, 4096, 4096, 4096>(pj + (size_t)row0 * 4096 + h * 64, pj + 1024 + h * 64, nullptr, pj + 2048 + h * 64, b * TPB,
                           pj + (size_t)row0 * 4096 + 3072 + h * 64, ntl, r0, lds, tid, dummy, nullptr, nullptr, -1);
    } else {
      const int q = it - 2048, b = q >> 4, h = q & 15, row0 = b * TPB;
      attn_body_seq<64, 64, 0, 0, 4096, 4096, 4096>(pj + (size_t)row0 * 4096 + h * 64, pj + 1024 + h * 64, nullptr, pj + 2048 + h * 64, b * TPB,
                           pj + (size_t)row0 * 4096 + 3072 + h * 64, ntl, 0, lds, tid, dummy, nullptr, nullptr, -1);
    }
  }
}

#define XB_TMO      128
#define XB_XCNT(j)  (256  + 64 * (j))
#define XB_XSUB(j)  (1280 + 64 * (j))
#define XB_XGEN(j)  (2304 + 64 * (j))
#define XB_TOP      3328
#define XB_TOPGEN   3392
#define XCD_BAR_WORDS 3456
#define XB_SPIN_CAP (1u << 22)
__device__ __forceinline__ unsigned xb_ld(unsigned* p)              { return __hip_atomic_load(p, __ATOMIC_RELAXED, __HIP_MEMORY_SCOPE_AGENT); }
__device__ __forceinline__ unsigned xb_add(unsigned* p, unsigned v) { return __hip_atomic_fetch_add(p, v, __ATOMIC_RELAXED, __HIP_MEMORY_SCOPE_AGENT); }
__device__ __forceinline__ unsigned xb_xcc_id() { return (unsigned)__builtin_amdgcn_s_getreg((3 << 11) | 20) & 0xFu; }
#define XB_SPIN(cond, bar) do { unsigned _sp = 0; while (cond) { __builtin_amdgcn_s_sleep(1); \
    if ((++_sp & 255u) == 0u) { if (xb_ld(&(bar)[XB_TMO])) break; if (_sp > XB_SPIN_CAP) { atomicAdd(&(bar)[XB_TMO], 1u); break; } } } } while (0)
struct XcdBarrier { unsigned* bar; unsigned x; volatile LAS unsigned* st; };
__device__ __forceinline__ XcdBarrier xcd_barrier_post(unsigned* bar, volatile LAS unsigned* st) {
    XcdBarrier b; b.bar = bar; b.x = xb_xcc_id(); b.st = st;
    if (threadIdx.x == 0) (void)xb_add(&bar[XB_XCNT(b.x)], 1u);
    return b;
}
__device__ __forceinline__ void xcd_barrier_complete(unsigned* bar, unsigned x, unsigned& nloc, unsigned& nx) {
    const unsigned G = gridDim.x * gridDim.y * gridDim.z;
    unsigned sum, cnt, mine, sp = 0u;
    for (;;) {
        sum = 0u; cnt = 0u; mine = 0u;
#pragma unroll
        for (unsigned j = 0; j < 16; ++j) { const unsigned c = xb_ld(&bar[XB_XCNT(j)]); sum += c; cnt += (c > 0u) ? 1u : 0u; mine = (j == x) ? c : mine; }
        if (sum == G) break;
        __builtin_amdgcn_s_sleep(1);
        if ((++sp & 255u) == 0u) { if (xb_ld(&bar[XB_TMO])) break; if (sp > XB_SPIN_CAP) { atomicAdd(&bar[XB_TMO], 1u); break; } }
    }
    nloc = mine > 0u ? mine : 1u; nx = cnt > 0u ? cnt : 1u;
}
__device__ __forceinline__ void xcd_barrier(const XcdBarrier& b, const int tid) {
    asm volatile("s_waitcnt vmcnt(0)" ::: "memory");
    __syncthreads();
    if (tid == 0) {
        unsigned* bar = b.bar;
        __builtin_amdgcn_s_waitcnt(0);
        unsigned nloc = b.st[0], nx = b.st[1];
        if (nloc == 0u) { xcd_barrier_complete(bar, b.x, nloc, nx); b.st[0] = nloc; b.st[1] = nx; }
        const unsigned old = xb_add(&bar[XB_XSUB(b.x)], 1u);
        const unsigned gen = old / nloc;
        if (old + 1u == (gen + 1u) * nloc) {
            __builtin_amdgcn_fence(__ATOMIC_RELEASE, "agent");
            asm volatile("s_waitcnt vmcnt(0)" ::: "memory");
            const unsigned og = xb_add(&bar[XB_TOP], 1u);
            const unsigned tg = og / nx;
            if (og + 1u == (tg + 1u) * nx) xb_add(&bar[XB_TOPGEN], 1u);
            else XB_SPIN(xb_ld(&bar[XB_TOPGEN]) == tg, bar);
            __builtin_amdgcn_fence(__ATOMIC_ACQUIRE, "agent");
            xb_add(&bar[XB_XGEN(b.x)], 1u);
            asm volatile("s_waitcnt vmcnt(0)" ::: "memory");
        } else {
            XB_SPIN(xb_ld(&bar[XB_XGEN(b.x)]) == gen, bar);
            __builtin_amdgcn_fence(__ATOMIC_ACQUIRE, "agent");
            asm volatile("s_waitcnt vmcnt(0)" ::: "memory");
        }
    }
    __syncthreads();
}

__global__ void __launch_bounds__(NTHREADS, 2) fwd_megakernel(const Params p_unused) {
  extern __shared__ __attribute__((aligned(16))) unsigned char shm[];
  cg::grid_group grid = cg::this_grid();
  char* lds = (char*)shm;
  __shared__ uint4 xb_words;
  const int wave_s = __builtin_amdgcn_readfirstlane((int)(threadIdx.x >> 6));
  if (threadIdx.x == 0) xb_words = make_uint4(0u, 0u, 0u, 0u);
  __syncthreads();
  { KP p0 = (KP)__builtin_amdgcn_kernarg_segment_ptr(); (void)xcd_barrier_post((unsigned*)(p0->ws + OFF_BAR), (volatile LAS unsigned*)&xb_words);
    phase_pre(p0, lds, (int)threadIdx.x); }
  grid.sync();
#ifndef PHM
#define PHM 0xffff
#endif
#define PH(k) if constexpr (((PHM) >> (k)) & 1)
  for (int oi = 1; oi < PROG.n; ++oi) {
    const Op op = PROG.ops[oi];
    unsigned zz = 0u; asm volatile("" : "+v"(zz));
    int tid = wave_s * 64 + (int)__builtin_amdgcn_mbcnt_hi(~0u, __builtin_amdgcn_mbcnt_lo(~0u, zz)); asm volatile("" : "+v"(tid));
    KP p = (KP)__builtin_amdgcn_kernarg_segment_ptr(); asm volatile("" : "+s"(p));
    char* ws = p->ws;
    switch (op.type) {
      case OP_MODFIN: PH(1) phase_modfin(p, tid); break;
      case OP_NORM: PH(2) phase_norm(p, op.i0, tid); break;
      case OP_GEMM_BF: case OP_GEMM_BF_NOSYNC: PH(3) {
        pg8::Gemm g{(const bf16_t*)(ws + op.a), (const bf16_t*)(ws + op.b), T, op.i0, op.i1, op.i2};
        pg8::StaticOrder S; S.init(T, op.i0, (int)gridDim.x, (int)blockIdx.x);
        pg8::EpiBf16 E{(bf16_t*)(ws + op.o), op.i0};
        pg8::gemm_phase<pg8::EpiBf16>((LAS unsigned char*)shm, g, S, E, tid);
      } break;
      case OP_GEMM_RES: PH(4) {
        pg8::Gemm g{(const bf16_t*)(ws + op.a), (const bf16_t*)(ws + op.b), T, DM, DM, op.i2};
        pg8::StaticOrder S; S.init(T, DM, (int)gridDim.x, (int)blockIdx.x, op.i0 == DEPTH - 1);
        float* xsc = (float*)(ws + OFF_XSC); float* outp = p->out;
        pg8::EpiResid E{op.i0 == 0 ? p->in[IN_X] : (const float*)outp, op.i0 == 0 ? p->in[IN_CTX] : (const float*)xsc, outp, xsc, (const float*)(ws + OFF_MOD) + (size_t)op.i0 * 5 * 3072};
        pg8::gemm_phase<pg8::EpiResid>((LAS unsigned char*)shm, g, S, E, tid);
      } break;
      case OP_GQA_POST: PH(5) phase_gqa_post(p, op.i0, op.i1, tid); break;
      case OP_ATT_GQA: PH(6) phase_att_gqa(p, op.i0, op.i1, op.i2, lds, tid); break;
      case OP_ATT_NA: PH(7) phase_att_na(p, op.i0, op.i1, lds, tid); break;
      case OP_MLA_POST1: PH(8) phase_mla_post1(p, op.i1, tid); break;
      case OP_MLA_POST2: PH(9) phase_mla_post2(p, tid); break;
      case OP_ATT_MLA: PH(10) phase_att_mla(p, op.i0, op.i1, lds, tid); break;
      case OP_FINAL: PH(11) phase_final(p, op.i1, tid); break;
      default: break;
    }
    if (op.type == OP_GEMM_BF_NOSYNC) __syncthreads(); else { XcdBarrier xb; xb.bar = (unsigned*)(ws + OFF_BAR); xb.x = xb_xcc_id(); xb.st = (volatile LAS unsigned*)&xb_words; xcd_barrier(xb, tid);
      if (PROBE_DUP & 512) { xcd_barrier(xb, tid); xcd_barrier(xb, tid); } }
  }
}

extern "C" void kernel_launch(void* const* d_in, const int* in_sizes, int n_in, void* d_out, int out_size, void* d_ws, size_t ws_size, hipStream_t stream) {
  static int grid_blocks = 0;
  if (!grid_blocks) {
    if (ws_size < WS_END) { fprintf(stderr, "kernel_launch: workspace too small: %zu < %zu\n", ws_size, (size_t)WS_END); return; }
    if (hipFuncSetAttribute((const void*)fwd_megakernel, hipFuncAttributeMaxDynamicSharedMemorySize, LDS_BYTES) != hipSuccess) { fprintf(stderr, "kernel_launch: hipFuncSetAttribute failed\n"); return; }
    int dev = 0, cus = 0, per_cu = 0;
    hipGetDevice(&dev);
    hipDeviceGetAttribute(&cus, hipDeviceAttributeMultiprocessorCount, dev);
    hipOccupancyMaxActiveBlocksPerMultiprocessor(&per_cu, fwd_megakernel, NTHREADS, LDS_BYTES);
    if (per_cu < 1) { fprintf(stderr, "kernel_launch: occupancy query returned %d\n", per_cu); return; }
    grid_blocks = cus;
  }
  Params p; memset(&p, 0, sizeof(p));
  if (n_in != N_IN) { fprintf(stderr, "kernel_launch: expected %d inputs, got %d\n", (int)N_IN, n_in); return; }
  for (int i = 0; i < N_IN; ++i) p.in[i] = (const float*)d_in[i];
  p.out = (float*)d_out; p.ws = (char*)d_ws;
  hipMemsetAsync((char*)d_ws + OFF_BAR, 0, XCD_BAR_WORDS * 4, stream);
  void* args[] = {&p};
  hipError_t e = hipLaunchCooperativeKernel((const void*)fwd_megakernel, dim3(grid_blocks), dim3(NTHREADS), args, LDS_BYTES, stream);
  if (e != hipSuccess) fprintf(stderr, "kernel_launch: cooperative launch failed: %s (grid %d)\n", hipGetErrorString(e), grid_blocks);
}
```

```cpp
#include <hip/hip_runtime.h>
#include <hip/hip_cooperative_groups.h>
#include <cstdio>
#include <cstring>
namespace cg = cooperative_groups;

#define LAS __attribute__((address_space(3)))
typedef unsigned short bf16_t;
typedef short bf16x8 __attribute__((ext_vector_type(8)));
typedef short s16x4 __attribute__((ext_vector_type(4)));
typedef float f32x4 __attribute__((ext_vector_type(4)));
typedef float f32x16 __attribute__((ext_vector_type(16)));
typedef unsigned u32x4 __attribute__((ext_vector_type(4)));
typedef unsigned u32x2 __attribute__((ext_vector_type(2)));

constexpr int NB = 4, SEQ = 8192, CTX = 256, DM = 1024, TPB = SEQ + CTX, T = NB * TPB;
constexpr int DEPTH = 4;
constexpr float EPS = 1e-6f;
constexpr int NTHREADS = 512;
constexpr int LDS_BYTES = 131072;

constexpr size_t OFF_XSC = 0;
constexpr size_t OFF_HB = OFF_XSC + (size_t)NB * CTX * DM * 4;
constexpr size_t OFF_PJ = OFF_HB + (size_t)T * DM * 2;
constexpr size_t OFF_QM = OFF_PJ + (size_t)T * 4096 * 2;
constexpr size_t OFF_W = OFF_QM + (size_t)T * 1536 * 2;
constexpr size_t W_GA_IN = 0, W_GA_OUT = W_GA_IN + 2ull * 2560 * 1024, W_NA_IN = W_GA_OUT + 2ull * 1024 * 1024, W_NA_OUT = W_NA_IN + 4096ull * 1024,
                 W_ML_IN = W_NA_OUT + 1024ull * 1024, W_ML_UQ = W_ML_IN + 2048ull * 1024, W_ML_UKV = W_ML_UQ + 1536ull * 512, W_ML_OUT = W_ML_UKV + 2048ull * 256,
                 W_END = W_ML_OUT + 1024ull * 1024;
constexpr size_t OFF_MODP = OFF_W + W_END * 2;
constexpr size_t OFF_MOD = OFF_MODP + 16ull * 4 * 5 * 3072 * 4;
constexpr size_t OFF_TABA = OFF_MOD + 4ull * 5 * 3072 * 4;
constexpr size_t OFF_TABM = OFF_TABA + 128ull * 32 * 8;
constexpr size_t OFF_BAR = OFF_TABM + 128ull * 16 * 8;
constexpr size_t WS_END = OFF_BAR + 3456ull * 4;

struct Op { int type, i0, i1, i2; unsigned long long a, b, o; };
enum { OP_PRE = 0, OP_MODFIN, OP_NORM, OP_GEMM_BF, OP_GEMM_RES, OP_GQA_POST, OP_ATT_GQA, OP_ATT_NA, OP_MLA_POST1, OP_MLA_POST2, OP_ATT_MLA, OP_FINAL, OP_GEMM_BF_NOSYNC };
enum { IN_X = 0, IN_C, IN_CTX, IN_CCTX, IN_MODW, IN_MODB, IN_NORMG, IN_FINALG, IN_GA_WIN, IN_GA_QG, IN_GA_KG, IN_GA_WOUT, IN_NA_WIN, IN_NA_RPB, IN_NA_WOUT,
       IN_ML_WIN, IN_ML_QG, IN_ML_KVG, IN_ML_WUQ, IN_ML_WUKV, IN_ML_WOUT, N_IN };
struct Params { const float* in[N_IN]; float* out; char* ws; };
#define KAS __attribute__((address_space(4)))
typedef const KAS Params* KP;

#ifndef PROBE_DUP
#define PROBE_DUP 0
#endif
constexpr int MAXOPS = 64;
struct Prog { Op ops[MAXOPS]; int n; };
constexpr void prog_add1(Prog& P, int type, int i0, int i1, int i2, size_t a, size_t b, size_t o) { Op& q = P.ops[P.n++]; q.type = type; q.i0 = i0; q.i1 = i1; q.i2 = i2; q.a = a; q.b = b; q.o = o; }
constexpr void prog_add(Prog& P, int type, int i0, int i1, int i2, size_t a, size_t b, size_t o) {
  const bool gemm = type == OP_GEMM_BF || type == OP_GEMM_BF_NOSYNC;
  if ((PROBE_DUP & 1) && gemm) prog_add1(P, OP_GEMM_BF, i0, i1, i2, a, b, o);
  if ((PROBE_DUP & 2) && type == OP_ATT_GQA) prog_add1(P, type, i0, 1, i2, a, b, o);
  if ((PROBE_DUP & 4) && type == OP_ATT_MLA) prog_add1(P, type, i0, 1, i2, a, b, o);
  if ((PROBE_DUP & 8) && type == OP_ATT_NA) prog_add1(P, type, i0, 1, i2, a, b, o);
  if ((PROBE_DUP & 16) && type == OP_NORM) prog_add1(P, type, i0, i1, i2, a, b, o);
  if ((PROBE_DUP & 32) && type == OP_GEMM_RES && i0 == 0) prog_add1(P, type, i0, i1, i2, a, b, o);
  if ((PROBE_DUP & 128) && type == OP_GQA_POST) prog_add1(P, type, i0, 1, i2, a, b, o);
  if ((PROBE_DUP & 256) && (type == OP_MLA_POST1 || type == OP_FINAL)) prog_add1(P, type, i0, 1, i2, a, b, o);
  if ((PROBE_DUP & 64) && type == OP_PRE) prog_add1(P, type, i0, i1, i2, a, b, o);
  prog_add1(P, type, i0, i1, i2, a, b, o);
}
constexpr Prog make_prog() {
  Prog P{}; P.n = 0;
  const size_t W = OFF_W, hb = OFF_HB, pj = OFF_PJ, qm = OFF_QM;
  prog_add(P, OP_PRE, 0, 0, 0, 0, 0, 0);
  prog_add(P, OP_MODFIN, 0, 0, 0, 0, 0, 0);
  for (int i = 0; i < DEPTH; ++i) {
    const int kind = i % 3, j = i / 3, need_ctx = i < DEPTH - 1;
    prog_add(P, OP_NORM, i, 0, 0, 0, 0, 0);
    if (kind == 0) {
      prog_add(P, OP_GEMM_BF, 2560, 1024, 1024, hb, W + 2 * (W_GA_IN + (size_t)j * 2560 * 1024), pj);
      prog_add(P, OP_GQA_POST, j, 0, 0, 0, 0, 0);
      prog_add(P, OP_ATT_GQA, need_ctx, 0, j, 0, 0, 0);
      prog_add(P, OP_GEMM_RES, i, 0, 2560, pj + 2 * 1536, W + 2 * (W_GA_OUT + (size_t)j * 1024 * 1024), 0);
    } else if (kind == 1) {
      prog_add(P, OP_GEMM_BF, 4096, 1024, 1024, hb, W + 2 * W_NA_IN, pj);
      prog_add(P, OP_ATT_NA, need_ctx, 0, 0, 0, 0, 0);
      prog_add(P, OP_GEMM_RES, i, 0, 4096, pj + 2 * 3072, W + 2 * W_NA_OUT, 0);
    } else {
      prog_add(P, OP_GEMM_BF, 2048, 1024, 1024, hb, W + 2 * W_ML_IN, pj);
      prog_add(P, OP_MLA_POST1, 0, 0, 0, 0, 0, 0);
      prog_add(P, OP_GEMM_BF_NOSYNC, 1536, 512, 2048, pj, W + 2 * W_ML_UQ, qm);
      prog_add(P, OP_GEMM_BF, 2048, 256, 2048, pj + 2 * 512, W + 2 * W_ML_UKV, pj + (size_t)T * 2048 * 2);
      prog_add(P, OP_ATT_MLA, need_ctx, 0, 0, 0, 0, 0);
      prog_add(P, OP_GEMM_RES, i, 0, 2048, pj + 2 * 832, W + 2 * W_ML_OUT, 0);
    }
  }
  prog_add(P, OP_FINAL, 0, 0, 0, 0, 0, 0);
  return P;
}
__device__ const Prog PROG = make_prog();

struct WDesc { int in_idx; int K, N, Npad, tile0; unsigned src_off, dst_off; int pad_; };
constexpr int NWD = 10;
struct WTab { WDesc d[NWD]; int ntiles; };
constexpr WTab make_wtab() {
  WTab t{}; int nt = 0, wi = 0;
  auto addw = [&](int in_idx, size_t src_off, size_t dst, int K, int N, int Npad) { WDesc& w = t.d[wi++]; w.in_idx = in_idx; w.src_off = (unsigned)src_off; w.dst_off = (unsigned)dst; w.K = K; w.N = N; w.Npad = Npad; w.tile0 = nt; w.pad_ = 0; nt += (K / 64) * (Npad / 64); };
  addw(IN_GA_WIN, 0, W_GA_IN, 1024, 2560, 2560); addw(IN_GA_WIN, 1024ull * 2560, W_GA_IN + 2560ull * 1024, 1024, 2560, 2560);
  addw(IN_GA_WOUT, 0, W_GA_OUT, 1024, 1024, 1024); addw(IN_GA_WOUT, 1024ull * 1024, W_GA_OUT + 1024ull * 1024, 1024, 1024, 1024);
  addw(IN_NA_WIN, 0, W_NA_IN, 1024, 4096, 4096); addw(IN_NA_WOUT, 0, W_NA_OUT, 1024, 1024, 1024);
  addw(IN_ML_WIN, 0, W_ML_IN, 1024, 1856, 2048); addw(IN_ML_WUQ, 0, W_ML_UQ, 512, 1536, 1536); addw(IN_ML_WUKV, 0, W_ML_UKV, 256, 2048, 2048); addw(IN_ML_WOUT, 0, W_ML_OUT, 1024, 1024, 1024);
  t.ntiles = nt; return t;
}
__device__ const WTab WTAB = make_wtab();

__device__ const float INV_A[32] = {1.000000000e+00f, 7.498942614e-01f, 5.623413324e-01f, 4.216965139e-01f, 3.162277639e-01f, 2.371373773e-01f, 1.778279394e-01f, 1.333521307e-01f, 1.000000015e-01f, 7.498941571e-02f, 5.623413250e-02f, 4.216965288e-02f, 3.162277490e-02f, 2.371373773e-02f, 1.778279431e-02f, 1.333521493e-02f, 9.999999776e-03f, 7.498941850e-03f, 5.623413250e-03f, 4.216964822e-03f, 3.162277630e-03f, 2.371373586e-03f, 1.778279431e-03f, 1.333521446e-03f, 1.000000047e-03f, 7.498942432e-04f, 5.623413017e-04f, 4.216965172e-04f, 3.162277571e-04f, 2.371373703e-04f, 1.778279402e-04f, 1.333521504e-04f};
__device__ const float INV_M[16] = {1.000000000e+00f, 5.623413324e-01f, 3.162277639e-01f, 1.778279394e-01f, 1.000000015e-01f, 5.623413250e-02f, 3.162277490e-02f, 1.778279431e-02f, 9.999999776e-03f, 5.623413250e-03f, 3.162277630e-03f, 1.778279431e-03f, 1.000000047e-03f, 5.623413017e-04f, 3.162277571e-04f, 1.778279402e-04f};

__device__ __forceinline__ float bf2f(short b) { return __uint_as_float(((unsigned)(unsigned short)b) << 16); }
__device__ __forceinline__ unsigned cvtpk(float lo, float hi) { unsigned r; asm volatile("v_cvt_pk_bf16_f32 %0, %1, %2" : "=v"(r) : "v"(lo), "v"(hi)); return r; }
__device__ __forceinline__ bf16x8 pack8(const float* v) { u32x4 w = {cvtpk(v[0], v[1]), cvtpk(v[2], v[3]), cvtpk(v[4], v[5]), cvtpk(v[6], v[7])}; return *reinterpret_cast<bf16x8*>(&w); }
__device__ __forceinline__ float silu_f(float g) { return g * __builtin_amdgcn_rcpf(1.f + __builtin_amdgcn_exp2f(-g * 1.4426950408889634f)); }
__device__ __forceinline__ float wave_sum(float v) {
#pragma unroll
  for (int o = 32; o >= 1; o >>= 1) v += __shfl_xor(v, o);
  return v;
}
__device__ __forceinline__ const float* res_src(KP p, int layer, int row) {
  const int b = row / TPB, j = row - b * TPB;
  if (j < CTX) return (layer == 0 ? p->in[IN_CTX] : (const float*)(p->ws + OFF_XSC)) + ((size_t)b * CTX + j) * DM;
  return (layer == 0 ? p->in[IN_X] : (const float*)p->out) + ((size_t)b * SEQ + (j - CTX)) * DM;
}

namespace pg8 {
constexpr int BM = 256, BK = 64, HALF = 128, HTB = HALF * BK * 2, STAGE_BYTES = 8 * HTB, NXCD = 8, WGM = 8;
__device__ __forceinline__ int lds_byte(int r, int c) { const int st = (r >> 4) * 2 + (c >> 5), rr = r & 15, cc = c & 31, ob = rr * 64 + cc * 2; return st * 1024 + (ob ^ (((ob >> 9) & 1) << 5)); }
__device__ __forceinline__ void stage_rc(int b, int& R, int& C) { const int st = b / 1024, sb = b % 1024, swz = sb ^ (((sb >> 9) & 1) << 5); R = (st >> 1) * 16 + swz / 64; C = (st & 1) * 32 + (swz % 64) / 2; }
__device__ __forceinline__ int perm32(int rho) { const int n = rho >> 4, i = rho & 15; return 8 * (i >> 2) + 4 * n + (i & 3); }
struct Unit { int pm, pn; };
struct Gemm { const bf16_t* A; const bf16_t* Bt; int M, N, K, lda; };
struct StaticOrder {
  int nM, nN, nwg, G, c, latonly;
  __device__ void init(int M, int N, int G_, int c_, int latonly_ = 0) { latonly = latonly_; nM = latonly ? 128 : M / BM; nN = N / BM; nwg = nM * nN; G = G_; c = c_; }
  __device__ bool next(int i, Unit& u) const {
    const long L = (long)i * G + c; if (L >= nwg) return false;
    int wgid = (int)L; { const int q = nwg / NXCD, r = nwg % NXCD, xcd = wgid % NXCD, off = wgid / NXCD; wgid = (xcd < r ? xcd * (q + 1) : r * (q + 1) + (xcd - r) * q) + off; }
    const int nig = WGM * nN, gid = wgid / nig, fm = gid * WGM, gsz = (nM - fm) < WGM ? (nM - fm) : WGM;
    u.pm = fm + ((wgid % nig) % gsz); u.pn = (wgid % nig) / gsz; if (latonly) u.pm += (u.pm >> 5) + 1; return true;
  }
};
struct EpiBf16 {
  static constexpr bool PERM = true;
  bf16_t* O; int ldc;
  __device__ __forceinline__ void operator()(const f32x4 (&acc)[2][2][4][2], const Unit& u, int wr, int wc, int fr, int fq) const {
    const int row0 = u.pm * BM + wr * 64 + fr, col0 = u.pn * BM + wc * 32 + 8 * fq;
#pragma unroll
    for (int ai = 0; ai < 2; ++ai)
#pragma unroll
      for (int m = 0; m < 4; ++m) { bf16_t* rowp = O + (size_t)(row0 + ai * HALF + m * 16) * ldc + col0;
#pragma unroll
        for (int bj = 0; bj < 2; ++bj) { const f32x4 v0 = acc[ai][bj][m][0], v1 = acc[ai][bj][m][1];
          u32x4 w; w.x = cvtpk(v0[0], v0[1]); w.y = cvtpk(v0[2], v0[3]); w.z = cvtpk(v1[0], v1[1]); w.w = cvtpk(v1[2], v1[3]);
          *(u32x4*)(rowp + bj * HALF) = w; } }
  }
};
struct EpiResid {
  static constexpr bool PERM = true;
  const float* res_lat; const float* res_ctx; float* out_lat; float* out_ctx; const float* mod;
  __device__ __forceinline__ void operator()(const f32x4 (&acc)[2][2][4][2], const Unit& u, int wr, int wc, int fr, int fq) const {
    const int b = u.pm / 33, lt = u.pm - b * 33;
    const float* rb; float* ob; const float* g;
    if (lt == 0) { rb = res_ctx + (size_t)b * CTX * DM; ob = out_ctx + (size_t)b * CTX * DM; g = mod + 4 * 3072 + 2048; }
    else { const size_t o = ((size_t)b * SEQ + (size_t)(lt - 1) * 256) * DM; rb = res_lat + o; ob = out_lat + o; g = mod + b * 3072 + 2048; }
    const int lr0 = wr * 64 + fr, col0 = u.pn * BM + wc * 32 + 8 * fq;
    f32x4 gv[2][2];
#pragma unroll
    for (int bj = 0; bj < 2; ++bj)
#pragma unroll
      for (int n = 0; n < 2; ++n) gv[bj][n] = *(const f32x4*)(g + col0 + bj * HALF + n * 4);
#pragma unroll
    for (int ai = 0; ai < 2; ++ai)
#pragma unroll
      for (int m = 0; m < 4; ++m) { const size_t ro = (size_t)(lr0 + ai * HALF + m * 16) * DM + col0;
#pragma unroll
        for (int bj = 0; bj < 2; ++bj)
#pragma unroll
          for (int n = 0; n < 2; ++n) { const f32x4 r = *(const f32x4*)(rb + ro + bj * HALF + n * 4);
            *(f32x4*)(ob + ro + bj * HALF + n * 4) = r + gv[bj][n] * acc[ai][bj][m][n]; } }
  }
};

template <class Epi>
__device__ __forceinline__ void gemm_phase(LAS unsigned char* lds, const Gemm g, const StaticOrder& S, const Epi& E, const int tid) {
  const int wid = __builtin_amdgcn_readfirstlane(tid >> 6), lane = tid & 63, wr = wid >> 2, wc = wid & 3, fr = lane & 15, fq = lane >> 4;
  const int K = g.K, nt = K / BK, lda = g.lda;
  unsigned voffA[2], voffB[2];
#pragma unroll
  for (int i = 0; i < 2; ++i) { int R, C; stage_rc(tid * 16 + i * 8192, R, C); const int Rb = Epi::PERM ? ((R & ~31) + perm32(R & 31)) : R;
    voffA[i] = (unsigned)(R * lda + C) * 2u; voffB[i] = (unsigned)(Rb * K + C) * 2u; }
  const size_t kstep = (size_t)(BK * 2);
  const size_t hstepA = (size_t)HALF * lda * 2, hstepB = (size_t)HALF * K * 2;
  const size_t tstepA = 2 * hstepA, tstepB = 2 * hstepB;
  const unsigned ldsw = (unsigned)wid * 1024u;
  const int aoff = lds_byte(wr * 64 + fr, fq * 8), boff = lds_byte(wc * 32 + fr, fq * 8);
#define PG8_SA(b, h) (((b) * 2 + (h)) * HTB)
#define PG8_SB(b, h) ((4 + (b) * 2 + (h)) * HTB)
#define PG8_STAGE(bufoff, gbase, voff) do { _Pragma("unroll") for (int _i = 0; _i < 2; ++_i) \
    __builtin_amdgcn_global_load_lds((const unsigned*)((const char*)(gbase) + (voff)[_i]), (LAS unsigned*)(lds + (bufoff) + ldsw + _i * 8192), 16, 0, 0); } while (0)
#define PG8_LDA(dst, b, h) do { _Pragma("unroll") for (int m = 0; m < 4; ++m) _Pragma("unroll") for (int k = 0; k < 2; ++k) dst[m][k] = *(const LAS bf16x8*)(lds + PG8_SA(b, h) + aoff + m * 2048 + k * 1024); } while (0)
#define PG8_LDB(dst, b, h) do { _Pragma("unroll") for (int n = 0; n < 2; ++n) _Pragma("unroll") for (int k = 0; k < 2; ++k) dst[n][k] = *(const LAS bf16x8*)(lds + PG8_SB(b, h) + boff + n * 2048 + k * 1024); } while (0)
#define PG8_MMA(ai, bj, At, Bt) do { __builtin_amdgcn_s_setprio(1); _Pragma("unroll") for (int m = 0; m < 4; ++m) _Pragma("unroll") for (int n = 0; n < 2; ++n) _Pragma("unroll") for (int k = 0; k < 2; ++k) \
    acc[ai][bj][m][n] = __builtin_amdgcn_mfma_f32_16x16x32_bf16(Bt[n][k], At[m][k], acc[ai][bj][m][n], 0, 0, 0); __builtin_amdgcn_s_setprio(0); } while (0)
#define PG8_WAIT_V(n) asm volatile("s_waitcnt vmcnt(" #n ")" ::: "memory")
#define PG8_WAIT_L(n) asm volatile("s_waitcnt lgkmcnt(" #n ")" ::: "memory")
#define PG8_BAR __builtin_amdgcn_s_barrier()
#define PG8_SCHED __builtin_amdgcn_sched_barrier(0)
  Unit cur, nxt; int ui = 0;
  if (!S.next(0, cur)) return;
  f32x4 acc[2][2][4][2];
#pragma unroll
  for (int a = 0; a < 2; ++a)
#pragma unroll
    for (int b = 0; b < 2; ++b)
#pragma unroll
      for (int m = 0; m < 4; ++m)
#pragma unroll
        for (int n = 0; n < 2; ++n) acc[a][b][m][n] = (f32x4){0.f, 0.f, 0.f, 0.f};
  bf16x8 At[4][2], B0[2][2], B1[2][2];
  const char* cA = (const char*)g.A + (size_t)cur.pm * tstepA; const char* cB = (const char*)g.Bt + (size_t)cur.pn * tstepB;
  PG8_STAGE(PG8_SB(0, 0), cB, voffB); PG8_STAGE(PG8_SA(0, 0), cA, voffA); PG8_STAGE(PG8_SB(0, 1), cB + hstepB, voffB); PG8_STAGE(PG8_SA(0, 1), cA + hstepA, voffA);
  if (wr == 1) PG8_BAR;
  PG8_WAIT_V(4); PG8_BAR;
  PG8_STAGE(PG8_SB(1, 0), cB + kstep, voffB); PG8_STAGE(PG8_SA(1, 0), cA + kstep, voffA); PG8_STAGE(PG8_SB(1, 1), cB + hstepB + kstep, voffB);
  PG8_WAIT_V(6); PG8_BAR;
  for (;;) {
    const bool has_next = S.next(ui + 1, nxt);
    const char* nA = has_next ? (const char*)g.A + (size_t)nxt.pm * tstepA : cA; const char* nB = has_next ? (const char*)g.Bt + (size_t)nxt.pn * tstepB : cB;
    for (int t = 0; t < nt; t += 2) {
      const bool last = (t == nt - 2);
      const char* a1 = cA + (size_t)(t + 1) * kstep;
      const char* a2 = last ? nA : cA + (size_t)(t + 2) * kstep; const char* b2 = last ? nB : cB + (size_t)(t + 2) * kstep;
      const char* a3 = a2 + kstep; const char* b3 = b2 + kstep;
      PG8_LDB(B0, 0, 0); PG8_SCHED; PG8_LDA(At, 0, 0); PG8_STAGE(PG8_SA(1, 1), a1 + hstepA, voffA);
      PG8_WAIT_L(8); PG8_BAR; PG8_WAIT_L(0); PG8_MMA(0, 0, At, B0); PG8_BAR; PG8_SCHED;
      PG8_LDB(B1, 0, 1); PG8_STAGE(PG8_SB(0, 0), b2, voffB);
      PG8_BAR; PG8_WAIT_L(0); PG8_MMA(0, 1, At, B1); PG8_BAR;
      PG8_LDA(At, 0, 1); PG8_STAGE(PG8_SA(0, 0), a2, voffA);
      PG8_BAR; PG8_WAIT_L(0); PG8_MMA(1, 0, At, B0); PG8_BAR; PG8_SCHED;
      PG8_STAGE(PG8_SB(0, 1), b2 + hstepB, voffB);
      PG8_WAIT_V(6); PG8_BAR; PG8_MMA(1, 1, At, B1); PG8_BAR;
      PG8_LDB(B0, 1, 0); PG8_SCHED; PG8_LDA(At, 1, 0); PG8_STAGE(PG8_SA(0, 1), a2 + hstepA, voffA);
      PG8_WAIT_L(8); PG8_BAR; PG8_WAIT_L(0); PG8_MMA(0, 0, At, B0); PG8_BAR; PG8_SCHED;
      PG8_LDB(B1, 1, 1); PG8_STAGE(PG8_SB(1, 0), b3, voffB);
      PG8_BAR; PG8_WAIT_L(0); PG8_MMA(0, 1, At, B1); PG8_BAR;
      PG8_LDA(At, 1, 1); PG8_STAGE(PG8_SA(1, 0), a3, voffA);
      PG8_BAR; PG8_WAIT_L(0); PG8_MMA(1, 0, At, B0); PG8_BAR; PG8_SCHED;
      PG8_STAGE(PG8_SB(1, 1), b3 + hstepB, voffB);
      PG8_WAIT_V(6); PG8_BAR; PG8_MMA(1, 1, At, B1); PG8_BAR;
    }
    E(acc, cur, wr, wc, fr, fq);
    if (!has_next) break;
#pragma unroll
    for (int a = 0; a < 2; ++a)
#pragma unroll
      for (int b = 0; b < 2; ++b)
#pragma unroll
        for (int m = 0; m < 4; ++m)
#pragma unroll
          for (int n = 0; n < 2; ++n) acc[a][b][m][n] = (f32x4){0.f, 0.f, 0.f, 0.f};
    cur = nxt; cA = nA; cB = nB; ++ui;
  }
  PG8_WAIT_V(0);
  if (wr == 0) PG8_BAR;
  PG8_BAR;
#undef PG8_SA
#undef PG8_SB
#undef PG8_STAGE
#undef PG8_LDA
#undef PG8_LDB
#undef PG8_MMA
#undef PG8_WAIT_V
#undef PG8_WAIT_L
#undef PG8_BAR
#undef PG8_SCHED
}
}

#define SBAR() __builtin_amdgcn_sched_barrier(0)
__device__ __forceinline__ int crow(int r, int hi) { return (r & 3) + 8 * (r >> 2) + 4 * hi; }
constexpr float THR = 8.f;
template <int DQK> struct ScaleOf;
template <> struct ScaleOf<64> { static constexpr float v = 0.125f; };
template <> struct ScaleOf<128> { static constexpr float v = 0.088388347648318440f; };
template <> struct ScaleOf<192> { static constexpr float v = 0.072168783648703220f; };

template <int DQK>
__device__ __forceinline__ void partialSM(f32x16& p0, f32x16& p1, float& m_reg, float& mn, float& alpha) {
  constexpr float SCALE = ScaleOf<DQK>::v, C = SCALE * 1.4426950408889634f;
  float pmax = p0[0];
#pragma unroll
  for (int r = 1; r < 16; ++r) pmax = fmaxf(pmax, p0[r]);
#pragma unroll
  for (int r = 0; r < 16; ++r) pmax = fmaxf(pmax, p1[r]);
  { auto rr = __builtin_amdgcn_permlane32_swap(__float_as_uint(pmax), __float_as_uint(pmax), false, false);
    pmax = fmaxf(__uint_as_float(rr[0]), __uint_as_float(rr[1])); }
  if (__builtin_expect(__all(pmax - m_reg <= THR / SCALE), 1)) { mn = m_reg; alpha = 1.f; }
  else { mn = fmaxf(m_reg, pmax); alpha = __builtin_amdgcn_exp2f((m_reg - mn) * C); m_reg = mn; }
  const float mnC = -mn * C;
#pragma unroll
  for (int r = 0; r < 16; ++r) p0[r] = fmaf(p0[r], C, mnC);
#pragma unroll
  for (int r = 0; r < 16; ++r) p1[r] = fmaf(p1[r], C, mnC);
#pragma unroll
  for (int r = 0; r < 16; ++r) p0[r] = __builtin_amdgcn_exp2f(p0[r]);
}
__device__ __forceinline__ void partialSM2(f32x16& p0, f32x16& p1, float& m_reg, float& alpha, f32x16& negm, const bool first) {
  constexpr float THR2 = THR * 1.4426950408889634f;
  float pmax = p0[0];
#pragma unroll
  for (int r = 1; r < 16; ++r) pmax = fmaxf(pmax, p0[r]);
#pragma unroll
  for (int r = 0; r < 16; ++r) pmax = fmaxf(pmax, p1[r]);
  { auto rr = __builtin_amdgcn_permlane32_swap(__float_as_uint(pmax), __float_as_uint(pmax), false, false);
    pmax = fmaxf(__uint_as_float(rr[0]), __uint_as_float(rr[1])); }
  if (__builtin_expect(!first && __all(pmax <= THR2), 1)) { alpha = 1.f; }
  else { const float d = first ? pmax : fmaxf(pmax, 0.f); alpha = first ? 1.f : __builtin_amdgcn_exp2f(-d); m_reg += d;
#pragma unroll
    for (int r = 0; r < 16; ++r) { p0[r] -= d; p1[r] -= d; }
    const float nm = -m_reg;
#pragma unroll
    for (int r = 0; r < 16; ++r) negm[r] = nm; }
#pragma unroll
  for (int r = 0; r < 16; ++r) p0[r] = __builtin_amdgcn_exp2f(p0[r]);
}
__device__ __forceinline__ void finishSM(f32x16& p0, f32x16& p1, float alpha, float& l_reg, bf16x8& pa0, bf16x8& pa1, bf16x8& pa2, bf16x8& pa3) {
#pragma unroll
  for (int r = 0; r < 16; ++r) p1[r] = __builtin_amdgcn_exp2f(p1[r]);
  float ps = 0;
#pragma unroll
  for (int r = 0; r < 16; ++r) ps += p0[r];
#pragma unroll
  for (int r = 0; r < 16; ++r) ps += p1[r];
  { auto rr = __builtin_amdgcn_permlane32_swap(__float_as_uint(ps), __float_as_uint(ps), false, false);
    ps = __uint_as_float(rr[0]) + __uint_as_float(rr[1]); }
  l_reg = l_reg * alpha + ps;
#define PK4(P, BASE, OUT) do { unsigned a0 = cvtpk(P[BASE + 0], P[BASE + 1]), a1 = cvtpk(P[BASE + 2], P[BASE + 3]);   \
    unsigned b0 = cvtpk(P[BASE + 4], P[BASE + 5]), b1 = cvtpk(P[BASE + 6], P[BASE + 7]);                              \
    auto r0 = __builtin_amdgcn_permlane32_swap(a0, b0, false, false); auto r1 = __builtin_amdgcn_permlane32_swap(a1, b1, false, false); \
    u32x4 w = {r0[0], r1[0], r0[1], r1[1]}; OUT = *reinterpret_cast<bf16x8*>(&w); } while (0)
  PK4(p0, 0, pa0); PK4(p0, 8, pa1); PK4(p1, 0, pa2); PK4(p1, 8, pa3);
#undef PK4
}
template <int DQK>
__device__ __forceinline__ void qkt(f32x16& p0, f32x16& p1, const char* Ks, const bf16x8* qr, int r32, int hi, const f32x16 init = f32x16{}) {
  constexpr int RB = DQK * 2;
  p0 = init; p1 = init;
#pragma unroll
  for (int d0 = 0; d0 < DQK / 16; ++d0) { const int cb = (d0 * 16 + hi * 8) * 2;
    const int sw = (DQK >= 128 && d0 < 8) ? ((r32 & 15) << 4) : ((r32 & 7) << 4);
    bf16x8 b0 = *reinterpret_cast<const bf16x8*>(Ks + r32 * RB + (cb ^ sw));
    bf16x8 b1 = *reinterpret_cast<const bf16x8*>(Ks + (32 + r32) * RB + (cb ^ sw));
    p0 = __builtin_amdgcn_mfma_f32_32x32x16_bf16(b0, qr[d0], p0, 0, 0, 0);
    p1 = __builtin_amdgcn_mfma_f32_32x32x16_bf16(b1, qr[d0], p1, 0, 0, 0); }
}
template <int NCB> __device__ __forceinline__ int v_st(int k, int c) { const int kk = (k & ~0xC) | ((k & 4) << 1) | ((k & 8) >> 1); return ((kk >> 3) * NCB + (c >> 5)) * 512 + ((kk & 7) * 32 + (c & 31)) * 2; }
__device__ __forceinline__ int v_rd_base(int lane) { return ((lane & 3) << 3) | (((lane >> 2) & 3) << 6) | (((lane >> 4) & 1) << 5) | (((lane >> 5) & 1) << 8); }
template <int OFF> __device__ __forceinline__ s16x4 tr_read(int vb) {
  s16x4 r; asm volatile("ds_read_b64_tr_b16 %0, %1 offset:%2" : "=&v"(r) : "v"(vb), "i"(OFF) : "memory"); return r;
}
template <int NCB, int D0> __device__ __forceinline__ void pv_one(f32x16& od, int vb, bf16x8 pa0, bf16x8 pa1, bf16x8 pa2, bf16x8 pa3) {
#define VOFF(ks, half) (D0 * 512 + (ks) * (NCB * 1024) + (half) * (NCB * 512))
  const s16x4 l0 = tr_read<VOFF(0, 0)>(vb), h0 = tr_read<VOFF(0, 1)>(vb), l1 = tr_read<VOFF(1, 0)>(vb), h1 = tr_read<VOFF(1, 1)>(vb);
  const s16x4 l2 = tr_read<VOFF(2, 0)>(vb), h2 = tr_read<VOFF(2, 1)>(vb), l3 = tr_read<VOFF(3, 0)>(vb), h3 = tr_read<VOFF(3, 1)>(vb);
#undef VOFF
  asm volatile("s_waitcnt lgkmcnt(0)" ::: "memory"); SBAR();
#define PK(L, H) (bf16x8){L[0], L[1], L[2], L[3], H[0], H[1], H[2], H[3]}
  od = __builtin_amdgcn_mfma_f32_32x32x16_bf16(pa0, PK(l0, h0), od, 0, 0, 0);
  od = __builtin_amdgcn_mfma_f32_32x32x16_bf16(pa1, PK(l1, h1), od, 0, 0, 0);
  od = __builtin_amdgcn_mfma_f32_32x32x16_bf16(pa2, PK(l2, h2), od, 0, 0, 0);
  od = __builtin_amdgcn_mfma_f32_32x32x16_bf16(pa3, PK(l3, h3), od, 0, 0, 0);
#undef PK
}
template <int NCB> __device__ __forceinline__ void pv_all(f32x16* o, int vb, bf16x8 pa0, bf16x8 pa1, bf16x8 pa2, bf16x8 pa3) {
  pv_one<NCB, 0>(o[0], vb, pa0, pa1, pa2, pa3); pv_one<NCB, 1>(o[1], vb, pa0, pa1, pa2, pa3);
  if constexpr (NCB == 4) { pv_one<NCB, 2>(o[2], vb, pa0, pa1, pa2, pa3); pv_one<NCB, 3>(o[3], vb, pa0, pa1, pa2, pa3); }
}

template <int DQK, int DV, int MODE, int QPOST, int NEGM, int ldq, int ldk, int ldo>
__device__ __forceinline__ void attn_body_seq(const bf16_t* __restrict__ Qb, const bf16_t* __restrict__ Kp, const bf16_t* __restrict__ K2p, const bf16_t* __restrict__ Vp,
                                              int krow_base, bf16_t* __restrict__ OG, int NT, int na_r0, char* lds, int tid, int dummy, const float* qgain, const float2* qtab, int q_t0) {
  constexpr int NQ = DQK / 16, NCB = DV / 32, SHM_K = 64 * DQK * 2, SHM_V = 64 * DV * 2, RB = DQK * 2;
  constexpr int NKC = DQK / 64, NVC = DV / 64;
  const int wid = tid >> 6, lane = tid & 63, r32 = lane & 31, hi = lane >> 5;
  char* V_lds = lds; char* K_lds = lds + 2 * SHM_V;
  float* wsl = (float*)(lds + 2 * SHM_V + 2 * SHM_K) + wid * 64; float* li_l = wsl; float* al_l = wsl + 32;
  const float* bias_l = (const float*)(lds + 2 * SHM_V + 2 * SHM_K + 8 * 64 * 4);
  float m_reg = -1e30f, l_reg = 0; f32x16 o[NCB]; bf16x8 qr[NQ];
#pragma unroll
  for (int d = 0; d < NCB; ++d) o[d] = f32x16{};
  const bf16_t* Qw = Qb + (size_t)(wid * 32 + r32) * ldq + hi * 8;
#pragma unroll
  for (int d0 = 0; d0 < NQ; ++d0) qr[d0] = *reinterpret_cast<const bf16x8*>(Qw + d0 * 16);
  if constexpr (QPOST == 1) {
    float xq[8][8]; float ss = 0;
#pragma unroll
    for (int d0 = 0; d0 < 8; ++d0)
#pragma unroll
      for (int j = 0; j < 8; ++j) { xq[d0][j] = bf2f(qr[d0][j]); ss += xq[d0][j] * xq[d0][j]; }
    { auto rr = __builtin_amdgcn_permlane32_swap(__float_as_uint(ss), __float_as_uint(ss), false, false); ss = __uint_as_float(rr[0]) + __uint_as_float(rr[1]); }
    const float rstd = rsqrtf(ss * (1.f / 128.f) + EPS) * (NEGM ? ScaleOf<DQK>::v * 1.4426950408889634f : 1.f);
#pragma unroll
    for (int d0 = 0; d0 < 8; ++d0) { const f32x4 g0 = *(const f32x4*)(qgain + d0 * 16 + hi * 8), g1 = *(const f32x4*)(qgain + d0 * 16 + hi * 8 + 4);
#pragma unroll
      for (int j = 0; j < 4; ++j) { xq[d0][j] *= rstd * g0[j]; xq[d0][4 + j] *= rstd * g1[j]; } }
    if (q_t0 >= 0) { const int t = q_t0 + wid * 32 + r32, prow = t >> 6, pcol = t & 63;
#pragma unroll
      for (int dd = 0; dd < 4; ++dd) { const int d0 = (dd & 1) + (dd >> 1) * 4, pos = (dd >> 1) ? pcol : prow; const float2* tp = qtab + pos * 32 + (d0 & 1) * 16 + hi * 8;
#pragma unroll
        for (int j = 0; j < 8; ++j) { const float2 cs = tp[j]; const float x0 = xq[d0][j], x1 = xq[d0 + 2][j]; xq[d0][j] = x0 * cs.x - x1 * cs.y; xq[d0 + 2][j] = x1 * cs.x + x0 * cs.y; } } }
#pragma unroll
    for (int d0 = 0; d0 < 8; ++d0) qr[d0] = pack8(xq[d0]);
  }
  if constexpr (DQK == 192) {
    if (q_t0 >= 0) { const int t = q_t0 + wid * 32 + r32, prow = t >> 6, pcol = t & 63;
#pragma unroll
      for (int ax = 0; ax < 2; ++ax) { const float2* tp = qtab + (ax ? pcol : prow) * 16 + hi * 8; float y0[8], y1[8];
#pragma unroll
        for (int j = 0; j < 8; ++j) { const float2 cs = tp[j]; const float x0 = bf2f(qr[8 + 2 * ax][j]), x1 = bf2f(qr[9 + 2 * ax][j]); y0[j] = x0 * cs.x - x1 * cs.y; y1[j] = x1 * cs.x + x0 * cs.y; }
        qr[8 + 2 * ax] = pack8(y0); qr[9 + 2 * ax] = pack8(y1); } }
  }
  if constexpr (NEGM == 1 && QPOST != 1) {
    constexpr float C = ScaleOf<DQK>::v * 1.4426950408889634f;
#pragma unroll
    for (int d0 = 0; d0 < NQ; ++d0) { float y[8];
#pragma unroll
      for (int j = 0; j < 8; ++j) y[j] = bf2f(qr[d0][j]) * C;
      qr[d0] = pack8(y); }
  }
  f32x16 negm = f32x16{};
  if constexpr (NEGM == 1) m_reg = 0.f;
  const int sr = tid >> 4, sc = (tid & 15) * 8, sr8 = tid >> 3, sc8 = (tid & 7) * 8;
  const int vb0 = (int)(uintptr_t)V_lds + v_rd_base(lane);
  auto tile_row = [&](int j) -> int {
    if constexpr (MODE == 0) return krow_base + j * 64;
    else { if (j < 4) return krow_base + j * 64; int kr = na_r0 - 8 + j; kr = kr < 0 ? 0 : (kr > 127 ? 127 : kr); return krow_base + CTX + kr * 64; }
  };
  auto na_mask = [&](f32x16& p0, f32x16& p1, int j) {
    if constexpr (MODE == 1) {
      if (j >= 4) {
        const int krraw = na_r0 - 8 + j, r = na_r0 + (wid >> 1);
        int rs = r - 4; rs = rs < 0 ? 0 : (rs > 120 ? 120 : rs);
        const float NINF = -__builtin_inff();
        if (krraw < rs || krraw >= rs + 8) {
#pragma unroll
          for (int q = 0; q < 16; ++q) { p0[q] = NINF; p1[q] = NINF; }
        } else {
          const float* brow = bias_l + (krraw - r + 7) * 32;
          const int c = (wid & 1) * 32 + r32; int cs = c - 8; cs = cs < 0 ? 0 : (cs > 48 ? 48 : cs);
#pragma unroll
          for (int q = 0; q < 16; ++q) {
            const int k0 = crow(q, hi), k1 = 32 + k0;
            int i0 = k0 - c + 15, i1 = k1 - c + 15; i0 = i0 < 0 ? 0 : (i0 > 30 ? 30 : i0); i1 = i1 < 0 ? 0 : (i1 > 30 ? 30 : i1);
            const float b0 = brow[i0], b1 = brow[i1];
            p0[q] = (k0 >= cs && k0 < cs + 16) ? p0[q] + b0 : NINF;
            p1[q] = (k1 >= cs && k1 < cs + 16) ? p1[q] + b1 : NINF;
          }
        }
      }
    }
  };
  bf16x8 sk[NKC], sv[NVC];
#define SLOAD(j) do { const size_t kr_ = (size_t)tile_row(j);                                                                      \
    if constexpr (DQK >= 128) { sk[0] = *reinterpret_cast<const bf16x8*>(Kp + (kr_ + sr) * ldk + sc); sk[1] = *reinterpret_cast<const bf16x8*>(Kp + (kr_ + 32 + sr) * ldk + sc); } \
    if constexpr (DQK == 192) sk[2] = *reinterpret_cast<const bf16x8*>(K2p + (kr_ + sr8) * ldk + sc8);                                       \
    if constexpr (DQK == 64) sk[0] = *reinterpret_cast<const bf16x8*>(Kp + (kr_ + sr8) * ldk + sc8);                                         \
    if constexpr (DV == 128) { sv[0] = *reinterpret_cast<const bf16x8*>(Vp + (kr_ + sr) * ldk + sc); sv[1] = *reinterpret_cast<const bf16x8*>(Vp + (kr_ + 32 + sr) * ldk + sc); } \
    else sv[0] = *reinterpret_cast<const bf16x8*>(Vp + (kr_ + sr8) * ldk + sc8); } while (0)
#define KSW(row, colB) ((row) * RB + ((colB) ^ ((((DQK >= 128) && ((colB) < 256)) ? ((row) & 15) : ((row) & 7)) << 4)))
#define SWRITE(b) do {                                                                                                                          \
    if constexpr (DV == 128) { *(bf16x8*)(V_lds + (b) * SHM_V + v_st<NCB>(sr, sc)) = sv[0]; *(bf16x8*)(V_lds + (b) * SHM_V + v_st<NCB>(32 + sr, sc)) = sv[1]; } \
    else *(bf16x8*)(V_lds + (b) * SHM_V + v_st<NCB>(sr8, sc8)) = sv[0];                                                                        \
    if constexpr (DQK >= 128) { *(bf16x8*)(K_lds + (b) * SHM_K + KSW(sr, sc * 2)) = sk[0]; *(bf16x8*)(K_lds + (b) * SHM_K + KSW(32 + sr, sc * 2)) = sk[1]; } \
    if constexpr (DQK == 192) *(bf16x8*)(K_lds + (b) * SHM_K + KSW(sr8, 256 + sc8 * 2)) = sk[2];                                              \
    if constexpr (DQK == 64) *(bf16x8*)(K_lds + (b) * SHM_K + KSW(sr8, sc8 * 2)) = sk[0]; } while (0)
  SLOAD(0); asm volatile("s_waitcnt vmcnt(0)" ::: "memory"); SWRITE(0); __syncthreads();
  for (int j = 0; j < NT; ++j) {
    const int bsel = j & 1;
    if (j + 1 < NT) SLOAD(j + 1);
    SBAR();
    bool skip = false;
    if constexpr (MODE == 1) { if (j >= 4) { const int krraw = na_r0 - 8 + j, r = na_r0 + (wid >> 1); int rs = r - 4; rs = rs < 0 ? 0 : (rs > 120 ? 120 : rs); skip = (krraw < rs) || (krraw >= rs + 8); } }
    if (!skip) {
    f32x16 p0, p1; float mn, al; bf16x8 pa0, pa1, pa2, pa3;
    if constexpr (NEGM == 1) { qkt<DQK>(p0, p1, K_lds + bsel * SHM_K, qr, r32, hi, negm); na_mask(p0, p1, j); partialSM2(p0, p1, m_reg, al, negm, j == 0); }
    else { qkt<DQK>(p0, p1, K_lds + bsel * SHM_K, qr, r32, hi); na_mask(p0, p1, j); partialSM<DQK>(p0, p1, m_reg, mn, al); }
    finishSM(p0, p1, al, l_reg, pa0, pa1, pa2, pa3);
    if (__any(al < 1.f)) { if (hi == 0) al_l[r32] = al; asm volatile("s_waitcnt lgkmcnt(0)" ::: "memory");
#pragma unroll
      for (int d = 0; d < NCB; ++d)
#pragma unroll
        for (int r = 0; r < 16; ++r) o[d][r] *= al_l[crow(r, hi)]; }
    SBAR();
    pv_all<NCB>(o, vb0 + bsel * SHM_V, pa0, pa1, pa2, pa3);
    }
    if (j + 1 < NT) SWRITE(bsel ^ 1);
    __syncthreads();
  }
  if (dummy) { if (l_reg == 123.456f) OG[tid] = (bf16_t)(cvtpk(o[0][0], o[1][3]) & 0xffffu); return; }
  if (hi == 0) li_l[r32] = l_reg; asm volatile("s_waitcnt lgkmcnt(0)" ::: "memory");
  float rli[16];
#pragma unroll
  for (int r = 0; r < 16; ++r) rli[r] = __builtin_amdgcn_rcpf(li_l[crow(r, hi)]);
  bf16_t* Ow = OG + (size_t)(wid * 32) * ldo;
#pragma unroll
  for (int r = 0; r < 16; ++r) { const int orow = crow(r, hi);
#pragma unroll
    for (int d0 = 0; d0 < NCB; ++d0) { bf16_t* pp = Ow + (size_t)orow * ldo + d0 * 32 + r32;
      const float g = bf2f((short)*pp); const float v = o[d0][r] * rli[r] * silu_f(g);
      *pp = (bf16_t)(cvtpk(v, v) & 0xffffu); } }
#undef SLOAD
#undef SWRITE
#undef KSW
}

__device__ __forceinline__ void phase_pre(KP p, char* lds, const int tid) {
  float* tl = (float*)lds;
  for (int tt = blockIdx.x; tt < WTAB.ntiles; tt += gridDim.x) {
    int di = 0;
    for (int i = 1; i < NWD; ++i) if (tt >= WTAB.d[i].tile0) di = i;
    const WDesc wd = WTAB.d[di];
    const float* src = p->in[wd.in_idx] + wd.src_off; bf16_t* dst = (bf16_t*)(p->ws + OFF_W) + wd.dst_off; const int K = wd.K, N = wd.N, local = tt - wd.tile0;
    const int nkt = K >> 6, kt = local % nkt, ntile = local / nkt;
    const int kk = tid >> 3, n8 = (tid & 7) * 8;
    f32x4 a = {0.f, 0.f, 0.f, 0.f}, b = a;
    if (ntile * 64 < N) { const float* sp = src + (size_t)(kt * 64 + kk) * N + ntile * 64 + n8; a = *(const f32x4*)sp; b = *(const f32x4*)(sp + 4); }
    __syncthreads();
#pragma unroll
    for (int i = 0; i < 4; ++i) { tl[(n8 + i) * 65 + kk] = a[i]; tl[(n8 + 4 + i) * 65 + kk] = b[i]; }
    __syncthreads();
    const int n = tid >> 3, k8 = (tid & 7) * 8; float v[8];
#pragma unroll
    for (int i = 0; i < 8; ++i) v[i] = tl[n * 65 + k8 + i];
    *(bf16x8*)(dst + (size_t)(ntile * 64 + n) * K + kt * 64 + k8) = pack8(v);
  }
  float* part = (float*)(p->ws + OFF_MODP);
  for (int it = blockIdx.x; it < 4 * 16 * 6; it += gridDim.x) {
    const int nb = it % 6, kc = (it / 6) & 15, layer = it / 96;
    __syncthreads();
    if (tid < 320) { const int s = tid >> 6, kk = tid & 63; const float cv = s < 4 ? p->in[IN_C][s * DM + kc * 64 + kk] : p->in[IN_CCTX][kc * 64 + kk]; tl[tid] = silu_f(cv); }
    __syncthreads();
    const int n = nb * 512 + tid; const float* wp = p->in[IN_MODW] + ((size_t)layer * DM + kc * 64) * 3072 + n;
    float a0 = 0, a1 = 0, a2 = 0, a3 = 0, a4 = 0;
#pragma unroll 8
    for (int kk = 0; kk < 64; ++kk) { const float w = wp[(size_t)kk * 3072]; a0 += tl[kk] * w; a1 += tl[64 + kk] * w; a2 += tl[128 + kk] * w; a3 += tl[192 + kk] * w; a4 += tl[256 + kk] * w; }
    float* pp = part + ((size_t)(kc * 4 + layer) * 5) * 3072 + n;
    pp[0] = a0; pp[3072] = a1; pp[2 * 3072] = a2; pp[3 * 3072] = a3; pp[4 * 3072] = a4;
  }
  for (int i = blockIdx.x * NTHREADS + tid; i < 128 * 48; i += gridDim.x * NTHREADS) {
    int pos, f; float inv; float2* dstp;
    if (i < 128 * 32) { pos = i >> 5; f = i & 31; inv = INV_A[f]; dstp = (float2*)(p->ws + OFF_TABA) + i; }
    else { const int q = i - 128 * 32; pos = q >> 4; f = q & 15; inv = INV_M[f]; dstp = (float2*)(p->ws + OFF_TABM) + q; }
    const float angf = (float)pos * inv;
    const double ang = (double)angf, k = __builtin_rint(ang * 0.15915494309189535), r = ang - k * 6.283185307179586476925287, r2 = r * r;
    double sn = r, cs = 1.0, ts = r, tc = 1.0;
#pragma unroll 1
    for (int q = 1; q <= 14; ++q) { tc = -tc * r2 / (double)((2 * q - 1) * (2 * q)); cs += tc; ts = -ts * r2 / (double)((2 * q) * (2 * q + 1)); sn += ts; }
    *dstp = make_float2((float)cs, (float)sn);
  }
}
__device__ __forceinline__ void phase_modfin(KP p, const int tid) {
  const float* part = (const float*)(p->ws + OFF_MODP); float* mod = (float*)(p->ws + OFF_MOD);
  for (int i = blockIdx.x * NTHREADS + tid; i < 4 * 5 * 3072; i += gridDim.x * NTHREADS) {
    const int n = i % 3072, layer = i / (5 * 3072);
    float a = p->in[IN_MODB][layer * 3072 + n];
#pragma unroll
    for (int kc = 0; kc < 16; ++kc) a += part[(size_t)kc * (4 * 5 * 3072) + i];
    mod[i] = a;
  }
}
__device__ __forceinline__ void phase_norm(KP p, int layer, const int tid) {
  const int lane = tid & 63, gw = blockIdx.x * 8 + (tid >> 6), nw = gridDim.x * 8;
  const float* mod = (const float*)(p->ws + OFF_MOD) + (size_t)layer * 5 * 3072; const float* g = p->in[IN_NORMG] + layer * DM; bf16_t* hb = (bf16_t*)(p->ws + OFF_HB);
  for (int row0 = gw * 4; row0 < T; row0 += nw * 4) {
    f32x4 v[4][4];
#pragma unroll
    for (int r = 0; r < 4; ++r) { const float* xr = res_src(p, layer, row0 + r);
#pragma unroll
      for (int i = 0; i < 4; ++i) v[r][i] = *(const f32x4*)(xr + i * 256 + lane * 4); }
    const int b = row0 / TPB, j = row0 - b * TPB; const float* m = mod + (j < CTX ? 4 : b) * 3072;
    f32x4 gm[4], sh[4];
#pragma unroll
    for (int i = 0; i < 4; ++i) { const int col = i * 256 + lane * 4; const f32x4 gg = *(const f32x4*)(g + col), scl = *(const f32x4*)(m + 1024 + col); sh[i] = *(const f32x4*)(m + col); gm[i] = gg * (1.f + scl); }
#pragma unroll
    for (int r = 0; r < 4; ++r) {
      float ss = 0;
#pragma unroll
      for (int i = 0; i < 4; ++i) ss += v[r][i][0] * v[r][i][0] + v[r][i][1] * v[r][i][1] + v[r][i][2] * v[r][i][2] + v[r][i][3] * v[r][i][3];
      ss = wave_sum(ss); const float rstd = rsqrtf(ss * (1.f / DM) + EPS);
#pragma unroll
      for (int i = 0; i < 4; ++i) { const int col = i * 256 + lane * 4; const f32x4 y = v[r][i] * rstd * gm[i] + sh[i];
        u32x2 w = {cvtpk(y[0], y[1]), cvtpk(y[2], y[3])}; *(u32x2*)(hb + (size_t)(row0 + r) * DM + col) = w; }
    }
  }
}
__device__ __forceinline__ void phase_final(KP p, int dummy, const int tid) {
  const int lane = tid & 63, gw = blockIdx.x * 8 + (tid >> 6), nw = gridDim.x * 8;
  const float* outp = p->out; float* dstp = dummy ? (float*)(p->ws + OFF_PJ) : p->out; const float* fg = p->in[IN_FINALG];
  f32x4 gg[4];
#pragma unroll
  for (int i = 0; i < 4; ++i) gg[i] = *(const f32x4*)(fg + i * 256 + lane * 4);
  for (int row0 = gw * 4; row0 < NB * SEQ; row0 += nw * 4) {
    f32x4 v[4][4];
#pragma unroll
    for (int r = 0; r < 4; ++r)
#pragma unroll
      for (int i = 0; i < 4; ++i) v[r][i] = *(const f32x4*)(outp + (size_t)(row0 + r) * DM + i * 256 + lane * 4);
#pragma unroll
    for (int r = 0; r < 4; ++r) {
      float ss = 0;
#pragma unroll
      for (int i = 0; i < 4; ++i) ss += v[r][i][0] * v[r][i][0] + v[r][i][1] * v[r][i][1] + v[r][i][2] * v[r][i][2] + v[r][i][3] * v[r][i][3];
      ss = wave_sum(ss); const float rstd = rsqrtf(ss * (1.f / DM) + EPS);
#pragma unroll
      for (int i = 0; i < 4; ++i) *(f32x4*)(dstp + (size_t)(row0 + r) * DM + i * 256 + lane * 4) = v[r][i] * rstd * gg[i];
    }
  }
}
__device__ __forceinline__ void phase_gqa_post(KP p, int j, int dummy, const int tid) {
  const int lane = tid & 63, gw = blockIdx.x * 8 + (tid >> 6), nw = gridDim.x * 8, g4 = lane >> 4, i = lane & 15;
  bf16_t* pj = (bf16_t*)(p->ws + (dummy ? OFF_QM : OFF_PJ)); const int ldp = dummy ? 1280 : 2560; const float2* tab = (const float2*)(p->ws + OFF_TABA);
  const float* kg = p->in[IN_GA_KG] + j * 128 + i * 8;
  float gk[8];
#pragma unroll
  for (int e = 0; e < 8; ++e) gk[e] = kg[e];
  const int axis = i >> 3, half = (i >> 2) & 1;
  for (int wi0 = gw * 4; wi0 < T * 2 / 4; wi0 += nw * 4) {
    bf16x8 raw[4]; bf16_t* ptr[4]; int rw[4];
#pragma unroll
    for (int u = 0; u < 4; ++u) { const int hv = (wi0 + u) * 4 + g4; rw[u] = hv >> 1; ptr[u] = pj + (size_t)rw[u] * ldp + 1024 + (hv & 1) * 128 + i * 8; raw[u] = *(const bf16x8*)ptr[u]; }
#pragma unroll
    for (int u = 0; u < 4; ++u) {
      float x[8]; float ss = 0;
#pragma unroll
      for (int e = 0; e < 8; ++e) { x[e] = bf2f(raw[u][e]); ss += x[e] * x[e]; }
      ss += __shfl_xor(ss, 1); ss += __shfl_xor(ss, 2); ss += __shfl_xor(ss, 4); ss += __shfl_xor(ss, 8);
      const float rstd = rsqrtf(ss * (1.f / 128.f) + EPS);
#pragma unroll
      for (int e = 0; e < 8; ++e) x[e] = x[e] * rstd * gk[e];
      const int b = rw[u] / TPB, jj = rw[u] - b * TPB; const bool lat = jj >= CTX; const int t = jj - CTX;
      const int pos = lat ? (axis ? (t & 63) : (t >> 6)) : 0;
      float y[8];
#pragma unroll
      for (int e = 0; e < 8; ++e) { const float xp = __shfl_xor(x[e], 4); const float2 cs = tab[pos * 32 + (i & 3) * 8 + e];
        y[e] = lat ? (half ? x[e] * cs.x + xp * cs.y : x[e] * cs.x - xp * cs.y) : x[e]; }
      *(bf16x8*)ptr[u] = pack8(y);
    }
  }
}
__device__ __forceinline__ void phase_mla_post1(KP p, int dummy, const int tid) {
  const int lane = tid & 63, gw = blockIdx.x * 8 + (tid >> 6), nw = gridDim.x * 8;
  bf16_t* pj = (bf16_t*)(p->ws + (dummy ? OFF_HB : OFF_PJ)); const int ldp = dummy ? 1024 : 2048; const float2* tab = (const float2*)(p->ws + OFF_TABM); const float* qgp = p->in[IN_ML_QG]; const float* kvgp = p->in[IN_ML_KVG];
  const int l2 = lane & 31, l3 = lane & 7;
  float gq[8], gkv[8];
#pragma unroll
  for (int e = 0; e < 8; ++e) { gq[e] = qgp[lane * 8 + e]; gkv[e] = kvgp[l2 * 8 + e]; }
  for (int row0 = gw * 2; row0 < T; row0 += nw * 2) {
    bf16x8 rq[2], rkv[2], rr[2];
#pragma unroll
    for (int u = 0; u < 2; ++u) { bf16_t* pr = pj + (size_t)(row0 + u) * ldp; rq[u] = *(const bf16x8*)(pr + lane * 8); rkv[u] = *(const bf16x8*)(pr + 512 + l2 * 8); rr[u] = *(const bf16x8*)(pr + 768 + l3 * 8); }
#pragma unroll
    for (int u = 0; u < 2; ++u) {
      const int row = row0 + u; bf16_t* pr = pj + (size_t)row * ldp;
      { float x[8]; float ss = 0;
#pragma unroll
        for (int e = 0; e < 8; ++e) { x[e] = bf2f(rq[u][e]); ss += x[e] * x[e]; }
        ss = wave_sum(ss); const float rstd = rsqrtf(ss * (1.f / 512.f) + EPS);
#pragma unroll
        for (int e = 0; e < 8; ++e) x[e] = x[e] * rstd * gq[e];
        *(bf16x8*)(pr + lane * 8) = pack8(x); }
      { float x[8]; float ss = 0;
#pragma unroll
        for (int e = 0; e < 8; ++e) { x[e] = bf2f(rkv[u][e]); ss += x[e] * x[e]; }
        ss = wave_sum(ss) * 0.5f; const float rstd = rsqrtf(ss * (1.f / 256.f) + EPS);
#pragma unroll
        for (int e = 0; e < 8; ++e) x[e] = x[e] * rstd * gkv[e];
        if (lane < 32) *(bf16x8*)(pr + 512 + l2 * 8) = pack8(x); }
      { const int b = row / TPB, jj = row - b * TPB; const bool lat = jj >= CTX; const int t = jj - CTX;
        const int axis = l3 >> 2, half = (l3 >> 1) & 1, pos = lat ? (axis ? (t & 63) : (t >> 6)) : 0; float y[8];
#pragma unroll
        for (int e = 0; e < 8; ++e) { const float x = bf2f(rr[u][e]); const float xp = __shfl_xor(x, 2); const float2 cs = tab[pos * 16 + (l3 & 1) * 8 + e];
          y[e] = half ? x * cs.x + xp * cs.y : x * cs.x - xp * cs.y; }
        if (lat && lane < 8) *(bf16x8*)(pr + 768 + l3 * 8) = pack8(y); }
    }
  }
}
__device__ __forceinline__ void phase_mla_post2(KP p, const int tid) {
  const int lane = tid & 63, gw = blockIdx.x * 8 + (tid >> 6), nw = gridDim.x * 8, h = lane >> 3, i = lane & 7;
  bf16_t* qm = (bf16_t*)(p->ws + OFF_QM); const float2* tab = (const float2*)(p->ws + OFF_TABM);
  const int axis = i >> 2, half = (i >> 1) & 1;
  for (int lr0 = gw * 4; lr0 < NB * SEQ; lr0 += nw * 4) {
    bf16x8 raw[4]; bf16_t* ptr[4];
#pragma unroll
    for (int u = 0; u < 4; ++u) { const int lr = lr0 + u, b = lr >> 13, t = lr & 8191; ptr[u] = qm + ((size_t)b * TPB + CTX + t) * 1536 + h * 192 + 128 + i * 8; raw[u] = *(const bf16x8*)ptr[u]; }
#pragma unroll
    for (int u = 0; u < 4; ++u) { const int t = (lr0 + u) & 8191, pos = axis ? (t & 63) : (t >> 6); float y[8];
#pragma unroll
      for (int e = 0; e < 8; ++e) { const float x = bf2f(raw[u][e]); const float xp = __shfl_xor(x, 2); const float2 cs = tab[pos * 16 + (i & 1) * 8 + e];
        y[e] = half ? x * cs.x + xp * cs.y : x * cs.x - xp * cs.y; }
      *(bf16x8*)ptr[u] = pack8(y); }
  }
}
__device__ __forceinline__ void phase_att_gqa(KP p, int need_ctx, int dummy, int jl, char* lds, const int tid) {
  bf16_t* pj = (bf16_t*)(p->ws + OFF_PJ); const float* qgain = p->in[IN_GA_QG] + jl * 128;
  const int nit = 1024 + (need_ctx ? 32 : 0);
  for (int it = blockIdx.x; it < nit; it += gridDim.x) {
    int b, h, row0, nt, qt0;
    if (it < 1024) { b = it >> 8; h = (it >> 5) & 7; row0 = b * TPB + CTX + (it & 31) * 256; nt = TPB / 64; qt0 = (it & 31) * 256; }
    else { const int q = it - 1024; b = q >> 3; h = q & 7; row0 = b * TPB; nt = CTX / 64; qt0 = -1; }
    __syncthreads();
    attn_body_seq<128, 128, 0, 1, 1, 2560, 2560, 2560>(pj + (size_t)row0 * 2560 + h * 128, pj + 1024 + (h >> 2) * 128, nullptr, pj + 1280 + (h >> 2) * 128, b * TPB,
                           pj + (size_t)row0 * 2560 + 1536 + h * 128, nt, 0, lds, tid, dummy, qgain, (const float2*)(p->ws + OFF_TABA), qt0);
  }
}
__device__ __forceinline__ void phase_att_mla(KP p, int need_ctx, int dummy, char* lds, const int tid) {
  bf16_t* pj = (bf16_t*)(p->ws + OFF_PJ); bf16_t* kvm = pj + (size_t)T * 2048; bf16_t* qm = (bf16_t*)(p->ws + OFF_QM);
  const int nit = 1024 + (need_ctx ? 32 : 0);
  for (int it = blockIdx.x; it < nit; it += gridDim.x) {
    int b, h, row0, nt, qt0;
    if (it < 1024) { b = it >> 8; h = (it >> 5) & 7; row0 = b * TPB + CTX + (it & 31) * 256; nt = TPB / 64; qt0 = (it & 31) * 256; }
    else { const int q = it - 1024; b = q >> 3; h = q & 7; row0 = b * TPB; nt = CTX / 64; qt0 = -1; }
    __syncthreads();
    attn_body_seq<192, 128, 0, 0, 0, 1536, 2048, 2048>(qm + (size_t)row0 * 1536 + h * 192, kvm + h * 256, pj + 768, kvm + h * 256 + 128, b * TPB,
                            pj + (size_t)row0 * 2048 + 832 + h * 128, nt, 0, lds, tid, dummy, nullptr, (const float2*)(p->ws + OFF_TABM), qt0);
  }
}
__device__ __forceinline__ void phase_att_na(KP p, int need_ctx, int dummy, char* lds, const int tid) {
  bf16_t* pj = (bf16_t*)(p->ws + OFF_PJ);
  float* bias_l = (float*)(lds + 2 * 8192 + 2 * 8192 + 8 * 64 * 4);
  const int nit = 2048 + (need_ctx ? 64 : 0);
  for (int it = blockIdx.x; it < nit; it += gridDim.x) {
    __syncthreads();
    int ntl = it < 2048 ? 16 : 4; asm volatile("" : "+s"(ntl));
    if (it < 2048) {
      const int b = it >> 9, h = (it >> 5) & 15, r0 = (it & 31) * 4, row0 = b * TPB + CTX + r0 * 64;
      if (tid < 15 * 32) { const int ro = tid >> 5, co = tid & 31; bias_l[tid] = co < 31 ? p->in[IN_NA_RPB][(h * 15 + ro) * 31 + co] * 1.4426950408889634f : 0.f; }
      attn_body_seq<64, 64, 1, 0, 1, 4096, 4096, 4096>(pj + (size_t)row0 * 4096 + h * 64, pj + 1024 + h * 64, nullptr, pj + 2048 + h * 64, b * TPB,
                           pj + (size_t)row0 * 4096 + 3072 + h * 64, ntl, r0, lds, tid, dummy, nullptr, nullptr, -1);
    } else {
      const int q = it - 2048, b = q >> 4, h = q & 15, row0 = b * TPB;
      attn_body_seq<64, 64, 0, 0, 1, 4096, 4096, 4096>(pj + (size_t)row0 * 4096 + h * 64, pj + 1024 + h * 64, nullptr, pj + 2048 + h * 64, b * TPB,
                           pj + (size_t)row0 * 4096 + 3072 + h * 64, ntl, 0, lds, tid, dummy, nullptr, nullptr, -1);
    }
  }
}

#define XB_TMO      128
#define XB_XCNT(j)  (256  + 64 * (j))
#define XB_XSUB(j)  (1280 + 64 * (j))
#define XB_XGEN(j)  (2304 + 64 * (j))
#define XB_TOP      3328
#define XB_TOPGEN   3392
#define XCD_BAR_WORDS 3456
#define XB_SPIN_CAP (1u << 22)
__device__ __forceinline__ unsigned xb_ld(unsigned* p)              { return __hip_atomic_load(p, __ATOMIC_RELAXED, __HIP_MEMORY_SCOPE_AGENT); }
__device__ __forceinline__ unsigned xb_add(unsigned* p, unsigned v) { return __hip_atomic_fetch_add(p, v, __ATOMIC_RELAXED, __HIP_MEMORY_SCOPE_AGENT); }
__device__ __forceinline__ unsigned xb_xcc_id() { return (unsigned)__builtin_amdgcn_s_getreg((3 << 11) | 20) & 0xFu; }
#define XB_SPIN(cond, bar) do { unsigned _sp = 0; while (cond) { __builtin_amdgcn_s_sleep(1); \
    if ((++_sp & 255u) == 0u) { if (xb_ld(&(bar)[XB_TMO])) break; if (_sp > XB_SPIN_CAP) { atomicAdd(&(bar)[XB_TMO], 1u); break; } } } } while (0)
struct XcdBarrier { unsigned* bar; unsigned x; volatile LAS unsigned* st; };
__device__ __forceinline__ XcdBarrier xcd_barrier_post(unsigned* bar, volatile LAS unsigned* st) {
    XcdBarrier b; b.bar = bar; b.x = xb_xcc_id(); b.st = st;
    if (threadIdx.x == 0) (void)xb_add(&bar[XB_XCNT(b.x)], 1u);
    return b;
}
__device__ __forceinline__ void xcd_barrier_complete(unsigned* bar, unsigned x, unsigned& nloc, unsigned& nx) {
    const unsigned G = gridDim.x * gridDim.y * gridDim.z;
    unsigned sum, cnt, mine, sp = 0u;
    for (;;) {
        sum = 0u; cnt = 0u; mine = 0u;
#pragma unroll
        for (unsigned j = 0; j < 16; ++j) { const unsigned c = xb_ld(&bar[XB_XCNT(j)]); sum += c; cnt += (c > 0u) ? 1u : 0u; mine = (j == x) ? c : mine; }
        if (sum == G) break;
        __builtin_amdgcn_s_sleep(1);
        if ((++sp & 255u) == 0u) { if (xb_ld(&bar[XB_TMO])) break; if (sp > XB_SPIN_CAP) { atomicAdd(&bar[XB_TMO], 1u); break; } }
    }
    nloc = mine > 0u ? mine : 1u; nx = cnt > 0u ? cnt : 1u;
}
__device__ __forceinline__ void xcd_barrier(const XcdBarrier& b, const int tid) {
    asm volatile("s_waitcnt vmcnt(0)" ::: "memory");
    __syncthreads();
    if (tid == 0) {
        unsigned* bar = b.bar;
        __builtin_amdgcn_s_waitcnt(0);
        unsigned nloc = b.st[0], nx = b.st[1];
        if (nloc == 0u) { xcd_barrier_complete(bar, b.x, nloc, nx); b.st[0] = nloc; b.st[1] = nx; }
        const unsigned old = xb_add(&bar[XB_XSUB(b.x)], 1u);
        const unsigned gen = old / nloc;
        if (old + 1u == (gen + 1u) * nloc) {
            __builtin_amdgcn_fence(__ATOMIC_RELEASE, "agent");
            asm volatile("s_waitcnt vmcnt(0)" ::: "memory");
            const unsigned og = xb_add(&bar[XB_TOP], 1u);
            const unsigned tg = og / nx;
            if (og + 1u == (tg + 1u) * nx) xb_add(&bar[XB_TOPGEN], 1u);
            else XB_SPIN(xb_ld(&bar[XB_TOPGEN]) == tg, bar);
            __builtin_amdgcn_fence(__ATOMIC_ACQUIRE, "agent");
            xb_add(&bar[XB_XGEN(b.x)], 1u);
            asm volatile("s_waitcnt vmcnt(0)" ::: "memory");
        } else {
            XB_SPIN(xb_ld(&bar[XB_XGEN(b.x)]) == gen, bar);
            __builtin_amdgcn_fence(__ATOMIC_ACQUIRE, "agent");
            asm volatile("s_waitcnt vmcnt(0)" ::: "memory");
        }
    }
    __syncthreads();
}

__global__ void __launch_bounds__(NTHREADS, 2) fwd_megakernel(const Params p_unused) {
  extern __shared__ __attribute__((aligned(16))) unsigned char shm[];
  cg::grid_group grid = cg::this_grid();
  char* lds = (char*)shm;
  __shared__ uint4 xb_words;
  const int wave_s = __builtin_amdgcn_readfirstlane((int)(threadIdx.x >> 6));
  if (threadIdx.x == 0) xb_words = make_uint4(0u, 0u, 0u, 0u);
  __syncthreads();
  { KP p0 = (KP)__builtin_amdgcn_kernarg_segment_ptr(); (void)xcd_barrier_post((unsigned*)(p0->ws + OFF_BAR), (volatile LAS unsigned*)&xb_words);
    phase_pre(p0, lds, (int)threadIdx.x); }
  { KP p0 = (KP)__builtin_amdgcn_kernarg_segment_ptr(); char* w0 = p0->ws;
    if (w0 == nullptr) grid.sync();
    XcdBarrier xb; xb.bar = (unsigned*)(w0 + OFF_BAR); xb.x = xb_xcc_id(); xb.st = (volatile LAS unsigned*)&xb_words; xcd_barrier(xb, (int)threadIdx.x); }
#ifndef PHM
#define PHM 0xffff
#endif
#define PH(k) if constexpr (((PHM) >> (k)) & 1)
  for (int oi = 1; oi < PROG.n; ++oi) {
    const Op op = PROG.ops[oi];
    unsigned zz = 0u; asm volatile("" : "+v"(zz));
    int tid = wave_s * 64 + (int)__builtin_amdgcn_mbcnt_hi(~0u, __builtin_amdgcn_mbcnt_lo(~0u, zz)); asm volatile("" : "+v"(tid));
    KP p = (KP)__builtin_amdgcn_kernarg_segment_ptr(); asm volatile("" : "+s"(p));
    char* ws = p->ws;
    switch (op.type) {
      case OP_MODFIN: PH(1) phase_modfin(p, tid); break;
      case OP_NORM: PH(2) phase_norm(p, op.i0, tid); break;
      case OP_GEMM_BF: case OP_GEMM_BF_NOSYNC: PH(3) {
        pg8::Gemm g{(const bf16_t*)(ws + op.a), (const bf16_t*)(ws + op.b), T, op.i0, op.i1, op.i2};
        pg8::StaticOrder S; S.init(T, op.i0, (int)gridDim.x, (int)blockIdx.x);
        pg8::EpiBf16 E{(bf16_t*)(ws + op.o), op.i0};
        pg8::gemm_phase<pg8::EpiBf16>((LAS unsigned char*)shm, g, S, E, tid);
      } break;
      case OP_GEMM_RES: PH(4) {
        pg8::Gemm g{(const bf16_t*)(ws + op.a), (const bf16_t*)(ws + op.b), T, DM, DM, op.i2};
        pg8::StaticOrder S; S.init(T, DM, (int)gridDim.x, (int)blockIdx.x, op.i0 == DEPTH - 1);
        float* xsc = (float*)(ws + OFF_XSC); float* outp = p->out;
        pg8::EpiResid E{op.i0 == 0 ? p->in[IN_X] : (const float*)outp, op.i0 == 0 ? p->in[IN_CTX] : (const float*)xsc, outp, xsc, (const float*)(ws + OFF_MOD) + (size_t)op.i0 * 5 * 3072};
        pg8::gemm_phase<pg8::EpiResid>((LAS unsigned char*)shm, g, S, E, tid);
      } break;
      case OP_GQA_POST: PH(5) phase_gqa_post(p, op.i0, op.i1, tid); break;
      case OP_ATT_GQA: PH(6) phase_att_gqa(p, op.i0, op.i1, op.i2, lds, tid); break;
      case OP_ATT_NA: PH(7) phase_att_na(p, op.i0, op.i1, lds, tid); break;
      case OP_MLA_POST1: PH(8) phase_mla_post1(p, op.i1, tid); break;
      case OP_MLA_POST2: PH(9) phase_mla_post2(p, tid); break;
      case OP_ATT_MLA: PH(10) phase_att_mla(p, op.i0, op.i1, lds, tid); break;
      case OP_FINAL: PH(11) phase_final(p, op.i1, tid); break;
      default: break;
    }
    if (op.type == OP_GEMM_BF_NOSYNC) __syncthreads(); else { XcdBarrier xb; xb.bar = (unsigned*)(ws + OFF_BAR); xb.x = xb_xcc_id(); xb.st = (volatile LAS unsigned*)&xb_words; xcd_barrier(xb, tid);
      if (PROBE_DUP & 512) { xcd_barrier(xb, tid); xcd_barrier(xb, tid); } }
  }
}

extern "C" void kernel_launch(void* const* d_in, const int* in_sizes, int n_in, void* d_out, int out_size, void* d_ws, size_t ws_size, hipStream_t stream) {
  static int grid_blocks = 0;
  if (!grid_blocks) {
    if (ws_size < WS_END) { fprintf(stderr, "kernel_launch: workspace too small: %zu < %zu\n", ws_size, (size_t)WS_END); return; }
    if (hipFuncSetAttribute((const void*)fwd_megakernel, hipFuncAttributeMaxDynamicSharedMemorySize, LDS_BYTES) != hipSuccess) { fprintf(stderr, "kernel_launch: hipFuncSetAttribute failed\n"); return; }
    int dev = 0, cus = 0, per_cu = 0;
    hipGetDevice(&dev);
    hipDeviceGetAttribute(&cus, hipDeviceAttributeMultiprocessorCount, dev);
    hipOccupancyMaxActiveBlocksPerMultiprocessor(&per_cu, fwd_megakernel, NTHREADS, LDS_BYTES);
    if (per_cu < 1) { fprintf(stderr, "kernel_launch: occupancy query returned %d\n", per_cu); return; }
    grid_blocks = cus;
  }
  Params p; memset(&p, 0, sizeof(p));
  if (n_in != N_IN) { fprintf(stderr, "kernel_launch: expected %d inputs, got %d\n", (int)N_IN, n_in); return; }
  for (int i = 0; i < N_IN; ++i) p.in[i] = (const float*)d_in[i];
  p.out = (float*)d_out; p.ws = (char*)d_ws;
  hipMemsetAsync((char*)d_ws + OFF_BAR, 0, XCD_BAR_WORDS * 4, stream);
  void* args[] = {&p};
  hipError_t e = hipLaunchCooperativeKernel((const void*)fwd_megakernel, dim3(grid_blocks), dim3(NTHREADS), args, LDS_BYTES, stream);
  if (e != hipSuccess) fprintf(stderr, "kernel_launch: cooperative launch failed: %s (grid %d)\n", hipGetErrorString(e), grid_blocks);
}
```

```cpp
#include <hip/hip_runtime.h>
#include <hip/hip_cooperative_groups.h>
#include <cstdio>
#include <cstring>
namespace cg = cooperative_groups;

#define LAS __attribute__((address_space(3)))
typedef unsigned short bf16_t;
typedef short bf16x8 __attribute__((ext_vector_type(8)));
typedef short s16x4 __attribute__((ext_vector_type(4)));
typedef float f32x4 __attribute__((ext_vector_type(4)));
typedef float f32x16 __attribute__((ext_vector_type(16)));
typedef unsigned u32x4 __attribute__((ext_vector_type(4)));
typedef unsigned u32x2 __attribute__((ext_vector_type(2)));

constexpr int NB = 4, SEQ = 8192, CTX = 256, DM = 1024, TPB = SEQ + CTX, T = NB * TPB;
constexpr int DEPTH = 4;
constexpr float EPS = 1e-6f;
constexpr int NTHREADS = 512;
constexpr int LDS_BYTES = 131072;

constexpr size_t OFF_XSC = 0;
constexpr size_t OFF_HB = OFF_XSC + (size_t)NB * CTX * DM * 4;
constexpr size_t OFF_PJ = OFF_HB + (size_t)T * DM * 2;
constexpr size_t OFF_QM = OFF_PJ + (size_t)T * 4096 * 2;
constexpr size_t OFF_W = OFF_QM + (size_t)T * 1536 * 2;
constexpr size_t W_GA_IN = 0, W_GA_OUT = W_GA_IN + 2ull * 2560 * 1024, W_NA_IN = W_GA_OUT + 2ull * 1024 * 1024, W_NA_OUT = W_NA_IN + 4096ull * 1024,
                 W_ML_IN = W_NA_OUT + 1024ull * 1024, W_ML_UQ = W_ML_IN + 2048ull * 1024, W_ML_UKV = W_ML_UQ + 1536ull * 512, W_ML_OUT = W_ML_UKV + 2048ull * 256,
                 W_END = W_ML_OUT + 1024ull * 1024;
constexpr size_t OFF_MODP = OFF_W + W_END * 2;
constexpr size_t OFF_MOD = OFF_MODP + 16ull * 4 * 5 * 3072 * 4;
constexpr size_t OFF_TABA = OFF_MOD + 4ull * 5 * 3072 * 4;
constexpr size_t OFF_TABM = OFF_TABA + 128ull * 32 * 8;
constexpr size_t OFF_BAR = OFF_TABM + 128ull * 16 * 8;
constexpr size_t WS_END = OFF_BAR + 3456ull * 4;

struct Op { int type, i0, i1, i2; unsigned long long a, b, o; };
enum { OP_PRE = 0, OP_MODFIN, OP_NORM, OP_GEMM_BF, OP_GEMM_RES, OP_GQA_POST, OP_ATT_GQA, OP_ATT_NA, OP_MLA_POST1, OP_MLA_POST2, OP_ATT_MLA, OP_FINAL, OP_GEMM_BF_NOSYNC };
enum { IN_X = 0, IN_C, IN_CTX, IN_CCTX, IN_MODW, IN_MODB, IN_NORMG, IN_FINALG, IN_GA_WIN, IN_GA_QG, IN_GA_KG, IN_GA_WOUT, IN_NA_WIN, IN_NA_RPB, IN_NA_WOUT,
       IN_ML_WIN, IN_ML_QG, IN_ML_KVG, IN_ML_WUQ, IN_ML_WUKV, IN_ML_WOUT, N_IN };
struct Params { const float* in[N_IN]; float* out; char* ws; };
#define KAS __attribute__((address_space(4)))
typedef const KAS Params* KP;

#ifndef PROBE_DUP
#define PROBE_DUP 0
#endif
constexpr int MAXOPS = 64;
struct Prog { Op ops[MAXOPS]; int n; };
constexpr void prog_add1(Prog& P, int type, int i0, int i1, int i2, size_t a, size_t b, size_t o) { Op& q = P.ops[P.n++]; q.type = type; q.i0 = i0; q.i1 = i1; q.i2 = i2; q.a = a; q.b = b; q.o = o; }
constexpr void prog_add(Prog& P, int type, int i0, int i1, int i2, size_t a, size_t b, size_t o) {
  const bool gemm = type == OP_GEMM_BF || type == OP_GEMM_BF_NOSYNC;
  if ((PROBE_DUP & 1) && gemm) prog_add1(P, OP_GEMM_BF, i0, i1, i2, a, b, o);
  if ((PROBE_DUP & 2) && type == OP_ATT_GQA) prog_add1(P, type, i0, 1, i2, a, b, o);
  if ((PROBE_DUP & 4) && type == OP_ATT_MLA) prog_add1(P, type, i0, 1, i2, a, b, o);
  if ((PROBE_DUP & 8) && type == OP_ATT_NA) prog_add1(P, type, i0, 1, i2, a, b, o);
  if ((PROBE_DUP & 16) && type == OP_NORM) prog_add1(P, type, i0, i1, i2, a, b, o);
  if ((PROBE_DUP & 32) && type == OP_GEMM_RES && i0 == 0) prog_add1(P, type, i0, i1, i2, a, b, o);
  if ((PROBE_DUP & 128) && type == OP_GQA_POST) prog_add1(P, type, i0, 1, i2, a, b, o);
  if ((PROBE_DUP & 256) && (type == OP_MLA_POST1 || type == OP_FINAL)) prog_add1(P, type, i0, 1, i2, a, b, o);
  if ((PROBE_DUP & 64) && type == OP_PRE) prog_add1(P, type, i0, i1, i2, a, b, o);
  prog_add1(P, type, i0, i1, i2, a, b, o);
}
constexpr Prog make_prog() {
  Prog P{}; P.n = 0;
  const size_t W = OFF_W, hb = OFF_HB, pj = OFF_PJ, qm = OFF_QM;
  prog_add(P, OP_PRE, 0, 0, 0, 0, 0, 0);
  prog_add(P, OP_MODFIN, 0, 0, 0, 0, 0, 0);
  for (int i = 0; i < DEPTH; ++i) {
    const int kind = i % 3, j = i / 3, need_ctx = i < DEPTH - 1;
    prog_add(P, OP_NORM, i, 0, 0, 0, 0, 0);
    if (kind == 0) {
      prog_add(P, OP_GEMM_BF, 2560, 1024, 1024, hb, W + 2 * (W_GA_IN + (size_t)j * 2560 * 1024), pj);
      prog_add(P, OP_GQA_POST, j, 0, 0, 0, 0, 0);
      prog_add(P, OP_ATT_GQA, need_ctx, 0, j, 0, 0, 0);
      prog_add(P, OP_GEMM_RES, i, 0, 2560, pj + 2 * 1536, W + 2 * (W_GA_OUT + (size_t)j * 1024 * 1024), 0);
    } else if (kind == 1) {
      prog_add(P, OP_GEMM_BF, 4096, 1024, 1024, hb, W + 2 * W_NA_IN, pj);
      prog_add(P, OP_ATT_NA, need_ctx, 0, 0, 0, 0, 0);
      prog_add(P, OP_GEMM_RES, i, 0, 4096, pj + 2 * 3072, W + 2 * W_NA_OUT, 0);
    } else {
      prog_add(P, OP_GEMM_BF, 2048, 1024, 1024, hb, W + 2 * W_ML_IN, pj);
      prog_add(P, OP_MLA_POST1, 0, 0, 0, 0, 0, 0);
      prog_add(P, OP_GEMM_BF_NOSYNC, 1536, 512, 2048, pj, W + 2 * W_ML_UQ, qm);
      prog_add(P, OP_GEMM_BF, 2048, 256, 2048, pj + 2 * 512, W + 2 * W_ML_UKV, pj + (size_t)T * 2048 * 2);
      prog_add(P, OP_ATT_MLA, need_ctx, 0, 0, 0, 0, 0);
      prog_add(P, OP_GEMM_RES, i, 0, 2048, pj + 2 * 832, W + 2 * W_ML_OUT, 0);
    }
  }
  prog_add(P, OP_FINAL, 0, 0, 0, 0, 0, 0);
  return P;
}
__device__ const Prog PROG = make_prog();

struct WDesc { int in_idx; int K, N, Npad, tile0; unsigned src_off, dst_off; int pad_; };
constexpr int NWD = 10;
struct WTab { WDesc d[NWD]; int ntiles; };
constexpr WTab make_wtab() {
  WTab t{}; int nt = 0, wi = 0;
  auto addw = [&](int in_idx, size_t src_off, size_t dst, int K, int N, int Npad) { WDesc& w = t.d[wi++]; w.in_idx = in_idx; w.src_off = (unsigned)src_off; w.dst_off = (unsigned)dst; w.K = K; w.N = N; w.Npad = Npad; w.tile0 = nt; w.pad_ = 0; nt += (K / 64) * (Npad / 64); };
  addw(IN_GA_WIN, 0, W_GA_IN, 1024, 2560, 2560); addw(IN_GA_WIN, 1024ull * 2560, W_GA_IN + 2560ull * 1024, 1024, 2560, 2560);
  addw(IN_GA_WOUT, 0, W_GA_OUT, 1024, 1024, 1024); addw(IN_GA_WOUT, 1024ull * 1024, W_GA_OUT + 1024ull * 1024, 1024, 1024, 1024);
  addw(IN_NA_WIN, 0, W_NA_IN, 1024, 4096, 4096); addw(IN_NA_WOUT, 0, W_NA_OUT, 1024, 1024, 1024);
  addw(IN_ML_WIN, 0, W_ML_IN, 1024, 1856, 2048); addw(IN_ML_WUQ, 0, W_ML_UQ, 512, 1536, 1536); addw(IN_ML_WUKV, 0, W_ML_UKV, 256, 2048, 2048); addw(IN_ML_WOUT, 0, W_ML_OUT, 1024, 1024, 1024);
  t.ntiles = nt; return t;
}
__device__ const WTab WTAB = make_wtab();

__device__ const float INV_A[32] = {1.000000000e+00f, 7.498942614e-01f, 5.623413324e-01f, 4.216965139e-01f, 3.162277639e-01f, 2.371373773e-01f, 1.778279394e-01f, 1.333521307e-01f, 1.000000015e-01f, 7.498941571e-02f, 5.623413250e-02f, 4.216965288e-02f, 3.162277490e-02f, 2.371373773e-02f, 1.778279431e-02f, 1.333521493e-02f, 9.999999776e-03f, 7.498941850e-03f, 5.623413250e-03f, 4.216964822e-03f, 3.162277630e-03f, 2.371373586e-03f, 1.778279431e-03f, 1.333521446e-03f, 1.000000047e-03f, 7.498942432e-04f, 5.623413017e-04f, 4.216965172e-04f, 3.162277571e-04f, 2.371373703e-04f, 1.778279402e-04f, 1.333521504e-04f};
__device__ const float INV_M[16] = {1.000000000e+00f, 5.623413324e-01f, 3.162277639e-01f, 1.778279394e-01f, 1.000000015e-01f, 5.623413250e-02f, 3.162277490e-02f, 1.778279431e-02f, 9.999999776e-03f, 5.623413250e-03f, 3.162277630e-03f, 1.778279431e-03f, 1.000000047e-03f, 5.623413017e-04f, 3.162277571e-04f, 1.778279402e-04f};

__device__ __forceinline__ float bf2f(short b) { return __uint_as_float(((unsigned)(unsigned short)b) << 16); }
__device__ __forceinline__ unsigned cvtpk(float lo, float hi) { unsigned r; asm volatile("v_cvt_pk_bf16_f32 %0, %1, %2" : "=v"(r) : "v"(lo), "v"(hi)); return r; }
__device__ __forceinline__ bf16x8 pack8(const float* v) { u32x4 w = {cvtpk(v[0], v[1]), cvtpk(v[2], v[3]), cvtpk(v[4], v[5]), cvtpk(v[6], v[7])}; return *reinterpret_cast<bf16x8*>(&w); }
__device__ __forceinline__ float silu_f(float g) { return g * __builtin_amdgcn_rcpf(1.f + __builtin_amdgcn_exp2f(-g * 1.4426950408889634f)); }
__device__ __forceinline__ float wave_sum(float v) {
#pragma unroll
  for (int o = 32; o >= 1; o >>= 1) v += __shfl_xor(v, o);
  return v;
}
__device__ __forceinline__ const float* res_src(KP p, int layer, int row) {
  const int b = row / TPB, j = row - b * TPB;
  if (j < CTX) return (layer == 0 ? p->in[IN_CTX] : (const float*)(p->ws + OFF_XSC)) + ((size_t)b * CTX + j) * DM;
  return (layer == 0 ? p->in[IN_X] : (const float*)p->out) + ((size_t)b * SEQ + (j - CTX)) * DM;
}

namespace pg8 {
constexpr int BM = 256, BK = 64, HALF = 128, HTB = HALF * BK * 2, STAGE_BYTES = 8 * HTB, NXCD = 8, WGM = 8;
__device__ __forceinline__ int lds_byte(int r, int c) { const int st = (r >> 4) * 2 + (c >> 5), rr = r & 15, cc = c & 31, ob = rr * 64 + cc * 2; return st * 1024 + (ob ^ (((ob >> 9) & 1) << 5)); }
__device__ __forceinline__ void stage_rc(int b, int& R, int& C) { const int st = b / 1024, sb = b % 1024, swz = sb ^ (((sb >> 9) & 1) << 5); R = (st >> 1) * 16 + swz / 64; C = (st & 1) * 32 + (swz % 64) / 2; }
__device__ __forceinline__ int perm32(int rho) { const int n = rho >> 4, i = rho & 15; return 8 * (i >> 2) + 4 * n + (i & 3); }
struct Unit { int pm, pn; };
struct Gemm { const bf16_t* A; const bf16_t* Bt; int M, N, K, lda; };
struct StaticOrder {
  int nM, nN, nwg, G, c, latonly;
  __device__ void init(int M, int N, int G_, int c_, int latonly_ = 0) { latonly = latonly_; nM = latonly ? 128 : M / BM; nN = N / BM; nwg = nM * nN; G = G_; c = c_; }
  __device__ bool next(int i, Unit& u) const {
    const long L = (long)i * G + c; if (L >= nwg) return false;
    int wgid = (int)L; { const int q = nwg / NXCD, r = nwg % NXCD, xcd = wgid % NXCD, off = wgid / NXCD; wgid = (xcd < r ? xcd * (q + 1) : r * (q + 1) + (xcd - r) * q) + off; }
    const int nig = WGM * nN, gid = wgid / nig, fm = gid * WGM, gsz = (nM - fm) < WGM ? (nM - fm) : WGM;
    u.pm = fm + ((wgid % nig) % gsz); u.pn = (wgid % nig) / gsz; if (latonly) u.pm += (u.pm >> 5) + 1; return true;
  }
};
struct EpiBf16 {
  static constexpr bool PERM = true;
  bf16_t* O; int ldc;
  __device__ __forceinline__ void operator()(const f32x4 (&acc)[2][2][4][2], const Unit& u, int wr, int wc, int fr, int fq) const {
    const int row0 = u.pm * BM + wr * 64 + fr, col0 = u.pn * BM + wc * 32 + 8 * fq;
#pragma unroll
    for (int ai = 0; ai < 2; ++ai)
#pragma unroll
      for (int m = 0; m < 4; ++m) { bf16_t* rowp = O + (size_t)(row0 + ai * HALF + m * 16) * ldc + col0;
#pragma unroll
        for (int bj = 0; bj < 2; ++bj) { const f32x4 v0 = acc[ai][bj][m][0], v1 = acc[ai][bj][m][1];
          u32x4 w; w.x = cvtpk(v0[0], v0[1]); w.y = cvtpk(v0[2], v0[3]); w.z = cvtpk(v1[0], v1[1]); w.w = cvtpk(v1[2], v1[3]);
          *(u32x4*)(rowp + bj * HALF) = w; } }
  }
};
struct EpiResid {
  static constexpr bool PERM = true;
  const float* res_lat; const float* res_ctx; float* out_lat; float* out_ctx; const float* mod;
  __device__ __forceinline__ void operator()(const f32x4 (&acc)[2][2][4][2], const Unit& u, int wr, int wc, int fr, int fq) const {
    const int b = u.pm / 33, lt = u.pm - b * 33;
    const float* rb; float* ob; const float* g;
    if (lt == 0) { rb = res_ctx + (size_t)b * CTX * DM; ob = out_ctx + (size_t)b * CTX * DM; g = mod + 4 * 3072 + 2048; }
    else { const size_t o = ((size_t)b * SEQ + (size_t)(lt - 1) * 256) * DM; rb = res_lat + o; ob = out_lat + o; g = mod + b * 3072 + 2048; }
    const int lr0 = wr * 64 + fr, col0 = u.pn * BM + wc * 32 + 8 * fq;
    f32x4 gv[2][2];
#pragma unroll
    for (int bj = 0; bj < 2; ++bj)
#pragma unroll
      for (int n = 0; n < 2; ++n) gv[bj][n] = *(const f32x4*)(g + col0 + bj * HALF + n * 4);
#pragma unroll
    for (int ai = 0; ai < 2; ++ai)
#pragma unroll
      for (int m = 0; m < 4; ++m) { const size_t ro = (size_t)(lr0 + ai * HALF + m * 16) * DM + col0;
#pragma unroll
        for (int bj = 0; bj < 2; ++bj)
#pragma unroll
          for (int n = 0; n < 2; ++n) { const f32x4 r = *(const f32x4*)(rb + ro + bj * HALF + n * 4);
            *(f32x4*)(ob + ro + bj * HALF + n * 4) = r + gv[bj][n] * acc[ai][bj][m][n]; } }
  }
};

template <class Epi>
__device__ __forceinline__ void gemm_phase(LAS unsigned char* lds, const Gemm g, const StaticOrder& S, const Epi& E, const int tid) {
  const int wid = __builtin_amdgcn_readfirstlane(tid >> 6), lane = tid & 63, wr = wid >> 2, wc = wid & 3, fr = lane & 15, fq = lane >> 4;
  const int K = g.K, nt = K / BK, lda = g.lda;
  unsigned voffA[2], voffB[2];
#pragma unroll
  for (int i = 0; i < 2; ++i) { int R, C; stage_rc(tid * 16 + i * 8192, R, C); const int Rb = Epi::PERM ? ((R & ~31) + perm32(R & 31)) : R;
    voffA[i] = (unsigned)(R * lda + C) * 2u; voffB[i] = (unsigned)(Rb * K + C) * 2u; }
  const size_t kstep = (size_t)(BK * 2);
  const size_t hstepA = (size_t)HALF * lda * 2, hstepB = (size_t)HALF * K * 2;
  const size_t tstepA = 2 * hstepA, tstepB = 2 * hstepB;
  const unsigned ldsw = (unsigned)wid * 1024u;
  const int aoff = lds_byte(wr * 64 + fr, fq * 8), boff = lds_byte(wc * 32 + fr, fq * 8);
#define PG8_SA(b, h) (((b) * 2 + (h)) * HTB)
#define PG8_SB(b, h) ((4 + (b) * 2 + (h)) * HTB)
#define PG8_STAGE(bufoff, gbase, voff) do { _Pragma("unroll") for (int _i = 0; _i < 2; ++_i) \
    __builtin_amdgcn_global_load_lds((const unsigned*)((const char*)(gbase) + (voff)[_i]), (LAS unsigned*)(lds + (bufoff) + ldsw + _i * 8192), 16, 0, 0); } while (0)
#define PG8_LDA(dst, b, h) do { _Pragma("unroll") for (int m = 0; m < 4; ++m) _Pragma("unroll") for (int k = 0; k < 2; ++k) dst[m][k] = *(const LAS bf16x8*)(lds + PG8_SA(b, h) + aoff + m * 2048 + k * 1024); } while (0)
#define PG8_LDB(dst, b, h) do { _Pragma("unroll") for (int n = 0; n < 2; ++n) _Pragma("unroll") for (int k = 0; k < 2; ++k) dst[n][k] = *(const LAS bf16x8*)(lds + PG8_SB(b, h) + boff + n * 2048 + k * 1024); } while (0)
#define PG8_MMA(ai, bj, At, Bt) do { __builtin_amdgcn_s_setprio(1); _Pragma("unroll") for (int m = 0; m < 4; ++m) _Pragma("unroll") for (int n = 0; n < 2; ++n) _Pragma("unroll") for (int k = 0; k < 2; ++k) \
    acc[ai][bj][m][n] = __builtin_amdgcn_mfma_f32_16x16x32_bf16(Bt[n][k], At[m][k], acc[ai][bj][m][n], 0, 0, 0); __builtin_amdgcn_s_setprio(0); } while (0)
#define PG8_WAIT_V(n) asm volatile("s_waitcnt vmcnt(" #n ")" ::: "memory")
#define PG8_WAIT_L(n) asm volatile("s_waitcnt lgkmcnt(" #n ")" ::: "memory")
#define PG8_BAR __builtin_amdgcn_s_barrier()
#define PG8_SCHED __builtin_amdgcn_sched_barrier(0)
  Unit cur, nxt; int ui = 0;
  if (!S.next(0, cur)) return;
  f32x4 acc[2][2][4][2];
#pragma unroll
  for (int a = 0; a < 2; ++a)
#pragma unroll
    for (int b = 0; b < 2; ++b)
#pragma unroll
      for (int m = 0; m < 4; ++m)
#pragma unroll
        for (int n = 0; n < 2; ++n) acc[a][b][m][n] = (f32x4){0.f, 0.f, 0.f, 0.f};
  bf16x8 At[4][2], B0[2][2], B1[2][2];
  const char* cA = (const char*)g.A + (size_t)cur.pm * tstepA; const char* cB = (const char*)g.Bt + (size_t)cur.pn * tstepB;
  PG8_STAGE(PG8_SB(0, 0), cB, voffB); PG8_STAGE(PG8_SA(0, 0), cA, voffA); PG8_STAGE(PG8_SB(0, 1), cB + hstepB, voffB); PG8_STAGE(PG8_SA(0, 1), cA + hstepA, voffA);
  if (wr == 1) PG8_BAR;
  PG8_WAIT_V(4); PG8_BAR;
  PG8_STAGE(PG8_SB(1, 0), cB + kstep, voffB); PG8_STAGE(PG8_SA(1, 0), cA + kstep, voffA); PG8_STAGE(PG8_SB(1, 1), cB + hstepB + kstep, voffB);
  PG8_WAIT_V(6); PG8_BAR;
  for (;;) {
    const bool has_next = S.next(ui + 1, nxt);
    const char* nA = has_next ? (const char*)g.A + (size_t)nxt.pm * tstepA : cA; const char* nB = has_next ? (const char*)g.Bt + (size_t)nxt.pn * tstepB : cB;
    for (int t = 0; t < nt; t += 2) {
      const bool last = (t == nt - 2);
      const char* a1 = cA + (size_t)(t + 1) * kstep;
      const char* a2 = last ? nA : cA + (size_t)(t + 2) * kstep; const char* b2 = last ? nB : cB + (size_t)(t + 2) * kstep;
      const char* a3 = a2 + kstep; const char* b3 = b2 + kstep;
      PG8_LDB(B0, 0, 0); PG8_SCHED; PG8_LDA(At, 0, 0); PG8_STAGE(PG8_SA(1, 1), a1 + hstepA, voffA);
      PG8_WAIT_L(8); PG8_BAR; PG8_WAIT_L(0); PG8_MMA(0, 0, At, B0); PG8_BAR; PG8_SCHED;
      PG8_LDB(B1, 0, 1); PG8_STAGE(PG8_SB(0, 0), b2, voffB);
      PG8_BAR; PG8_WAIT_L(0); PG8_MMA(0, 1, At, B1); PG8_BAR;
      PG8_LDA(At, 0, 1); PG8_STAGE(PG8_SA(0, 0), a2, voffA);
      PG8_BAR; PG8_WAIT_L(0); PG8_MMA(1, 0, At, B0); PG8_BAR; PG8_SCHED;
      PG8_STAGE(PG8_SB(0, 1), b2 + hstepB, voffB);
      PG8_WAIT_V(6); PG8_BAR; PG8_MMA(1, 1, At, B1); PG8_BAR;
      PG8_LDB(B0, 1, 0); PG8_SCHED; PG8_LDA(At, 1, 0); PG8_STAGE(PG8_SA(0, 1), a2 + hstepA, voffA);
      PG8_WAIT_L(8); PG8_BAR; PG8_WAIT_L(0); PG8_MMA(0, 0, At, B0); PG8_BAR; PG8_SCHED;
      PG8_LDB(B1, 1, 1); PG8_STAGE(PG8_SB(1, 0), b3, voffB);
      PG8_BAR; PG8_WAIT_L(0); PG8_MMA(0, 1, At, B1); PG8_BAR;
      PG8_LDA(At, 1, 1); PG8_STAGE(PG8_SA(1, 0), a3, voffA);
      PG8_BAR; PG8_WAIT_L(0); PG8_MMA(1, 0, At, B0); PG8_BAR; PG8_SCHED;
      PG8_STAGE(PG8_SB(1, 1), b3 + hstepB, voffB);
      PG8_WAIT_V(6); PG8_BAR; PG8_MMA(1, 1, At, B1); PG8_BAR;
    }
    E(acc, cur, wr, wc, fr, fq);
    if (!has_next) break;
#pragma unroll
    for (int a = 0; a < 2; ++a)
#pragma unroll
      for (int b = 0; b < 2; ++b)
#pragma unroll
        for (int m = 0; m < 4; ++m)
#pragma unroll
          for (int n = 0; n < 2; ++n) acc[a][b][m][n] = (f32x4){0.f, 0.f, 0.f, 0.f};
    cur = nxt; cA = nA; cB = nB; ++ui;
  }
  PG8_WAIT_V(0);
  if (wr == 0) PG8_BAR;
  PG8_BAR;
#undef PG8_SA
#undef PG8_SB
#undef PG8_STAGE
#undef PG8_LDA
#undef PG8_LDB
#undef PG8_MMA
#undef PG8_WAIT_V
#undef PG8_WAIT_L
#undef PG8_BAR
#undef PG8_SCHED
}
}

#define SBAR() __builtin_amdgcn_sched_barrier(0)
__device__ __forceinline__ int crow(int r, int hi) { return (r & 3) + 8 * (r >> 2) + 4 * hi; }
constexpr float THR = 8.f;
template <int DQK> struct ScaleOf;
template <> struct ScaleOf<64> { static constexpr float v = 0.125f; };
template <> struct ScaleOf<128> { static constexpr float v = 0.088388347648318440f; };
template <> struct ScaleOf<192> { static constexpr float v = 0.072168783648703220f; };

template <int DQK>
__device__ __forceinline__ void partialSM(f32x16& p0, f32x16& p1, float& m_reg, float& mn, float& alpha) {
  constexpr float SCALE = ScaleOf<DQK>::v, C = SCALE * 1.4426950408889634f;
  float pmax = p0[0];
#pragma unroll
  for (int r = 1; r < 16; ++r) pmax = fmaxf(pmax, p0[r]);
#pragma unroll
  for (int r = 0; r < 16; ++r) pmax = fmaxf(pmax, p1[r]);
  { auto rr = __builtin_amdgcn_permlane32_swap(__float_as_uint(pmax), __float_as_uint(pmax), false, false);
    pmax = fmaxf(__uint_as_float(rr[0]), __uint_as_float(rr[1])); }
  if (__builtin_expect(__all(pmax - m_reg <= THR / SCALE), 1)) { mn = m_reg; alpha = 1.f; }
  else { mn = fmaxf(m_reg, pmax); alpha = __builtin_amdgcn_exp2f((m_reg - mn) * C); m_reg = mn; }
  const float mnC = -mn * C;
#pragma unroll
  for (int r = 0; r < 16; ++r) p0[r] = fmaf(p0[r], C, mnC);
#pragma unroll
  for (int r = 0; r < 16; ++r) p1[r] = fmaf(p1[r], C, mnC);
#pragma unroll
  for (int r = 0; r < 16; ++r) p0[r] = __builtin_amdgcn_exp2f(p0[r]);
}
__device__ __forceinline__ void partialSM2(f32x16& p0, f32x16& p1, float& m_reg, float& alpha, f32x16& negm, const bool first) {
  constexpr float THR2 = THR * 1.4426950408889634f;
  float pmax = p0[0];
#pragma unroll
  for (int r = 1; r < 16; ++r) pmax = fmaxf(pmax, p0[r]);
#pragma unroll
  for (int r = 0; r < 16; ++r) pmax = fmaxf(pmax, p1[r]);
  { auto rr = __builtin_amdgcn_permlane32_swap(__float_as_uint(pmax), __float_as_uint(pmax), false, false);
    pmax = fmaxf(__uint_as_float(rr[0]), __uint_as_float(rr[1])); }
  if (__builtin_expect(!first && __all(pmax <= THR2), 1)) { alpha = 1.f; }
  else { const float d = first ? pmax : fmaxf(pmax, 0.f); alpha = first ? 1.f : __builtin_amdgcn_exp2f(-d); m_reg += d;
#pragma unroll
    for (int r = 0; r < 16; ++r) { p0[r] -= d; p1[r] -= d; }
    const float nm = -m_reg;
#pragma unroll
    for (int r = 0; r < 16; ++r) negm[r] = nm; }
#pragma unroll
  for (int r = 0; r < 16; ++r) p0[r] = __builtin_amdgcn_exp2f(p0[r]);
}
__device__ __forceinline__ void finishSM(f32x16& p0, f32x16& p1, float alpha, float& l_reg, bf16x8& pa0, bf16x8& pa1, bf16x8& pa2, bf16x8& pa3) {
#pragma unroll
  for (int r = 0; r < 16; ++r) p1[r] = __builtin_amdgcn_exp2f(p1[r]);
  float ps = 0;
#pragma unroll
  for (int r = 0; r < 16; ++r) ps += p0[r];
#pragma unroll
  for (int r = 0; r < 16; ++r) ps += p1[r];
  { auto rr = __builtin_amdgcn_permlane32_swap(__float_as_uint(ps), __float_as_uint(ps), false, false);
    ps = __uint_as_float(rr[0]) + __uint_as_float(rr[1]); }
  l_reg = l_reg * alpha + ps;
#define PK4(P, BASE, OUT) do { u32x4 w = {cvtpk(P[BASE + 0], P[BASE + 1]), cvtpk(P[BASE + 2], P[BASE + 3]), cvtpk(P[BASE + 4], P[BASE + 5]), cvtpk(P[BASE + 6], P[BASE + 7])}; \
    OUT = *reinterpret_cast<bf16x8*>(&w); } while (0)
  PK4(p0, 0, pa0); PK4(p0, 8, pa1); PK4(p1, 0, pa2); PK4(p1, 8, pa3);
#undef PK4
}
template <int DQK>
__device__ __forceinline__ void qkt(f32x16& p0, f32x16& p1, const char* Ks, const bf16x8* qr, int r32, int hi, const f32x16 init = f32x16{}) {
  constexpr int RB = DQK * 2;
  p0 = init; p1 = init;
#pragma unroll
  for (int d0 = 0; d0 < DQK / 16; ++d0) { const int cb = (d0 * 16 + hi * 8) * 2;
    const int sw = (DQK >= 128 && d0 < 8) ? ((r32 & 15) << 4) : ((r32 & 7) << 4);
    bf16x8 b0 = *reinterpret_cast<const bf16x8*>(Ks + r32 * RB + (cb ^ sw));
    bf16x8 b1 = *reinterpret_cast<const bf16x8*>(Ks + (32 + r32) * RB + (cb ^ sw));
    p0 = __builtin_amdgcn_mfma_f32_32x32x16_bf16(b0, qr[d0], p0, 0, 0, 0);
    p1 = __builtin_amdgcn_mfma_f32_32x32x16_bf16(b1, qr[d0], p1, 0, 0, 0); }
}
template <int NCB> __device__ __forceinline__ int v_st(int k, int c) { const int kk = k; return ((kk >> 3) * NCB + (c >> 5)) * 512 + ((kk & 7) * 32 + (c & 31)) * 2; }
__device__ __forceinline__ int v_rd_base(int lane) { return ((lane & 3) << 3) | (((lane >> 2) & 3) << 6) | (((lane >> 4) & 1) << 5) | (((lane >> 5) & 1) << 8); }
template <int OFF> __device__ __forceinline__ s16x4 tr_read(int vb) {
  s16x4 r; asm volatile("ds_read_b64_tr_b16 %0, %1 offset:%2" : "=&v"(r) : "v"(vb), "i"(OFF) : "memory"); return r;
}
template <int NCB, int D0> __device__ __forceinline__ void pv_one(f32x16& od, int vb, bf16x8 pa0, bf16x8 pa1, bf16x8 pa2, bf16x8 pa3) {
#define VOFF(ks, half) (D0 * 512 + (ks) * (NCB * 1024) + (half) * (NCB * 512))
  const s16x4 l0 = tr_read<VOFF(0, 0)>(vb), h0 = tr_read<VOFF(0, 1)>(vb), l1 = tr_read<VOFF(1, 0)>(vb), h1 = tr_read<VOFF(1, 1)>(vb);
  const s16x4 l2 = tr_read<VOFF(2, 0)>(vb), h2 = tr_read<VOFF(2, 1)>(vb), l3 = tr_read<VOFF(3, 0)>(vb), h3 = tr_read<VOFF(3, 1)>(vb);
#undef VOFF
  asm volatile("s_waitcnt lgkmcnt(0)" ::: "memory"); SBAR();
#define PK(L, H) (bf16x8){L[0], L[1], L[2], L[3], H[0], H[1], H[2], H[3]}
  od = __builtin_amdgcn_mfma_f32_32x32x16_bf16(pa0, PK(l0, h0), od, 0, 0, 0);
  od = __builtin_amdgcn_mfma_f32_32x32x16_bf16(pa1, PK(l1, h1), od, 0, 0, 0);
  od = __builtin_amdgcn_mfma_f32_32x32x16_bf16(pa2, PK(l2, h2), od, 0, 0, 0);
  od = __builtin_amdgcn_mfma_f32_32x32x16_bf16(pa3, PK(l3, h3), od, 0, 0, 0);
#undef PK
}
template <int NCB> __device__ __forceinline__ void pv_all(f32x16* o, int vb, bf16x8 pa0, bf16x8 pa1, bf16x8 pa2, bf16x8 pa3) {
  pv_one<NCB, 0>(o[0], vb, pa0, pa1, pa2, pa3); pv_one<NCB, 1>(o[1], vb, pa0, pa1, pa2, pa3);
  if constexpr (NCB == 4) { pv_one<NCB, 2>(o[2], vb, pa0, pa1, pa2, pa3); pv_one<NCB, 3>(o[3], vb, pa0, pa1, pa2, pa3); }
}

template <int DQK, int DV, int MODE, int QPOST, int NEGM, int ldq, int ldk, int ldo>
__device__ __forceinline__ void attn_body_seq(const bf16_t* __restrict__ Qb, const bf16_t* __restrict__ Kp, const bf16_t* __restrict__ K2p, const bf16_t* __restrict__ Vp,
                                              int krow_base, bf16_t* __restrict__ OG, int NT, int na_r0, char* lds, int tid, int dummy, const float* qgain, const float2* qtab, int q_t0) {
  constexpr int NQ = DQK / 16, NCB = DV / 32, SHM_K = 64 * DQK * 2, SHM_V = 64 * DV * 2, RB = DQK * 2;
  constexpr int NKC = DQK / 64, NVC = DV / 64;
  const int wid = tid >> 6, lane = tid & 63, r32 = lane & 31, hi = lane >> 5;
  char* V_lds = lds; char* K_lds = lds + 2 * SHM_V;
  float* wsl = (float*)(lds + 2 * SHM_V + 2 * SHM_K) + wid * 64; float* li_l = wsl; float* al_l = wsl + 32;
  const float* bias_l = (const float*)(lds + 2 * SHM_V + 2 * SHM_K + 8 * 64 * 4);
  float m_reg = -1e30f, l_reg = 0; f32x16 o[NCB]; bf16x8 qr[NQ];
#pragma unroll
  for (int d = 0; d < NCB; ++d) o[d] = f32x16{};
  const bf16_t* Qw = Qb + (size_t)(wid * 32 + r32) * ldq + hi * 8;
#pragma unroll
  for (int d0 = 0; d0 < NQ; ++d0) qr[d0] = *reinterpret_cast<const bf16x8*>(Qw + d0 * 16);
  if constexpr (QPOST == 1) {
    float xq[8][8]; float ss = 0;
#pragma unroll
    for (int d0 = 0; d0 < 8; ++d0)
#pragma unroll
      for (int j = 0; j < 8; ++j) { xq[d0][j] = bf2f(qr[d0][j]); ss += xq[d0][j] * xq[d0][j]; }
    { auto rr = __builtin_amdgcn_permlane32_swap(__float_as_uint(ss), __float_as_uint(ss), false, false); ss = __uint_as_float(rr[0]) + __uint_as_float(rr[1]); }
    const float rstd = rsqrtf(ss * (1.f / 128.f) + EPS) * (NEGM ? ScaleOf<DQK>::v * 1.4426950408889634f : 1.f);
#pragma unroll
    for (int d0 = 0; d0 < 8; ++d0) { const f32x4 g0 = *(const f32x4*)(qgain + d0 * 16 + hi * 8), g1 = *(const f32x4*)(qgain + d0 * 16 + hi * 8 + 4);
#pragma unroll
      for (int j = 0; j < 4; ++j) { xq[d0][j] *= rstd * g0[j]; xq[d0][4 + j] *= rstd * g1[j]; } }
    if (q_t0 >= 0) { const int t = q_t0 + wid * 32 + r32, prow = t >> 6, pcol = t & 63;
#pragma unroll
      for (int dd = 0; dd < 4; ++dd) { const int d0 = (dd & 1) + (dd >> 1) * 4, pos = (dd >> 1) ? pcol : prow; const float2* tp = qtab + pos * 32 + (d0 & 1) * 16 + hi * 8;
#pragma unroll
        for (int j = 0; j < 8; ++j) { const float2 cs = tp[j]; const float x0 = xq[d0][j], x1 = xq[d0 + 2][j]; xq[d0][j] = x0 * cs.x - x1 * cs.y; xq[d0 + 2][j] = x1 * cs.x + x0 * cs.y; } } }
#pragma unroll
    for (int d0 = 0; d0 < 8; ++d0) qr[d0] = pack8(xq[d0]);
  }
  if constexpr (DQK == 192) {
    if (q_t0 >= 0) { const int t = q_t0 + wid * 32 + r32, prow = t >> 6, pcol = t & 63;
#pragma unroll
      for (int ax = 0; ax < 2; ++ax) { const float2* tp = qtab + (ax ? pcol : prow) * 16 + hi * 8; float y0[8], y1[8];
#pragma unroll
        for (int j = 0; j < 8; ++j) { const float2 cs = tp[j]; const float x0 = bf2f(qr[8 + 2 * ax][j]), x1 = bf2f(qr[9 + 2 * ax][j]); y0[j] = x0 * cs.x - x1 * cs.y; y1[j] = x1 * cs.x + x0 * cs.y; }
        qr[8 + 2 * ax] = pack8(y0); qr[9 + 2 * ax] = pack8(y1); } }
  }
  if constexpr (NEGM == 1 && QPOST != 1) {
    constexpr float C = ScaleOf<DQK>::v * 1.4426950408889634f;
#pragma unroll
    for (int d0 = 0; d0 < NQ; ++d0) { float y[8];
#pragma unroll
      for (int j = 0; j < 8; ++j) y[j] = bf2f(qr[d0][j]) * C;
      qr[d0] = pack8(y); }
  }
  f32x16 negm = f32x16{};
  if constexpr (NEGM == 1) m_reg = 0.f;
  const int sr = tid >> 4, sc = (tid & 15) * 8, sr8 = tid >> 3, sc8 = (tid & 7) * 8;
  const int vb0 = (int)(uintptr_t)V_lds + v_rd_base(lane);
  auto tile_row = [&](int j) -> int {
    if constexpr (MODE == 0) return krow_base + j * 64;
    else { if (j < 4) return krow_base + j * 64; int kr = na_r0 - 8 + j; kr = kr < 0 ? 0 : (kr > 127 ? 127 : kr); return krow_base + CTX + kr * 64; }
  };
  auto na_mask = [&](f32x16& p0, f32x16& p1, int j) {
    if constexpr (MODE == 1) {
      if (j >= 4) {
        const int krraw = na_r0 - 8 + j, r = na_r0 + (wid >> 1);
        int rs = r - 4; rs = rs < 0 ? 0 : (rs > 120 ? 120 : rs);
        const float NINF = -__builtin_inff();
        if (krraw < rs || krraw >= rs + 8) {
#pragma unroll
          for (int q = 0; q < 16; ++q) { p0[q] = NINF; p1[q] = NINF; }
        } else {
          const float* brow = bias_l + (krraw - r + 7) * 32;
          const int c = (wid & 1) * 32 + r32; int cs = c - 8; cs = cs < 0 ? 0 : (cs > 48 ? 48 : cs);
#pragma unroll
          for (int q = 0; q < 16; ++q) {
            const int k0 = crow(q, hi), k1 = 32 + k0;
            int i0 = k0 - c + 15, i1 = k1 - c + 15; i0 = i0 < 0 ? 0 : (i0 > 30 ? 30 : i0); i1 = i1 < 0 ? 0 : (i1 > 30 ? 30 : i1);
            const float b0 = brow[i0], b1 = brow[i1];
            p0[q] = (k0 >= cs && k0 < cs + 16) ? p0[q] + b0 : NINF;
            p1[q] = (k1 >= cs && k1 < cs + 16) ? p1[q] + b1 : NINF;
          }
        }
      }
    }
  };
  bf16x8 sk[NKC], sv[NVC];
#define SLOAD(j) do { const size_t kr_ = (size_t)tile_row(j);                                                                      \
    if constexpr (DQK >= 128) { sk[0] = *reinterpret_cast<const bf16x8*>(Kp + (kr_ + sr) * ldk + sc); sk[1] = *reinterpret_cast<const bf16x8*>(Kp + (kr_ + 32 + sr) * ldk + sc); } \
    if constexpr (DQK == 192) sk[2] = *reinterpret_cast<const bf16x8*>(K2p + (kr_ + sr8) * ldk + sc8);                                       \
    if constexpr (DQK == 64) sk[0] = *reinterpret_cast<const bf16x8*>(Kp + (kr_ + sr8) * ldk + sc8);                                         \
    if constexpr (DV == 128) { sv[0] = *reinterpret_cast<const bf16x8*>(Vp + (kr_ + sr) * ldk + sc); sv[1] = *reinterpret_cast<const bf16x8*>(Vp + (kr_ + 32 + sr) * ldk + sc); } \
    else sv[0] = *reinterpret_cast<const bf16x8*>(Vp + (kr_ + sr8) * ldk + sc8); } while (0)
#define KSW(row, colB) ((row) * RB + ((colB) ^ ((((DQK >= 128) && ((colB) < 256)) ? ((row) & 15) : ((row) & 7)) << 4)))
#define SWRITE(b) do {                                                                                                                          \
    if constexpr (DV == 128) { *(bf16x8*)(V_lds + (b) * SHM_V + v_st<NCB>(sr, sc)) = sv[0]; *(bf16x8*)(V_lds + (b) * SHM_V + v_st<NCB>(32 + sr, sc)) = sv[1]; } \
    else *(bf16x8*)(V_lds + (b) * SHM_V + v_st<NCB>(sr8, sc8)) = sv[0];                                                                        \
    if constexpr (DQK >= 128) { *(bf16x8*)(K_lds + (b) * SHM_K + KSW(sr, sc * 2)) = sk[0]; *(bf16x8*)(K_lds + (b) * SHM_K + KSW(32 + sr, sc * 2)) = sk[1]; } \
    if constexpr (DQK == 192) *(bf16x8*)(K_lds + (b) * SHM_K + KSW(sr8, 256 + sc8 * 2)) = sk[2];                                              \
    if constexpr (DQK == 64) *(bf16x8*)(K_lds + (b) * SHM_K + KSW(sr8, sc8 * 2)) = sk[0]; } while (0)
  SLOAD(0); asm volatile("s_waitcnt vmcnt(0)" ::: "memory"); SWRITE(0); __syncthreads();
  for (int j = 0; j < NT; ++j) {
    const int bsel = j & 1;
    if (j + 1 < NT) SLOAD(j + 1);
    SBAR();
    bool skip = false;
    if constexpr (MODE == 1) { if (j >= 4) { const int krraw = na_r0 - 8 + j, r = na_r0 + (wid >> 1); int rs = r - 4; rs = rs < 0 ? 0 : (rs > 120 ? 120 : rs); skip = (krraw < rs) || (krraw >= rs + 8); } }
    if (!skip) {
    f32x16 p0, p1; float mn, al; bf16x8 pa0, pa1, pa2, pa3;
    if constexpr (NEGM == 1) { qkt<DQK>(p0, p1, K_lds + bsel * SHM_K, qr, r32, hi, negm); na_mask(p0, p1, j); partialSM2(p0, p1, m_reg, al, negm, j == 0); }
    else { qkt<DQK>(p0, p1, K_lds + bsel * SHM_K, qr, r32, hi); na_mask(p0, p1, j); partialSM<DQK>(p0, p1, m_reg, mn, al); }
    finishSM(p0, p1, al, l_reg, pa0, pa1, pa2, pa3);
    if (__any(al < 1.f)) { if (hi == 0) al_l[r32] = al; asm volatile("s_waitcnt lgkmcnt(0)" ::: "memory");
#pragma unroll
      for (int d = 0; d < NCB; ++d)
#pragma unroll
        for (int r = 0; r < 16; ++r) o[d][r] *= al_l[crow(r, hi)]; }
    SBAR();
    pv_all<NCB>(o, vb0 + bsel * SHM_V, pa0, pa1, pa2, pa3);
    }
    if (j + 1 < NT) SWRITE(bsel ^ 1);
    __syncthreads();
  }
  if (dummy) { if (l_reg == 123.456f) OG[tid] = (bf16_t)(cvtpk(o[0][0], o[1][3]) & 0xffffu); return; }
  if (hi == 0) li_l[r32] = l_reg; asm volatile("s_waitcnt lgkmcnt(0)" ::: "memory");
  float rli[16];
#pragma unroll
  for (int r = 0; r < 16; ++r) rli[r] = __builtin_amdgcn_rcpf(li_l[crow(r, hi)]);
  bf16_t* Ow = OG + (size_t)(wid * 32) * ldo;
#pragma unroll
  for (int r = 0; r < 16; ++r) { const int orow = crow(r, hi);
#pragma unroll
    for (int d0 = 0; d0 < NCB; ++d0) { bf16_t* pp = Ow + (size_t)orow * ldo + d0 * 32 + r32;
      const float g = bf2f((short)*pp); const float v = o[d0][r] * rli[r] * silu_f(g);
      *pp = (bf16_t)(cvtpk(v, v) & 0xffffu); } }
#undef SLOAD
#undef SWRITE
#undef KSW
}

__device__ __forceinline__ void phase_pre(KP p, char* lds, const int tid) {
  float* tl = (float*)lds;
  for (int tt = blockIdx.x; tt < WTAB.ntiles; tt += gridDim.x) {
    int di = 0;
    for (int i = 1; i < NWD; ++i) if (tt >= WTAB.d[i].tile0) di = i;
    const WDesc wd = WTAB.d[di];
    const float* src = p->in[wd.in_idx] + wd.src_off; bf16_t* dst = (bf16_t*)(p->ws + OFF_W) + wd.dst_off; const int K = wd.K, N = wd.N, local = tt - wd.tile0;
    const int nkt = K >> 6, kt = local % nkt, ntile = local / nkt;
    const int kk = tid >> 3, n8 = (tid & 7) * 8;
    f32x4 a = {0.f, 0.f, 0.f, 0.f}, b = a;
    if (ntile * 64 < N) { const float* sp = src + (size_t)(kt * 64 + kk) * N + ntile * 64 + n8; a = *(const f32x4*)sp; b = *(const f32x4*)(sp + 4); }
    __syncthreads();
#pragma unroll
    for (int i = 0; i < 4; ++i) { tl[(n8 + i) * 65 + kk] = a[i]; tl[(n8 + 4 + i) * 65 + kk] = b[i]; }
    __syncthreads();
    const int n = tid >> 3, k8 = (tid & 7) * 8; float v[8];
#pragma unroll
    for (int i = 0; i < 8; ++i) v[i] = tl[n * 65 + k8 + i];
    *(bf16x8*)(dst + (size_t)(ntile * 64 + n) * K + kt * 64 + k8) = pack8(v);
  }
  float* part = (float*)(p->ws + OFF_MODP);
  for (int it = blockIdx.x; it < 4 * 16 * 6; it += gridDim.x) {
    const int nb = it % 6, kc = (it / 6) & 15, layer = it / 96;
    __syncthreads();
    if (tid < 320) { const int s = tid >> 6, kk = tid & 63; const float cv = s < 4 ? p->in[IN_C][s * DM + kc * 64 + kk] : p->in[IN_CCTX][kc * 64 + kk]; tl[tid] = silu_f(cv); }
    __syncthreads();
    const int n = nb * 512 + tid; const float* wp = p->in[IN_MODW] + ((size_t)layer * DM + kc * 64) * 3072 + n;
    float a0 = 0, a1 = 0, a2 = 0, a3 = 0, a4 = 0;
#pragma unroll 8
    for (int kk = 0; kk < 64; ++kk) { const float w = wp[(size_t)kk * 3072]; a0 += tl[kk] * w; a1 += tl[64 + kk] * w; a2 += tl[128 + kk] * w; a3 += tl[192 + kk] * w; a4 += tl[256 + kk] * w; }
    float* pp = part + ((size_t)(kc * 4 + layer) * 5) * 3072 + n;
    pp[0] = a0; pp[3072] = a1; pp[2 * 3072] = a2; pp[3 * 3072] = a3; pp[4 * 3072] = a4;
  }
  for (int i = blockIdx.x * NTHREADS + tid; i < 128 * 48; i += gridDim.x * NTHREADS) {
    int pos, f; float inv; float2* dstp;
    if (i < 128 * 32) { pos = i >> 5; f = i & 31; inv = INV_A[f]; dstp = (float2*)(p->ws + OFF_TABA) + i; }
    else { const int q = i - 128 * 32; pos = q >> 4; f = q & 15; inv = INV_M[f]; dstp = (float2*)(p->ws + OFF_TABM) + q; }
    const float angf = (float)pos * inv;
    const double ang = (double)angf, k = __builtin_rint(ang * 0.15915494309189535), r = ang - k * 6.283185307179586476925287, r2 = r * r;
    double sn = r, cs = 1.0, ts = r, tc = 1.0;
#pragma unroll 1
    for (int q = 1; q <= 14; ++q) { tc = -tc * r2 / (double)((2 * q - 1) * (2 * q)); cs += tc; ts = -ts * r2 / (double)((2 * q) * (2 * q + 1)); sn += ts; }
    *dstp = make_float2((float)cs, (float)sn);
  }
}
__device__ __forceinline__ void phase_modfin(KP p, const int tid) {
  const float* part = (const float*)(p->ws + OFF_MODP); float* mod = (float*)(p->ws + OFF_MOD);
  for (int i = blockIdx.x * NTHREADS + tid; i < 4 * 5 * 3072; i += gridDim.x * NTHREADS) {
    const int n = i % 3072, layer = i / (5 * 3072);
    float a = p->in[IN_MODB][layer * 3072 + n];
#pragma unroll
    for (int kc = 0; kc < 16; ++kc) a += part[(size_t)kc * (4 * 5 * 3072) + i];
    mod[i] = a;
  }
}
__device__ __forceinline__ void phase_norm(KP p, int layer, const int tid) {
  const int lane = tid & 63, gw = blockIdx.x * 8 + (tid >> 6), nw = gridDim.x * 8;
  const float* mod = (const float*)(p->ws + OFF_MOD) + (size_t)layer * 5 * 3072; const float* g = p->in[IN_NORMG] + layer * DM; bf16_t* hb = (bf16_t*)(p->ws + OFF_HB);
  for (int row0 = gw * 4; row0 < T; row0 += nw * 4) {
    f32x4 v[4][4];
#pragma unroll
    for (int r = 0; r < 4; ++r) { const float* xr = res_src(p, layer, row0 + r);
#pragma unroll
      for (int i = 0; i < 4; ++i) v[r][i] = *(const f32x4*)(xr + i * 256 + lane * 4); }
    const int b = row0 / TPB, j = row0 - b * TPB; const float* m = mod + (j < CTX ? 4 : b) * 3072;
    f32x4 gm[4], sh[4];
#pragma unroll
    for (int i = 0; i < 4; ++i) { const int col = i * 256 + lane * 4; const f32x4 gg = *(const f32x4*)(g + col), scl = *(const f32x4*)(m + 1024 + col); sh[i] = *(const f32x4*)(m + col); gm[i] = gg * (1.f + scl); }
#pragma unroll
    for (int r = 0; r < 4; ++r) {
      float ss = 0;
#pragma unroll
      for (int i = 0; i < 4; ++i) ss += v[r][i][0] * v[r][i][0] + v[r][i][1] * v[r][i][1] + v[r][i][2] * v[r][i][2] + v[r][i][3] * v[r][i][3];
      ss = wave_sum(ss); const float rstd = rsqrtf(ss * (1.f / DM) + EPS);
#pragma unroll
      for (int i = 0; i < 4; ++i) { const int col = i * 256 + lane * 4; const f32x4 y = v[r][i] * rstd * gm[i] + sh[i];
        u32x2 w = {cvtpk(y[0], y[1]), cvtpk(y[2], y[3])}; *(u32x2*)(hb + (size_t)(row0 + r) * DM + col) = w; }
    }
  }
}
__device__ __forceinline__ void phase_final(KP p, int dummy, const int tid) {
  const int lane = tid & 63, gw = blockIdx.x * 8 + (tid >> 6), nw = gridDim.x * 8;
  const float* outp = p->out; float* dstp = dummy ? (float*)(p->ws + OFF_PJ) : p->out; const float* fg = p->in[IN_FINALG];
  f32x4 gg[4];
#pragma unroll
  for (int i = 0; i < 4; ++i) gg[i] = *(const f32x4*)(fg + i * 256 + lane * 4);
  for (int row0 = gw * 4; row0 < NB * SEQ; row0 += nw * 4) {
    f32x4 v[4][4];
#pragma unroll
    for (int r = 0; r < 4; ++r)
#pragma unroll
      for (int i = 0; i < 4; ++i) v[r][i] = *(const f32x4*)(outp + (size_t)(row0 + r) * DM + i * 256 + lane * 4);
#pragma unroll
    for (int r = 0; r < 4; ++r) {
      float ss = 0;
#pragma unroll
      for (int i = 0; i < 4; ++i) ss += v[r][i][0] * v[r][i][0] + v[r][i][1] * v[r][i][1] + v[r][i][2] * v[r][i][2] + v[r][i][3] * v[r][i][3];
      ss = wave_sum(ss); const float rstd = rsqrtf(ss * (1.f / DM) + EPS);
#pragma unroll
      for (int i = 0; i < 4; ++i) *(f32x4*)(dstp + (size_t)(row0 + r) * DM + i * 256 + lane * 4) = v[r][i] * rstd * gg[i];
    }
  }
}
__device__ __forceinline__ void phase_gqa_post(KP p, int j, int dummy, const int tid) {
  const int lane = tid & 63, gw = blockIdx.x * 8 + (tid >> 6), nw = gridDim.x * 8, g4 = lane >> 4, i = lane & 15;
  bf16_t* pj = (bf16_t*)(p->ws + (dummy ? OFF_QM : OFF_PJ)); const int ldp = dummy ? 1280 : 2560; const float2* tab = (const float2*)(p->ws + OFF_TABA);
  const float* kg = p->in[IN_GA_KG] + j * 128 + i * 8;
  float gk[8];
#pragma unroll
  for (int e = 0; e < 8; ++e) gk[e] = kg[e];
  const int axis = i >> 3, half = (i >> 2) & 1;
  for (int wi0 = gw * 4; wi0 < T * 2 / 4; wi0 += nw * 4) {
    bf16x8 raw[4]; bf16_t* ptr[4]; int rw[4];
#pragma unroll
    for (int u = 0; u < 4; ++u) { const int hv = (wi0 + u) * 4 + g4; rw[u] = hv >> 1; ptr[u] = pj + (size_t)rw[u] * ldp + 1024 + (hv & 1) * 128 + i * 8; raw[u] = *(const bf16x8*)ptr[u]; }
#pragma unroll
    for (int u = 0; u < 4; ++u) {
      float x[8]; float ss = 0;
#pragma unroll
      for (int e = 0; e < 8; ++e) { x[e] = bf2f(raw[u][e]); ss += x[e] * x[e]; }
      ss += __shfl_xor(ss, 1); ss += __shfl_xor(ss, 2); ss += __shfl_xor(ss, 4); ss += __shfl_xor(ss, 8);
      const float rstd = rsqrtf(ss * (1.f / 128.f) + EPS);
#pragma unroll
      for (int e = 0; e < 8; ++e) x[e] = x[e] * rstd * gk[e];
      const int b = rw[u] / TPB, jj = rw[u] - b * TPB; const bool lat = jj >= CTX; const int t = jj - CTX;
      const int pos = lat ? (axis ? (t & 63) : (t >> 6)) : 0;
      float y[8];
#pragma unroll
      for (int e = 0; e < 8; ++e) { const float xp = __shfl_xor(x[e], 4); const float2 cs = tab[pos * 32 + (i & 3) * 8 + e];
        y[e] = lat ? (half ? x[e] * cs.x + xp * cs.y : x[e] * cs.x - xp * cs.y) : x[e]; }
      *(bf16x8*)ptr[u] = pack8(y);
    }
  }
}
__device__ __forceinline__ void phase_mla_post1(KP p, int dummy, const int tid) {
  const int lane = tid & 63, gw = blockIdx.x * 8 + (tid >> 6), nw = gridDim.x * 8;
  bf16_t* pj = (bf16_t*)(p->ws + (dummy ? OFF_HB : OFF_PJ)); const int ldp = dummy ? 1024 : 2048; const float2* tab = (const float2*)(p->ws + OFF_TABM); const float* qgp = p->in[IN_ML_QG]; const float* kvgp = p->in[IN_ML_KVG];
  const int l2 = lane & 31, l3 = lane & 7;
  float gq[8], gkv[8];
#pragma unroll
  for (int e = 0; e < 8; ++e) { gq[e] = qgp[lane * 8 + e]; gkv[e] = kvgp[l2 * 8 + e]; }
  for (int row0 = gw * 2; row0 < T; row0 += nw * 2) {
    bf16x8 rq[2], rkv[2], rr[2];
#pragma unroll
    for (int u = 0; u < 2; ++u) { bf16_t* pr = pj + (size_t)(row0 + u) * ldp; rq[u] = *(const bf16x8*)(pr + lane * 8); rkv[u] = *(const bf16x8*)(pr + 512 + l2 * 8); rr[u] = *(const bf16x8*)(pr + 768 + l3 * 8); }
#pragma unroll
    for (int u = 0; u < 2; ++u) {
      const int row = row0 + u; bf16_t* pr = pj + (size_t)row * ldp;
      { float x[8]; float ss = 0;
#pragma unroll
        for (int e = 0; e < 8; ++e) { x[e] = bf2f(rq[u][e]); ss += x[e] * x[e]; }
        ss = wave_sum(ss); const float rstd = rsqrtf(ss * (1.f / 512.f) + EPS);
#pragma unroll
        for (int e = 0; e < 8; ++e) x[e] = x[e] * rstd * gq[e];
        *(bf16x8*)(pr + lane * 8) = pack8(x); }
      { float x[8]; float ss = 0;
#pragma unroll
        for (int e = 0; e < 8; ++e) { x[e] = bf2f(rkv[u][e]); ss += x[e] * x[e]; }
        ss = wave_sum(ss) * 0.5f; const float rstd = rsqrtf(ss * (1.f / 256.f) + EPS);
#pragma unroll
        for (int e = 0; e < 8; ++e) x[e] = x[e] * rstd * gkv[e];
        if (lane < 32) *(bf16x8*)(pr + 512 + l2 * 8) = pack8(x); }
      { const int b = row / TPB, jj = row - b * TPB; const bool lat = jj >= CTX; const int t = jj - CTX;
        const int axis = l3 >> 2, half = (l3 >> 1) & 1, pos = lat ? (axis ? (t & 63) : (t >> 6)) : 0; float y[8];
#pragma unroll
        for (int e = 0; e < 8; ++e) { const float x = bf2f(rr[u][e]); const float xp = __shfl_xor(x, 2); const float2 cs = tab[pos * 16 + (l3 & 1) * 8 + e];
          y[e] = half ? x * cs.x + xp * cs.y : x * cs.x - xp * cs.y; }
        if (lat && lane < 8) *(bf16x8*)(pr + 768 + l3 * 8) = pack8(y); }
    }
  }
}
__device__ __forceinline__ void phase_mla_post2(KP p, const int tid) {
  const int lane = tid & 63, gw = blockIdx.x * 8 + (tid >> 6), nw = gridDim.x * 8, h = lane >> 3, i = lane & 7;
  bf16_t* qm = (bf16_t*)(p->ws + OFF_QM); const float2* tab = (const float2*)(p->ws + OFF_TABM);
  const int axis = i >> 2, half = (i >> 1) & 1;
  for (int lr0 = gw * 4; lr0 < NB * SEQ; lr0 += nw * 4) {
    bf16x8 raw[4]; bf16_t* ptr[4];
#pragma unroll
    for (int u = 0; u < 4; ++u) { const int lr = lr0 + u, b = lr >> 13, t = lr & 8191; ptr[u] = qm + ((size_t)b * TPB + CTX + t) * 1536 + h * 192 + 128 + i * 8; raw[u] = *(const bf16x8*)ptr[u]; }
#pragma unroll
    for (int u = 0; u < 4; ++u) { const int t = (lr0 + u) & 8191, pos = axis ? (t & 63) : (t >> 6); float y[8];
#pragma unroll
      for (int e = 0; e < 8; ++e) { const float x = bf2f(raw[u][e]); const float xp = __shfl_xor(x, 2); const float2 cs = tab[pos * 16 + (i & 1) * 8 + e];
        y[e] = half ? x * cs.x + xp * cs.y : x * cs.x - xp * cs.y; }
      *(bf16x8*)ptr[u] = pack8(y); }
  }
}
__device__ __forceinline__ void phase_att_gqa(KP p, int need_ctx, int dummy, int jl, char* lds, const int tid) {
  bf16_t* pj = (bf16_t*)(p->ws + OFF_PJ); const float* qgain = p->in[IN_GA_QG] + jl * 128;
  const int nit = 1024 + (need_ctx ? 32 : 0);
  for (int it = blockIdx.x; it < nit; it += gridDim.x) {
    int b, h, row0, nt, qt0;
    if (it < 1024) { b = it >> 8; h = (it >> 5) & 7; row0 = b * TPB + CTX + (it & 31) * 256; nt = TPB / 64; qt0 = (it & 31) * 256; }
    else { const int q = it - 1024; b = q >> 3; h = q & 7; row0 = b * TPB; nt = CTX / 64; qt0 = -1; }
    __syncthreads();
    attn_body_seq<128, 128, 0, 1, 1, 2560, 2560, 2560>(pj + (size_t)row0 * 2560 + h * 128, pj + 1024 + (h >> 2) * 128, nullptr, pj + 1280 + (h >> 2) * 128, b * TPB,
                           pj + (size_t)row0 * 2560 + 1536 + h * 128, nt, 0, lds, tid, dummy, qgain, (const float2*)(p->ws + OFF_TABA), qt0);
  }
}
__device__ __forceinline__ void phase_att_mla(KP p, int need_ctx, int dummy, char* lds, const int tid) {
  bf16_t* pj = (bf16_t*)(p->ws + OFF_PJ); bf16_t* kvm = pj + (size_t)T * 2048; bf16_t* qm = (bf16_t*)(p->ws + OFF_QM);
  const int nit = 1024 + (need_ctx ? 32 : 0);
  for (int it = blockIdx.x; it < nit; it += gridDim.x) {
    int b, h, row0, nt, qt0;
    if (it < 1024) { b = it >> 8; h = (it >> 5) & 7; row0 = b * TPB + CTX + (it & 31) * 256; nt = TPB / 64; qt0 = (it & 31) * 256; }
    else { const int q = it - 1024; b = q >> 3; h = q & 7; row0 = b * TPB; nt = CTX / 64; qt0 = -1; }
    __syncthreads();
    attn_body_seq<192, 128, 0, 0, 0, 1536, 2048, 2048>(qm + (size_t)row0 * 1536 + h * 192, kvm + h * 256, pj + 768, kvm + h * 256 + 128, b * TPB,
                            pj + (size_t)row0 * 2048 + 832 + h * 128, nt, 0, lds, tid, dummy, nullptr, (const float2*)(p->ws + OFF_TABM), qt0);
  }
}
__device__ __forceinline__ void phase_att_na(KP p, int need_ctx, int dummy, char* lds, const int tid) {
  bf16_t* pj = (bf16_t*)(p->ws + OFF_PJ);
  float* bias_l = (float*)(lds + 2 * 8192 + 2 * 8192 + 8 * 64 * 4);
  const int nit = 2048 + (need_ctx ? 64 : 0);
  for (int it = blockIdx.x; it < nit; it += gridDim.x) {
    __syncthreads();
    int ntl = it < 2048 ? 16 : 4; asm volatile("" : "+s"(ntl));
    if (it < 2048) {
      const int b = it >> 9, h = (it >> 5) & 15, r0 = (it & 31) * 4, row0 = b * TPB + CTX + r0 * 64;
      if (tid < 15 * 32) { const int ro = tid >> 5, co = tid & 31; bias_l[tid] = co < 31 ? p->in[IN_NA_RPB][(h * 15 + ro) * 31 + co] * 1.4426950408889634f : 0.f; }
      attn_body_seq<64, 64, 1, 0, 1, 4096, 4096, 4096>(pj + (size_t)row0 * 4096 + h * 64, pj + 1024 + h * 64, nullptr, pj + 2048 + h * 64, b * TPB,
                           pj + (size_t)row0 * 4096 + 3072 + h * 64, ntl, r0, lds, tid, dummy, nullptr, nullptr, -1);
    } else {
      const int q = it - 2048, b = q >> 4, h = q & 15, row0 = b * TPB;
      attn_body_seq<64, 64, 0, 0, 1, 4096, 4096, 4096>(pj + (size_t)row0 * 4096 + h * 64, pj + 1024 + h * 64, nullptr, pj + 2048 + h * 64, b * TPB,
                           pj + (size_t)row0 * 4096 + 3072 + h * 64, ntl, 0, lds, tid, dummy, nullptr, nullptr, -1);
    }
  }
}

#define XB_TMO      128
#define XB_XCNT(j)  (256  + 64 * (j))
#define XB_XSUB(j)  (1280 + 64 * (j))
#define XB_XGEN(j)  (2304 + 64 * (j))
#define XB_TOP      3328
#define XB_TOPGEN   3392
#define XCD_BAR_WORDS 3456
#define XB_SPIN_CAP (1u << 22)
__device__ __forceinline__ unsigned xb_ld(unsigned* p)              { return __hip_atomic_load(p, __ATOMIC_RELAXED, __HIP_MEMORY_SCOPE_AGENT); }
__device__ __forceinline__ unsigned xb_add(unsigned* p, unsigned v) { return __hip_atomic_fetch_add(p, v, __ATOMIC_RELAXED, __HIP_MEMORY_SCOPE_AGENT); }
__device__ __forceinline__ unsigned xb_xcc_id() { return (unsigned)__builtin_amdgcn_s_getreg((3 << 11) | 20) & 0xFu; }
#define XB_SPIN(cond, bar) do { unsigned _sp = 0; while (cond) { __builtin_amdgcn_s_sleep(1); \
    if ((++_sp & 255u) == 0u) { if (xb_ld(&(bar)[XB_TMO])) break; if (_sp > XB_SPIN_CAP) { atomicAdd(&(bar)[XB_TMO], 1u); break; } } } } while (0)
struct XcdBarrier { unsigned* bar; unsigned x; volatile LAS unsigned* st; };
__device__ __forceinline__ XcdBarrier xcd_barrier_post(unsigned* bar, volatile LAS unsigned* st) {
    XcdBarrier b; b.bar = bar; b.x = xb_xcc_id(); b.st = st;
    if (threadIdx.x == 0) (void)xb_add(&bar[XB_XCNT(b.x)], 1u);
    return b;
}
__device__ __forceinline__ void xcd_barrier_complete(unsigned* bar, unsigned x, unsigned& nloc, unsigned& nx) {
    const unsigned G = gridDim.x * gridDim.y * gridDim.z;
    unsigned sum, cnt, mine, sp = 0u;
    for (;;) {
        sum = 0u; cnt = 0u; mine = 0u;
#pragma unroll
        for (unsigned j = 0; j < 16; ++j) { const unsigned c = xb_ld(&bar[XB_XCNT(j)]); sum += c; cnt += (c > 0u) ? 1u : 0u; mine = (j == x) ? c : mine; }
        if (sum == G) break;
        __builtin_amdgcn_s_sleep(1);
        if ((++sp & 255u) == 0u) { if (xb_ld(&bar[XB_TMO])) break; if (sp > XB_SPIN_CAP) { atomicAdd(&bar[XB_TMO], 1u); break; } }
    }
    nloc = mine > 0u ? mine : 1u; nx = cnt > 0u ? cnt : 1u;
}
__device__ __forceinline__ void xcd_barrier(const XcdBarrier& b, const int tid) {
    asm volatile("s_waitcnt vmcnt(0)" ::: "memory");
    __syncthreads();
    if (tid == 0) {
        unsigned* bar = b.bar;
        __builtin_amdgcn_s_waitcnt(0);
        unsigned nloc = b.st[0], nx = b.st[1];
        if (nloc == 0u) { xcd_barrier_complete(bar, b.x, nloc, nx); b.st[0] = nloc; b.st[1] = nx; }
        const unsigned old = xb_add(&bar[XB_XSUB(b.x)], 1u);
        const unsigned gen = old / nloc;
        if (old + 1u == (gen + 1u) * nloc) {
            __builtin_amdgcn_fence(__ATOMIC_RELEASE, "agent");
            asm volatile("s_waitcnt vmcnt(0)" ::: "memory");
            const unsigned og = xb_add(&bar[XB_TOP], 1u);
            const unsigned tg = og / nx;
            if (og + 1u == (tg + 1u) * nx) xb_add(&bar[XB_TOPGEN], 1u);
            else XB_SPIN(xb_ld(&bar[XB_TOPGEN]) == tg, bar);
            __builtin_amdgcn_fence(__ATOMIC_ACQUIRE, "agent");
            xb_add(&bar[XB_XGEN(b.x)], 1u);
            asm volatile("s_waitcnt vmcnt(0)" ::: "memory");
        } else {
            XB_SPIN(xb_ld(&bar[XB_XGEN(b.x)]) == gen, bar);
            __builtin_amdgcn_fence(__ATOMIC_ACQUIRE, "agent");
            asm volatile("s_waitcnt vmcnt(0)" ::: "memory");
        }
    }
    __syncthreads();
}

__global__ void __launch_bounds__(NTHREADS, 2) fwd_megakernel(const Params p_unused) {
  extern __shared__ __attribute__((aligned(16))) unsigned char shm[];
  cg::grid_group grid = cg::this_grid();
  char* lds = (char*)shm;
  __shared__ uint4 xb_words;
  const int wave_s = __builtin_amdgcn_readfirstlane((int)(threadIdx.x >> 6));
  if (threadIdx.x == 0) xb_words = make_uint4(0u, 0u, 0u, 0u);
  __syncthreads();
  { KP p0 = (KP)__builtin_amdgcn_kernarg_segment_ptr(); (void)xcd_barrier_post((unsigned*)(p0->ws + OFF_BAR), (volatile LAS unsigned*)&xb_words);
    phase_pre(p0, lds, (int)threadIdx.x); }
  { KP p0 = (KP)__builtin_amdgcn_kernarg_segment_ptr(); char* w0 = p0->ws;
    if (w0 == nullptr) grid.sync();
    XcdBarrier xb; xb.bar = (unsigned*)(w0 + OFF_BAR); xb.x = xb_xcc_id(); xb.st = (volatile LAS unsigned*)&xb_words; xcd_barrier(xb, (int)threadIdx.x); }
#ifndef PHM
#define PHM 0xffff
#endif
#define PH(k) if constexpr (((PHM) >> (k)) & 1)
  for (int oi = 1; oi < PROG.n; ++oi) {
    const Op op = PROG.ops[oi];
    unsigned zz = 0u; asm volatile("" : "+v"(zz));
    int tid = wave_s * 64 + (int)__builtin_amdgcn_mbcnt_hi(~0u, __builtin_amdgcn_mbcnt_lo(~0u, zz)); asm volatile("" : "+v"(tid));
    KP p = (KP)__builtin_amdgcn_kernarg_segment_ptr(); asm volatile("" : "+s"(p));
    char* ws = p->ws;
    switch (op.type) {
      case OP_MODFIN: PH(1) phase_modfin(p, tid); break;
      case OP_NORM: PH(2) phase_norm(p, op.i0, tid); break;
      case OP_GEMM_BF: case OP_GEMM_BF_NOSYNC: PH(3) {
        pg8::Gemm g{(const bf16_t*)(ws + op.a), (const bf16_t*)(ws + op.b), T, op.i0, op.i1, op.i2};
        pg8::StaticOrder S; S.init(T, op.i0, (int)gridDim.x, (int)blockIdx.x);
        pg8::EpiBf16 E{(bf16_t*)(ws + op.o), op.i0};
        pg8::gemm_phase<pg8::EpiBf16>((LAS unsigned char*)shm, g, S, E, tid);
      } break;
      case OP_GEMM_RES: PH(4) {
        pg8::Gemm g{(const bf16_t*)(ws + op.a), (const bf16_t*)(ws + op.b), T, DM, DM, op.i2};
        pg8::StaticOrder S; S.init(T, DM, (int)gridDim.x, (int)blockIdx.x, op.i0 == DEPTH - 1);
        float* xsc = (float*)(ws + OFF_XSC); float* outp = p->out;
        pg8::EpiResid E{op.i0 == 0 ? p->in[IN_X] : (const float*)outp, op.i0 == 0 ? p->in[IN_CTX] : (const float*)xsc, outp, xsc, (const float*)(ws + OFF_MOD) + (size_t)op.i0 * 5 * 3072};
        pg8::gemm_phase<pg8::EpiResid>((LAS unsigned char*)shm, g, S, E, tid);
      } break;
      case OP_GQA_POST: PH(5) phase_gqa_post(p, op.i0, op.i1, tid); break;
      case OP_ATT_GQA: PH(6) phase_att_gqa(p, op.i0, op.i1, op.i2, lds, tid); break;
      case OP_ATT_NA: PH(7) phase_att_na(p, op.i0, op.i1, lds, tid); break;
      case OP_MLA_POST1: PH(8) phase_mla_post1(p, op.i1, tid); break;
      case OP_MLA_POST2: PH(9) phase_mla_post2(p, tid); break;
      case OP_ATT_MLA: PH(10) phase_att_mla(p, op.i0, op.i1, lds, tid); break;
      case OP_FINAL: PH(11) phase_final(p, op.i1, tid); break;
      default: break;
    }
    if (op.type == OP_GEMM_BF_NOSYNC) __syncthreads(); else { XcdBarrier xb; xb.bar = (unsigned*)(ws + OFF_BAR); xb.x = xb_xcc_id(); xb.st = (volatile LAS unsigned*)&xb_words; xcd_barrier(xb, tid);
      if (PROBE_DUP & 512) { xcd_barrier(xb, tid); xcd_barrier(xb, tid); } }
  }
}

extern "C" void kernel_launch(void* const* d_in, const int* in_sizes, int n_in, void* d_out, int out_size, void* d_ws, size_t ws_size, hipStream_t stream) {
  static int grid_blocks = 0;
  if (!grid_blocks) {
    if (ws_size < WS_END) { fprintf(stderr, "kernel_launch: workspace too small: %zu < %zu\n", ws_size, (size_t)WS_END); return; }
    if (hipFuncSetAttribute((const void*)fwd_megakernel, hipFuncAttributeMaxDynamicSharedMemorySize, LDS_BYTES) != hipSuccess) { fprintf(stderr, "kernel_launch: hipFuncSetAttribute failed\n"); return; }
    int dev = 0, cus = 0, per_cu = 0;
    hipGetDevice(&dev);
    hipDeviceGetAttribute(&cus, hipDeviceAttributeMultiprocessorCount, dev);
    hipOccupancyMaxActiveBlocksPerMultiprocessor(&per_cu, fwd_megakernel, NTHREADS, LDS_BYTES);
    if (per_cu < 1) { fprintf(stderr, "kernel_launch: occupancy query returned %d\n", per_cu); return; }
    grid_blocks = cus;
  }
  Params p; memset(&p, 0, sizeof(p));
  if (n_in != N_IN) { fprintf(stderr, "kernel_launch: expected %d inputs, got %d\n", (int)N_IN, n_in); return; }
  for (int i = 0; i < N_IN; ++i) p.in[i] = (const float*)d_in[i];
  p.out = (float*)d_out; p.ws = (char*)d_ws;
  hipMemsetAsync((char*)d_ws + OFF_BAR, 0, XCD_BAR_WORDS * 4, stream);
  void* args[] = {&p};
  hipError_t e = hipLaunchCooperativeKernel((const void*)fwd_megakernel, dim3(grid_blocks), dim3(NTHREADS), args, LDS_BYTES, stream);
  if (e != hipSuccess) fprintf(stderr, "kernel_launch: cooperative launch failed: %s (grid %d)\n", hipGetErrorString(e), grid_blocks);
}
```

```cpp
#include <hip/hip_runtime.h>
#include <hip/hip_cooperative_groups.h>
#include <cstdio>
#include <cstring>
namespace cg = cooperative_groups;

#define LAS __attribute__((address_space(3)))
typedef unsigned short bf16_t;
typedef short bf16x8 __attribute__((ext_vector_type(8)));
typedef short s16x4 __attribute__((ext_vector_type(4)));
typedef float f32x4 __attribute__((ext_vector_type(4)));
typedef float f32x16 __attribute__((ext_vector_type(16)));
typedef unsigned u32x4 __attribute__((ext_vector_type(4)));
typedef unsigned u32x2 __attribute__((ext_vector_type(2)));

constexpr int NB = 4, SEQ = 8192, CTX = 256, DM = 1024, TPB = SEQ + CTX, T = NB * TPB;
constexpr int DEPTH = 4;
constexpr float EPS = 1e-6f;
constexpr int NTHREADS = 512;
constexpr int LDS_BYTES = 131072;

constexpr size_t OFF_XSC = 0;
constexpr size_t OFF_HB = OFF_XSC + (size_t)NB * CTX * DM * 4;
constexpr size_t OFF_PJ = OFF_HB + (size_t)T * DM * 2;
constexpr size_t OFF_QM = OFF_PJ + (size_t)T * 4096 * 2;
constexpr size_t OFF_W = OFF_QM + (size_t)T * 1536 * 2;
constexpr size_t W_GA_IN = 0, W_GA_OUT = W_GA_IN + 2ull * 2560 * 1024, W_NA_IN = W_GA_OUT + 2ull * 1024 * 1024, W_NA_OUT = W_NA_IN + 4096ull * 1024,
                 W_ML_IN = W_NA_OUT + 1024ull * 1024, W_ML_UQ = W_ML_IN + 2048ull * 1024, W_ML_UKV = W_ML_UQ + 1536ull * 512, W_ML_OUT = W_ML_UKV + 2048ull * 256,
                 W_END = W_ML_OUT + 1024ull * 1024;
constexpr size_t OFF_MODP = OFF_W + W_END * 2;
constexpr size_t OFF_MOD = OFF_MODP + 16ull * 4 * 5 * 3072 * 4;
constexpr size_t OFF_TABA = OFF_MOD + 4ull * 5 * 3072 * 4;
constexpr size_t OFF_TABM = OFF_TABA + 128ull * 32 * 8;
constexpr size_t OFF_BAR = OFF_TABM + 128ull * 16 * 8;
constexpr size_t WS_END = OFF_BAR + 3456ull * 4;

struct Op { int type, i0, i1, i2; unsigned long long a, b, o; };
enum { OP_PRE = 0, OP_MODFIN, OP_NORM, OP_GEMM_BF, OP_GEMM_RES, OP_GQA_POST, OP_ATT_GQA, OP_ATT_NA, OP_MLA_POST1, OP_MLA_POST2, OP_ATT_MLA, OP_FINAL, OP_GEMM_BF_NOSYNC };
enum { IN_X = 0, IN_C, IN_CTX, IN_CCTX, IN_MODW, IN_MODB, IN_NORMG, IN_FINALG, IN_GA_WIN, IN_GA_QG, IN_GA_KG, IN_GA_WOUT, IN_NA_WIN, IN_NA_RPB, IN_NA_WOUT,
       IN_ML_WIN, IN_ML_QG, IN_ML_KVG, IN_ML_WUQ, IN_ML_WUKV, IN_ML_WOUT, N_IN };
struct Params { const float* in[N_IN]; float* out; char* ws; };
#define KAS __attribute__((address_space(4)))
typedef const KAS Params* KP;

#ifndef PROBE_DUP
#define PROBE_DUP 0
#endif
constexpr int MAXOPS = 64;
struct Prog { Op ops[MAXOPS]; int n; };
constexpr void prog_add1(Prog& P, int type, int i0, int i1, int i2, size_t a, size_t b, size_t o) { Op& q = P.ops[P.n++]; q.type = type; q.i0 = i0; q.i1 = i1; q.i2 = i2; q.a = a; q.b = b; q.o = o; }
constexpr void prog_add(Prog& P, int type, int i0, int i1, int i2, size_t a, size_t b, size_t o) {
  const bool gemm = type == OP_GEMM_BF || type == OP_GEMM_BF_NOSYNC;
  if ((PROBE_DUP & 1) && gemm) prog_add1(P, OP_GEMM_BF, i0, i1, i2, a, b, o);
  if ((PROBE_DUP & 2) && type == OP_ATT_GQA) prog_add1(P, type, i0, 1, i2, a, b, o);
  if ((PROBE_DUP & 4) && type == OP_ATT_MLA) prog_add1(P, type, i0, 1, i2, a, b, o);
  if ((PROBE_DUP & 8) && type == OP_ATT_NA) prog_add1(P, type, i0, 1, i2, a, b, o);
  if ((PROBE_DUP & 16) && type == OP_NORM) prog_add1(P, type, i0, i1, i2, a, b, o);
  if ((PROBE_DUP & 32) && type == OP_GEMM_RES && i0 == 0) prog_add1(P, type, i0, i1, i2, a, b, o);
  if ((PROBE_DUP & 128) && type == OP_GQA_POST) prog_add1(P, type, i0, 1, i2, a, b, o);
  if ((PROBE_DUP & 256) && (type == OP_MLA_POST1 || type == OP_FINAL)) prog_add1(P, type, i0, 1, i2, a, b, o);
  if ((PROBE_DUP & 64) && type == OP_PRE) prog_add1(P, type, i0, i1, i2, a, b, o);
  prog_add1(P, type, i0, i1, i2, a, b, o);
}
constexpr Prog make_prog() {
  Prog P{}; P.n = 0;
  const size_t W = OFF_W, hb = OFF_HB, pj = OFF_PJ, qm = OFF_QM;
  prog_add(P, OP_PRE, 0, 0, 0, 0, 0, 0);
  prog_add(P, OP_MODFIN, 0, 0, 0, 0, 0, 0);
  for (int i = 0; i < DEPTH; ++i) {
    const int kind = i % 3, j = i / 3, need_ctx = i < DEPTH - 1;
    prog_add(P, OP_NORM, i, 0, 0, 0, 0, 0);
    if (kind == 0) {
      prog_add(P, OP_GEMM_BF, 2560, 1024, 1024, hb, W + 2 * (W_GA_IN + (size_t)j * 2560 * 1024), pj);
      prog_add(P, OP_GQA_POST, j, 0, 0, 0, 0, 0);
      prog_add(P, OP_ATT_GQA, need_ctx, 0, j, 0, 0, 0);
      prog_add(P, OP_GEMM_RES, i, 0, 2560, pj + 2 * 1536, W + 2 * (W_GA_OUT + (size_t)j * 1024 * 1024), 0);
    } else if (kind == 1) {
      prog_add(P, OP_GEMM_BF, 4096, 1024, 1024, hb, W + 2 * W_NA_IN, pj);
      prog_add(P, OP_ATT_NA, need_ctx, 0, 0, 0, 0, 0);
      prog_add(P, OP_GEMM_RES, i, 0, 4096, pj + 2 * 3072, W + 2 * W_NA_OUT, 0);
    } else {
      prog_add(P, OP_GEMM_BF, 2048, 1024, 1024, hb, W + 2 * W_ML_IN, pj);
      prog_add(P, OP_MLA_POST1, 0, 0, 0, 0, 0, 0);
      prog_add(P, OP_GEMM_BF_NOSYNC, 1536, 512, 2048, pj, W + 2 * W_ML_UQ, qm);
      prog_add(P, OP_GEMM_BF, 2048, 256, 2048, pj + 2 * 512, W + 2 * W_ML_UKV, pj + (size_t)T * 2048 * 2);
      prog_add(P, OP_ATT_MLA, need_ctx, 0, 0, 0, 0, 0);
      prog_add(P, OP_GEMM_RES, i, 0, 2048, pj + 2 * 832, W + 2 * W_ML_OUT, 0);
    }
  }
  prog_add(P, OP_FINAL, 0, 0, 0, 0, 0, 0);
  return P;
}
__device__ const Prog PROG = make_prog();

struct WDesc { int in_idx; int K, N, Npad, tile0; unsigned src_off, dst_off; int pad_; };
constexpr int NWD = 10;
struct WTab { WDesc d[NWD]; int ntiles; };
constexpr WTab make_wtab() {
  WTab t{}; int nt = 0, wi = 0;
  auto addw = [&](int in_idx, size_t src_off, size_t dst, int K, int N, int Npad) { WDesc& w = t.d[wi++]; w.in_idx = in_idx; w.src_off = (unsigned)src_off; w.dst_off = (unsigned)dst; w.K = K; w.N = N; w.Npad = Npad; w.tile0 = nt; w.pad_ = 0; nt += (K / 64) * (Npad / 64); };
  addw(IN_GA_WIN, 0, W_GA_IN, 1024, 2560, 2560); addw(IN_GA_WIN, 1024ull * 2560, W_GA_IN + 2560ull * 1024, 1024, 2560, 2560);
  addw(IN_GA_WOUT, 0, W_GA_OUT, 1024, 1024, 1024); addw(IN_GA_WOUT, 1024ull * 1024, W_GA_OUT + 1024ull * 1024, 1024, 1024, 1024);
  addw(IN_NA_WIN, 0, W_NA_IN, 1024, 4096, 4096); addw(IN_NA_WOUT, 0, W_NA_OUT, 1024, 1024, 1024);
  addw(IN_ML_WIN, 0, W_ML_IN, 1024, 1856, 2048); addw(IN_ML_WUQ, 0, W_ML_UQ, 512, 1536, 1536); addw(IN_ML_WUKV, 0, W_ML_UKV, 256, 2048, 2048); addw(IN_ML_WOUT, 0, W_ML_OUT, 1024, 1024, 1024);
  t.ntiles = nt; return t;
}
__device__ const WTab WTAB = make_wtab();

__device__ const float INV_A[32] = {1.000000000e+00f, 7.498942614e-01f, 5.623413324e-01f, 4.216965139e-01f, 3.162277639e-01f, 2.371373773e-01f, 1.778279394e-01f, 1.333521307e-01f, 1.000000015e-01f, 7.498941571e-02f, 5.623413250e-02f, 4.216965288e-02f, 3.162277490e-02f, 2.371373773e-02f, 1.778279431e-02f, 1.333521493e-02f, 9.999999776e-03f, 7.498941850e-03f, 5.623413250e-03f, 4.216964822e-03f, 3.162277630e-03f, 2.371373586e-03f, 1.778279431e-03f, 1.333521446e-03f, 1.000000047e-03f, 7.498942432e-04f, 5.623413017e-04f, 4.216965172e-04f, 3.162277571e-04f, 2.371373703e-04f, 1.778279402e-04f, 1.333521504e-04f};
__device__ const float INV_M[16] = {1.000000000e+00f, 5.623413324e-01f, 3.162277639e-01f, 1.778279394e-01f, 1.000000015e-01f, 5.623413250e-02f, 3.162277490e-02f, 1.778279431e-02f, 9.999999776e-03f, 5.623413250e-03f, 3.162277630e-03f, 1.778279431e-03f, 1.000000047e-03f, 5.623413017e-04f, 3.162277571e-04f, 1.778279402e-04f};

__device__ __forceinline__ float bf2f(short b) { return __uint_as_float(((unsigned)(unsigned short)b) << 16); }
__device__ __forceinline__ unsigned cvtpk(float lo, float hi) { unsigned r; asm volatile("v_cvt_pk_bf16_f32 %0, %1, %2" : "=v"(r) : "v"(lo), "v"(hi)); return r; }
__device__ __forceinline__ bf16x8 pack8(const float* v) { u32x4 w = {cvtpk(v[0], v[1]), cvtpk(v[2], v[3]), cvtpk(v[4], v[5]), cvtpk(v[6], v[7])}; return *reinterpret_cast<bf16x8*>(&w); }
__device__ __forceinline__ float silu_f(float g) { return g * __builtin_amdgcn_rcpf(1.f + __builtin_amdgcn_exp2f(-g * 1.4426950408889634f)); }
__device__ __forceinline__ float wave_sum(float v) {
#pragma unroll
  for (int o = 32; o >= 1; o >>= 1) v += __shfl_xor(v, o);
  return v;
}
__device__ __forceinline__ const float* res_src(KP p, int layer, int row) {
  const int b = row / TPB, j = row - b * TPB;
  if (j < CTX) return (layer == 0 ? p->in[IN_CTX] : (const float*)(p->ws + OFF_XSC)) + ((size_t)b * CTX + j) * DM;
  return (layer == 0 ? p->in[IN_X] : (const float*)p->out) + ((size_t)b * SEQ + (j - CTX)) * DM;
}

namespace pg8 {
constexpr int BM = 256, BK = 64, HALF = 128, HTB = HALF * BK * 2, STAGE_BYTES = 8 * HTB, NXCD = 8, WGM = 8;
__device__ __forceinline__ int lds_byte(int r, int c) { const int st = (r >> 4) * 2 + (c >> 5), rr = r & 15, cc = c & 31, ob = rr * 64 + cc * 2; return st * 1024 + (ob ^ (((ob >> 9) & 1) << 5)); }
__device__ __forceinline__ void stage_rc(int b, int& R, int& C) { const int st = b / 1024, sb = b % 1024, swz = sb ^ (((sb >> 9) & 1) << 5); R = (st >> 1) * 16 + swz / 64; C = (st & 1) * 32 + (swz % 64) / 2; }
__device__ __forceinline__ int perm32(int rho) { const int n = rho >> 4, i = rho & 15; return 8 * (i >> 2) + 4 * n + (i & 3); }
struct Unit { int pm, pn; };
struct Gemm { const bf16_t* A; const bf16_t* Bt; int M, N, K, lda; };
struct StaticOrder {
  int nM, nN, nwg, G, c, latonly;
  __device__ void init(int M, int N, int G_, int c_, int latonly_ = 0) { latonly = latonly_; nM = latonly ? 128 : M / BM; nN = N / BM; nwg = nM * nN; G = G_; c = c_; }
  __device__ bool next(int i, Unit& u) const {
    const long L = (long)i * G + c; if (L >= nwg) return false;
    int wgid = (int)L; { const int q = nwg / NXCD, r = nwg % NXCD, xcd = wgid % NXCD, off = wgid / NXCD; wgid = (xcd < r ? xcd * (q + 1) : r * (q + 1) + (xcd - r) * q) + off; }
    const int nig = WGM * nN, gid = wgid / nig, fm = gid * WGM, gsz = (nM - fm) < WGM ? (nM - fm) : WGM;
    u.pm = fm + ((wgid % nig) % gsz); u.pn = (wgid % nig) / gsz; if (latonly) u.pm += (u.pm >> 5) + 1; return true;
  }
};
struct EpiBf16 {
  static constexpr bool PERM = true;
  bf16_t* O; int ldc;
  __device__ __forceinline__ void operator()(const f32x4 (&acc)[2][2][4][2], const Unit& u, int wr, int wc, int fr, int fq) const {
    const int row0 = u.pm * BM + wr * 64 + fr, col0 = u.pn * BM + wc * 32 + 8 * fq;
#pragma unroll
    for (int ai = 0; ai < 2; ++ai)
#pragma unroll
      for (int m = 0; m < 4; ++m) { bf16_t* rowp = O + (size_t)(row0 + ai * HALF + m * 16) * ldc + col0;
#pragma unroll
        for (int bj = 0; bj < 2; ++bj) { const f32x4 v0 = acc[ai][bj][m][0], v1 = acc[ai][bj][m][1];
          u32x4 w; w.x = cvtpk(v0[0], v0[1]); w.y = cvtpk(v0[2], v0[3]); w.z = cvtpk(v1[0], v1[1]); w.w = cvtpk(v1[2], v1[3]);
          *(u32x4*)(rowp + bj * HALF) = w; } }
  }
};
struct EpiResid {
  static constexpr bool PERM = true;
  const float* res_lat; const float* res_ctx; float* out_lat; float* out_ctx; const float* mod;
  __device__ __forceinline__ void operator()(const f32x4 (&acc)[2][2][4][2], const Unit& u, int wr, int wc, int fr, int fq) const {
    const int b = u.pm / 33, lt = u.pm - b * 33;
    const float* rb; float* ob; const float* g;
    if (lt == 0) { rb = res_ctx + (size_t)b * CTX * DM; ob = out_ctx + (size_t)b * CTX * DM; g = mod + 4 * 3072 + 2048; }
    else { const size_t o = ((size_t)b * SEQ + (size_t)(lt - 1) * 256) * DM; rb = res_lat + o; ob = out_lat + o; g = mod + b * 3072 + 2048; }
    const int lr0 = wr * 64 + fr, col0 = u.pn * BM + wc * 32 + 8 * fq;
    f32x4 gv[2][2];
#pragma unroll
    for (int bj = 0; bj < 2; ++bj)
#pragma unroll
      for (int n = 0; n < 2; ++n) gv[bj][n] = *(const f32x4*)(g + col0 + bj * HALF + n * 4);
#pragma unroll
    for (int ai = 0; ai < 2; ++ai)
#pragma unroll
      for (int m = 0; m < 4; ++m) { const size_t ro = (size_t)(lr0 + ai * HALF + m * 16) * DM + col0;
#pragma unroll
        for (int bj = 0; bj < 2; ++bj)
#pragma unroll
          for (int n = 0; n < 2; ++n) { const f32x4 r = *(const f32x4*)(rb + ro + bj * HALF + n * 4);
            *(f32x4*)(ob + ro + bj * HALF + n * 4) = r + gv[bj][n] * acc[ai][bj][m][n]; } }
  }
};

template <class Epi>
__device__ __forceinline__ void gemm_phase(LAS unsigned char* lds, const Gemm g, const StaticOrder& S, const Epi& E, const int tid) {
  const int wid = __builtin_amdgcn_readfirstlane(tid >> 6), lane = tid & 63, wr = wid >> 2, wc = wid & 3, fr = lane & 15, fq = lane >> 4;
  const int K = g.K, nt = K / BK, lda = g.lda;
  unsigned voffA[2], voffB[2];
#pragma unroll
  for (int i = 0; i < 2; ++i) { int R, C; stage_rc(tid * 16 + i * 8192, R, C); const int Rb = Epi::PERM ? ((R & ~31) + perm32(R & 31)) : R;
    voffA[i] = (unsigned)(R * lda + C) * 2u; voffB[i] = (unsigned)(Rb * K + C) * 2u; }
  const size_t kstep = (size_t)(BK * 2);
  const size_t hstepA = (size_t)HALF * lda * 2, hstepB = (size_t)HALF * K * 2;
  const size_t tstepA = 2 * hstepA, tstepB = 2 * hstepB;
  const unsigned ldsw = (unsigned)wid * 1024u;
  const int aoff = lds_byte(wr * 64 + fr, fq * 8), boff = lds_byte(wc * 32 + fr, fq * 8);
#define PG8_SA(b, h) (((b) * 2 + (h)) * HTB)
#define PG8_SB(b, h) ((4 + (b) * 2 + (h)) * HTB)
#define PG8_STAGE(bufoff, gbase, voff) do { _Pragma("unroll") for (int _i = 0; _i < 2; ++_i) \
    __builtin_amdgcn_global_load_lds((const unsigned*)((const char*)(gbase) + (voff)[_i]), (LAS unsigned*)(lds + (bufoff) + ldsw + _i * 8192), 16, 0, 0); } while (0)
#define PG8_LDA(dst, b, h) do { _Pragma("unroll") for (int m = 0; m < 4; ++m) _Pragma("unroll") for (int k = 0; k < 2; ++k) dst[m][k] = *(const LAS bf16x8*)(lds + PG8_SA(b, h) + aoff + m * 2048 + k * 1024); } while (0)
#define PG8_LDB(dst, b, h) do { _Pragma("unroll") for (int n = 0; n < 2; ++n) _Pragma("unroll") for (int k = 0; k < 2; ++k) dst[n][k] = *(const LAS bf16x8*)(lds + PG8_SB(b, h) + boff + n * 2048 + k * 1024); } while (0)
#define PG8_MMA(ai, bj, At, Bt) do { __builtin_amdgcn_s_setprio(1); _Pragma("unroll") for (int m = 0; m < 4; ++m) _Pragma("unroll") for (int n = 0; n < 2; ++n) _Pragma("unroll") for (int k = 0; k < 2; ++k) \
    acc[ai][bj][m][n] = __builtin_amdgcn_mfma_f32_16x16x32_bf16(Bt[n][k], At[m][k], acc[ai][bj][m][n], 0, 0, 0); __builtin_amdgcn_s_setprio(0); } while (0)
#define PG8_WAIT_V(n) asm volatile("s_waitcnt vmcnt(" #n ")" ::: "memory")
#define PG8_WAIT_L(n) asm volatile("s_waitcnt lgkmcnt(" #n ")" ::: "memory")
#define PG8_BAR __builtin_amdgcn_s_barrier()
#define PG8_SCHED __builtin_amdgcn_sched_barrier(0)
  Unit cur, nxt; int ui = 0;
  if (!S.next(0, cur)) return;
  f32x4 acc[2][2][4][2];
#pragma unroll
  for (int a = 0; a < 2; ++a)
#pragma unroll
    for (int b = 0; b < 2; ++b)
#pragma unroll
      for (int m = 0; m < 4; ++m)
#pragma unroll
        for (int n = 0; n < 2; ++n) acc[a][b][m][n] = (f32x4){0.f, 0.f, 0.f, 0.f};
  bf16x8 At[4][2], B0[2][2], B1[2][2];
  const char* cA = (const char*)g.A + (size_t)cur.pm * tstepA; const char* cB = (const char*)g.Bt + (size_t)cur.pn * tstepB;
  PG8_STAGE(PG8_SB(0, 0), cB, voffB); PG8_STAGE(PG8_SA(0, 0), cA, voffA); PG8_STAGE(PG8_SB(0, 1), cB + hstepB, voffB); PG8_STAGE(PG8_SA(0, 1), cA + hstepA, voffA);
  if (wr == 1) PG8_BAR;
  PG8_WAIT_V(4); PG8_BAR;
  PG8_STAGE(PG8_SB(1, 0), cB + kstep, voffB); PG8_STAGE(PG8_SA(1, 0), cA + kstep, voffA); PG8_STAGE(PG8_SB(1, 1), cB + hstepB + kstep, voffB);
  PG8_WAIT_V(6); PG8_BAR;
  for (;;) {
    const bool has_next = S.next(ui + 1, nxt);
    const char* nA = has_next ? (const char*)g.A + (size_t)nxt.pm * tstepA : cA; const char* nB = has_next ? (const char*)g.Bt + (size_t)nxt.pn * tstepB : cB;
    for (int t = 0; t < nt; t += 2) {
      const bool last = (t == nt - 2);
      const char* a1 = cA + (size_t)(t + 1) * kstep;
      const char* a2 = last ? nA : cA + (size_t)(t + 2) * kstep; const char* b2 = last ? nB : cB + (size_t)(t + 2) * kstep;
      const char* a3 = a2 + kstep; const char* b3 = b2 + kstep;
      PG8_LDB(B0, 0, 0); PG8_SCHED; PG8_LDA(At, 0, 0); PG8_STAGE(PG8_SA(1, 1), a1 + hstepA, voffA);
      PG8_WAIT_L(8); PG8_BAR; PG8_WAIT_L(0); PG8_MMA(0, 0, At, B0); PG8_BAR; PG8_SCHED;
      PG8_LDB(B1, 0, 1); PG8_STAGE(PG8_SB(0, 0), b2, voffB);
      PG8_BAR; PG8_WAIT_L(0); PG8_MMA(0, 1, At, B1); PG8_BAR;
      PG8_LDA(At, 0, 1); PG8_STAGE(PG8_SA(0, 0), a2, voffA);
      PG8_BAR; PG8_WAIT_L(0); PG8_MMA(1, 0, At, B0); PG8_BAR; PG8_SCHED;
      PG8_STAGE(PG8_SB(0, 1), b2 + hstepB, voffB);
      PG8_WAIT_V(6); PG8_BAR; PG8_MMA(1, 1, At, B1); PG8_BAR;
      PG8_LDB(B0, 1, 0); PG8_SCHED; PG8_LDA(At, 1, 0); PG8_STAGE(PG8_SA(0, 1), a2 + hstepA, voffA);
      PG8_WAIT_L(8); PG8_BAR; PG8_WAIT_L(0); PG8_MMA(0, 0, At, B0); PG8_BAR; PG8_SCHED;
      PG8_LDB(B1, 1, 1); PG8_STAGE(PG8_SB(1, 0), b3, voffB);
      PG8_BAR; PG8_WAIT_L(0); PG8_MMA(0, 1, At, B1); PG8_BAR;
      PG8_LDA(At, 1, 1); PG8_STAGE(PG8_SA(1, 0), a3, voffA);
      PG8_BAR; PG8_WAIT_L(0); PG8_MMA(1, 0, At, B0); PG8_BAR; PG8_SCHED;
      PG8_STAGE(PG8_SB(1, 1), b3 + hstepB, voffB);
      PG8_WAIT_V(6); PG8_BAR; PG8_MMA(1, 1, At, B1); PG8_BAR;
    }
    E(acc, cur, wr, wc, fr, fq);
    if (!has_next) break;
#pragma unroll
    for (int a = 0; a < 2; ++a)
#pragma unroll
      for (int b = 0; b < 2; ++b)
#pragma unroll
        for (int m = 0; m < 4; ++m)
#pragma unroll
          for (int n = 0; n < 2; ++n) acc[a][b][m][n] = (f32x4){0.f, 0.f, 0.f, 0.f};
    cur = nxt; cA = nA; cB = nB; ++ui;
  }
  PG8_WAIT_V(0);
  if (wr == 0) PG8_BAR;
  PG8_BAR;
#undef PG8_SA
#undef PG8_SB
#undef PG8_STAGE
#undef PG8_LDA
#undef PG8_LDB
#undef PG8_MMA
#undef PG8_WAIT_V
#undef PG8_WAIT_L
#undef PG8_BAR
#undef PG8_SCHED
}
}

#define SBAR() __builtin_amdgcn_sched_barrier(0)
__device__ __forceinline__ int crow(int r, int hi) { return (r & 3) + 8 * (r >> 2) + 4 * hi; }
constexpr float THR = 8.f;
template <int DQK> struct ScaleOf;
template <> struct ScaleOf<64> { static constexpr float v = 0.125f; };
template <> struct ScaleOf<128> { static constexpr float v = 0.088388347648318440f; };
template <> struct ScaleOf<192> { static constexpr float v = 0.072168783648703220f; };

template <int DQK>
__device__ __forceinline__ void partialSM(f32x16& p0, f32x16& p1, float& m_reg, float& mn, float& alpha) {
  constexpr float SCALE = ScaleOf<DQK>::v, C = SCALE * 1.4426950408889634f;
  float pmax = p0[0];
#pragma unroll
  for (int r = 1; r < 16; ++r) pmax = fmaxf(pmax, p0[r]);
#pragma unroll
  for (int r = 0; r < 16; ++r) pmax = fmaxf(pmax, p1[r]);
  { auto rr = __builtin_amdgcn_permlane32_swap(__float_as_uint(pmax), __float_as_uint(pmax), false, false);
    pmax = fmaxf(__uint_as_float(rr[0]), __uint_as_float(rr[1])); }
  if (__builtin_expect(__all(pmax - m_reg <= THR / SCALE), 1)) { mn = m_reg; alpha = 1.f; }
  else { mn = fmaxf(m_reg, pmax); alpha = __builtin_amdgcn_exp2f((m_reg - mn) * C); m_reg = mn; }
  const float mnC = -mn * C;
#pragma unroll
  for (int r = 0; r < 16; ++r) p0[r] = fmaf(p0[r], C, mnC);
#pragma unroll
  for (int r = 0; r < 16; ++r) p1[r] = fmaf(p1[r], C, mnC);
#pragma unroll
  for (int r = 0; r < 16; ++r) p0[r] = __builtin_amdgcn_exp2f(p0[r]);
}
__device__ __forceinline__ void partialSM2(f32x16& p0, f32x16& p1, float& m_reg, float& alpha, f32x16& negm, const bool first) {
  constexpr float THR2 = THR * 1.4426950408889634f;
  float pmax = p0[0];
#pragma unroll
  for (int r = 1; r < 16; ++r) pmax = fmaxf(pmax, p0[r]);
#pragma unroll
  for (int r = 0; r < 16; ++r) pmax = fmaxf(pmax, p1[r]);
  { auto rr = __builtin_amdgcn_permlane32_swap(__float_as_uint(pmax), __float_as_uint(pmax), false, false);
    pmax = fmaxf(__uint_as_float(rr[0]), __uint_as_float(rr[1])); }
  if (__builtin_expect(!first && __all(pmax <= THR2), 1)) { alpha = 1.f; }
  else { const float d = first ? pmax : fmaxf(pmax, 0.f); alpha = first ? 1.f : __builtin_amdgcn_exp2f(-d); m_reg += d;
#pragma unroll
    for (int r = 0; r < 16; ++r) { p0[r] -= d; p1[r] -= d; }
    const float nm = -m_reg;
#pragma unroll
    for (int r = 0; r < 16; ++r) negm[r] = nm; }
#pragma unroll
  for (int r = 0; r < 16; ++r) p0[r] = __builtin_amdgcn_exp2f(p0[r]);
}
__device__ __forceinline__ void finishSM(f32x16& p0, f32x16& p1, float alpha, float& l_reg, bf16x8& pa0, bf16x8& pa1, bf16x8& pa2, bf16x8& pa3) {
#pragma unroll
  for (int r = 0; r < 16; ++r) p1[r] = __builtin_amdgcn_exp2f(p1[r]);
  float ps = 0;
#pragma unroll
  for (int r = 0; r < 16; ++r) ps += p0[r];
#pragma unroll
  for (int r = 0; r < 16; ++r) ps += p1[r];
  { auto rr = __builtin_amdgcn_permlane32_swap(__float_as_uint(ps), __float_as_uint(ps), false, false);
    ps = __uint_as_float(rr[0]) + __uint_as_float(rr[1]); }
  l_reg = l_reg * alpha + ps;
#define PK4(P, BASE, OUT) do { u32x4 w = {cvtpk(P[BASE + 0], P[BASE + 1]), cvtpk(P[BASE + 2], P[BASE + 3]), cvtpk(P[BASE + 4], P[BASE + 5]), cvtpk(P[BASE + 6], P[BASE + 7])}; \
    OUT = *reinterpret_cast<bf16x8*>(&w); } while (0)
  PK4(p0, 0, pa0); PK4(p0, 8, pa1); PK4(p1, 0, pa2); PK4(p1, 8, pa3);
#undef PK4
}
template <int DQK>
__device__ __forceinline__ void qkt(f32x16& p0, f32x16& p1, const char* Ks, const bf16x8* qr, int r32, int hi, const f32x16 init = f32x16{}) {
  constexpr int RB = DQK * 2;
  p0 = init; p1 = init;
#pragma unroll
  for (int d0 = 0; d0 < DQK / 16; ++d0) { const int cb = (d0 * 16 + hi * 8) * 2;
    const int sw = (DQK >= 128 && d0 < 8) ? ((r32 & 15) << 4) : ((r32 & 7) << 4);
    bf16x8 b0 = *reinterpret_cast<const bf16x8*>(Ks + r32 * RB + (cb ^ sw));
    bf16x8 b1 = *reinterpret_cast<const bf16x8*>(Ks + (32 + r32) * RB + (cb ^ sw));
    p0 = __builtin_amdgcn_mfma_f32_32x32x16_bf16(b0, qr[d0], p0, 0, 0, 0);
    p1 = __builtin_amdgcn_mfma_f32_32x32x16_bf16(b1, qr[d0], p1, 0, 0, 0); }
}
template <int NCB> __device__ __forceinline__ int v_st(int k, int c) { const int kk = k; return ((kk >> 3) * NCB + (c >> 5)) * 512 + ((kk & 7) * 32 + (c & 31)) * 2; }
__device__ __forceinline__ int v_rd_base(int lane) { return ((lane & 3) << 3) | (((lane >> 2) & 3) << 6) | (((lane >> 4) & 1) << 5) | (((lane >> 5) & 1) << 8); }
template <int OFF> __device__ __forceinline__ s16x4 tr_read(int vb) {
  s16x4 r; asm volatile("ds_read_b64_tr_b16 %0, %1 offset:%2" : "=&v"(r) : "v"(vb), "i"(OFF) : "memory"); return r;
}
template <int NCB, int D0> __device__ __forceinline__ void pv_one(f32x16& od, int vb, bf16x8 pa0, bf16x8 pa1, bf16x8 pa2, bf16x8 pa3) {
#define VOFF(ks, half) (D0 * 512 + (ks) * (NCB * 1024) + (half) * (NCB * 512))
  const s16x4 l0 = tr_read<VOFF(0, 0)>(vb), h0 = tr_read<VOFF(0, 1)>(vb), l1 = tr_read<VOFF(1, 0)>(vb), h1 = tr_read<VOFF(1, 1)>(vb);
  const s16x4 l2 = tr_read<VOFF(2, 0)>(vb), h2 = tr_read<VOFF(2, 1)>(vb), l3 = tr_read<VOFF(3, 0)>(vb), h3 = tr_read<VOFF(3, 1)>(vb);
#undef VOFF
  asm volatile("s_waitcnt lgkmcnt(0)" ::: "memory"); SBAR();
#define PK(L, H) (bf16x8){L[0], L[1], L[2], L[3], H[0], H[1], H[2], H[3]}
  od = __builtin_amdgcn_mfma_f32_32x32x16_bf16(pa0, PK(l0, h0), od, 0, 0, 0);
  od = __builtin_amdgcn_mfma_f32_32x32x16_bf16(pa1, PK(l1, h1), od, 0, 0, 0);
  od = __builtin_amdgcn_mfma_f32_32x32x16_bf16(pa2, PK(l2, h2), od, 0, 0, 0);
  od = __builtin_amdgcn_mfma_f32_32x32x16_bf16(pa3, PK(l3, h3), od, 0, 0, 0);
#undef PK
}
template <int NCB> __device__ __forceinline__ void pv_all(f32x16* o, int vb, bf16x8 pa0, bf16x8 pa1, bf16x8 pa2, bf16x8 pa3) {
  pv_one<NCB, 0>(o[0], vb, pa0, pa1, pa2, pa3); pv_one<NCB, 1>(o[1], vb, pa0, pa1, pa2, pa3);
  if constexpr (NCB == 4) { pv_one<NCB, 2>(o[2], vb, pa0, pa1, pa2, pa3); pv_one<NCB, 3>(o[3], vb, pa0, pa1, pa2, pa3); }
}

template <int DQK, int DV, int MODE, int QPOST, int NEGM, int ldq, int ldk, int ldo>
__device__ __forceinline__ void attn_body_seq(const bf16_t* __restrict__ Qb, const bf16_t* __restrict__ Kp, const bf16_t* __restrict__ K2p, const bf16_t* __restrict__ Vp,
                                              int krow_base, bf16_t* __restrict__ OG, int NT, int na_r0, char* lds, int tid, int dummy, const float* qgain, const float2* qtab, int q_t0) {
  constexpr int NQ = DQK / 16, NCB = DV / 32, SHM_K = 64 * DQK * 2, SHM_V = 64 * DV * 2, RB = DQK * 2;
  constexpr int NKC = DQK / 64, NVC = DV / 64;
  const int wid = tid >> 6, lane = tid & 63, r32 = lane & 31, hi = lane >> 5;
  char* V_lds = lds; char* K_lds = lds + 2 * SHM_V;
  float* wsl = (float*)(lds + 2 * SHM_V + 2 * SHM_K) + wid * 64; float* li_l = wsl; float* al_l = wsl + 32;
  const float* bias_l = (const float*)(lds + 2 * SHM_V + 2 * SHM_K + 8 * 64 * 4);
  float m_reg = -1e30f, l_reg = 0; f32x16 o[NCB]; bf16x8 qr[NQ];
#pragma unroll
  for (int d = 0; d < NCB; ++d) o[d] = f32x16{};
  const bf16_t* Qw = Qb + (size_t)(wid * 32 + r32) * ldq + hi * 8;
#pragma unroll
  for (int d0 = 0; d0 < NQ; ++d0) qr[d0] = *reinterpret_cast<const bf16x8*>(Qw + d0 * 16);
  if constexpr (QPOST == 1) {
    float xq[8][8]; float ss = 0;
#pragma unroll
    for (int d0 = 0; d0 < 8; ++d0)
#pragma unroll
      for (int j = 0; j < 8; ++j) { xq[d0][j] = bf2f(qr[d0][j]); ss += xq[d0][j] * xq[d0][j]; }
    { auto rr = __builtin_amdgcn_permlane32_swap(__float_as_uint(ss), __float_as_uint(ss), false, false); ss = __uint_as_float(rr[0]) + __uint_as_float(rr[1]); }
    const float rstd = rsqrtf(ss * (1.f / 128.f) + EPS) * (NEGM ? ScaleOf<DQK>::v * 1.4426950408889634f : 1.f);
#pragma unroll
    for (int d0 = 0; d0 < 8; ++d0) { const f32x4 g0 = *(const f32x4*)(qgain + d0 * 16 + hi * 8), g1 = *(const f32x4*)(qgain + d0 * 16 + hi * 8 + 4);
#pragma unroll
      for (int j = 0; j < 4; ++j) { xq[d0][j] *= rstd * g0[j]; xq[d0][4 + j] *= rstd * g1[j]; } }
    if (q_t0 >= 0) { const int t = q_t0 + wid * 32 + r32, prow = t >> 6, pcol = t & 63;
#pragma unroll
      for (int dd = 0; dd < 4; ++dd) { const int d0 = (dd & 1) + (dd >> 1) * 4, pos = (dd >> 1) ? pcol : prow; const float2* tp = qtab + pos * 32 + (d0 & 1) * 16 + hi * 8;
#pragma unroll
        for (int j = 0; j < 8; ++j) { const float2 cs = tp[j]; const float x0 = xq[d0][j], x1 = xq[d0 + 2][j]; xq[d0][j] = x0 * cs.x - x1 * cs.y; xq[d0 + 2][j] = x1 * cs.x + x0 * cs.y; } } }
#pragma unroll
    for (int d0 = 0; d0 < 8; ++d0) qr[d0] = pack8(xq[d0]);
  }
  if constexpr (DQK == 192) {
    if (q_t0 >= 0) { const int t = q_t0 + wid * 32 + r32, prow = t >> 6, pcol = t & 63;
#pragma unroll
      for (int ax = 0; ax < 2; ++ax) { const float2* tp = qtab + (ax ? pcol : prow) * 16 + hi * 8; float y0[8], y1[8];
#pragma unroll
        for (int j = 0; j < 8; ++j) { const float2 cs = tp[j]; const float x0 = bf2f(qr[8 + 2 * ax][j]), x1 = bf2f(qr[9 + 2 * ax][j]); y0[j] = x0 * cs.x - x1 * cs.y; y1[j] = x1 * cs.x + x0 * cs.y; }
        qr[8 + 2 * ax] = pack8(y0); qr[9 + 2 * ax] = pack8(y1); } }
  }
  if constexpr (NEGM == 1 && QPOST != 1) {
    constexpr float C = ScaleOf<DQK>::v * 1.4426950408889634f;
#pragma unroll
    for (int d0 = 0; d0 < NQ; ++d0) { float y[8];
#pragma unroll
      for (int j = 0; j < 8; ++j) y[j] = bf2f(qr[d0][j]) * C;
      qr[d0] = pack8(y); }
  }
  f32x16 negm = f32x16{};
  if constexpr (NEGM == 1) m_reg = 0.f;
  const int sr = tid >> 4, sc = (tid & 15) * 8, sr8 = tid >> 3, sc8 = (tid & 7) * 8;
  const int vb0 = (int)(uintptr_t)V_lds + v_rd_base(lane);
  auto tile_row = [&](int j) -> int {
    if constexpr (MODE == 0) return krow_base + j * 64;
    else { if (j < 4) return krow_base + j * 64; int kr = na_r0 - 8 + j; kr = kr < 0 ? 0 : (kr > 127 ? 127 : kr); return krow_base + CTX + kr * 64; }
  };
  auto na_mask = [&](f32x16& p0, f32x16& p1, int j) {
    if constexpr (MODE == 1) {
      if (j >= 4) {
        const int krraw = na_r0 - 8 + j, r = na_r0 + (wid >> 1);
        int rs = r - 4; rs = rs < 0 ? 0 : (rs > 120 ? 120 : rs);
        const float NINF = -__builtin_inff();
        if (krraw < rs || krraw >= rs + 8) {
#pragma unroll
          for (int q = 0; q < 16; ++q) { p0[q] = NINF; p1[q] = NINF; }
        } else {
          const float* brow = bias_l + (krraw - r + 7) * 32;
          const int c = (wid & 1) * 32 + r32; int cs = c - 8; cs = cs < 0 ? 0 : (cs > 48 ? 48 : cs);
#pragma unroll
          for (int q = 0; q < 16; ++q) {
            const int k0 = crow(q, hi), k1 = 32 + k0;
            int i0 = k0 - c + 15, i1 = k1 - c + 15; i0 = i0 < 0 ? 0 : (i0 > 30 ? 30 : i0); i1 = i1 < 0 ? 0 : (i1 > 30 ? 30 : i1);
            const float b0 = brow[i0], b1 = brow[i1];
            p0[q] = (k0 >= cs && k0 < cs + 16) ? p0[q] + b0 : NINF;
            p1[q] = (k1 >= cs && k1 < cs + 16) ? p1[q] + b1 : NINF;
          }
        }
      }
    }
  };
  bf16x8 sk[NKC], sv[NVC];
#define SLOAD(j) do { const size_t kr_ = (size_t)tile_row(j);                                                                      \
    if constexpr (DQK >= 128) { sk[0] = *reinterpret_cast<const bf16x8*>(Kp + (kr_ + sr) * ldk + sc); sk[1] = *reinterpret_cast<const bf16x8*>(Kp + (kr_ + 32 + sr) * ldk + sc); } \
    if constexpr (DQK == 192) sk[2] = *reinterpret_cast<const bf16x8*>(K2p + (kr_ + sr8) * ldk + sc8);                                       \
    if constexpr (DQK == 64) sk[0] = *reinterpret_cast<const bf16x8*>(Kp + (kr_ + sr8) * ldk + sc8);                                         \
    if constexpr (DV == 128) { sv[0] = *reinterpret_cast<const bf16x8*>(Vp + (kr_ + sr) * ldk + sc); sv[1] = *reinterpret_cast<const bf16x8*>(Vp + (kr_ + 32 + sr) * ldk + sc); } \
    else sv[0] = *reinterpret_cast<const bf16x8*>(Vp + (kr_ + sr8) * ldk + sc8); } while (0)
#define KSW(row, colB) ((row) * RB + ((colB) ^ ((((DQK >= 128) && ((colB) < 256)) ? ((row) & 15) : ((row) & 7)) << 4)))
#define SWRITE(b) do {                                                                                                                          \
    if constexpr (DV == 128) { *(bf16x8*)(V_lds + (b) * SHM_V + v_st<NCB>(sr, sc)) = sv[0]; *(bf16x8*)(V_lds + (b) * SHM_V + v_st<NCB>(32 + sr, sc)) = sv[1]; } \
    else *(bf16x8*)(V_lds + (b) * SHM_V + v_st<NCB>(sr8, sc8)) = sv[0];                                                                        \
    if constexpr (DQK >= 128) { *(bf16x8*)(K_lds + (b) * SHM_K + KSW(sr, sc * 2)) = sk[0]; *(bf16x8*)(K_lds + (b) * SHM_K + KSW(32 + sr, sc * 2)) = sk[1]; } \
    if constexpr (DQK == 192) *(bf16x8*)(K_lds + (b) * SHM_K + KSW(sr8, 256 + sc8 * 2)) = sk[2];                                              \
    if constexpr (DQK == 64) *(bf16x8*)(K_lds + (b) * SHM_K + KSW(sr8, sc8 * 2)) = sk[0]; } while (0)
  SLOAD(0); asm volatile("s_waitcnt vmcnt(0)" ::: "memory"); SWRITE(0); __syncthreads();
  for (int j = 0; j < NT; ++j) {
    const int bsel = j & 1;
    if (j + 1 < NT) SLOAD(j + 1);
    SBAR();
    bool skip = false;
    if constexpr (MODE == 1) { if (j >= 4) { const int krraw = na_r0 - 8 + j, r = na_r0 + (wid >> 1); int rs = r - 4; rs = rs < 0 ? 0 : (rs > 120 ? 120 : rs); skip = (krraw < rs) || (krraw >= rs + 8); } }
    if (!skip) {
    f32x16 p0, p1; float mn, al; bf16x8 pa0, pa1, pa2, pa3;
    if constexpr (NEGM == 1) { qkt<DQK>(p0, p1, K_lds + bsel * SHM_K, qr, r32, hi, negm); na_mask(p0, p1, j); partialSM2(p0, p1, m_reg, al, negm, j == 0); }
    else { qkt<DQK>(p0, p1, K_lds + bsel * SHM_K, qr, r32, hi); na_mask(p0, p1, j); partialSM<DQK>(p0, p1, m_reg, mn, al); }
    finishSM(p0, p1, al, l_reg, pa0, pa1, pa2, pa3);
    if (__any(al < 1.f)) { if (hi == 0) al_l[r32] = al; asm volatile("s_waitcnt lgkmcnt(0)" ::: "memory");
#pragma unroll
      for (int d = 0; d < NCB; ++d)
#pragma unroll
        for (int r = 0; r < 16; ++r) o[d][r] *= al_l[crow(r, hi)]; }
    SBAR();
    pv_all<NCB>(o, vb0 + bsel * SHM_V, pa0, pa1, pa2, pa3);
    }
    if (j + 1 < NT) SWRITE(bsel ^ 1);
    __syncthreads();
  }
  if (dummy) { if (l_reg == 123.456f) OG[tid] = (bf16_t)(cvtpk(o[0][0], o[1][3]) & 0xffffu); return; }
  if (hi == 0) li_l[r32] = l_reg; asm volatile("s_waitcnt lgkmcnt(0)" ::: "memory");
  float rli[16];
#pragma unroll
  for (int r = 0; r < 16; ++r) rli[r] = __builtin_amdgcn_rcpf(li_l[crow(r, hi)]);
  bf16_t* Ow = OG + (size_t)(wid * 32) * ldo;
#pragma unroll
  for (int r = 0; r < 16; ++r) { const int orow = crow(r, hi);
#pragma unroll
    for (int d0 = 0; d0 < NCB; ++d0) { bf16_t* pp = Ow + (size_t)orow * ldo + d0 * 32 + r32;
      const float g = bf2f((short)*pp); const float v = o[d0][r] * rli[r] * silu_f(g);
      *pp = (bf16_t)(cvtpk(v, v) & 0xffffu); } }
#undef SLOAD
#undef SWRITE
#undef KSW
}

__device__ __forceinline__ void phase_pre(KP p, char* lds, const int tid) {
  float* tl = (float*)lds;
  for (int tt = blockIdx.x; tt < WTAB.ntiles; tt += gridDim.x) {
    int di = 0;
    for (int i = 1; i < NWD; ++i) if (tt >= WTAB.d[i].tile0) di = i;
    const WDesc wd = WTAB.d[di];
    const float* src = p->in[wd.in_idx] + wd.src_off; bf16_t* dst = (bf16_t*)(p->ws + OFF_W) + wd.dst_off; const int K = wd.K, N = wd.N, local = tt - wd.tile0;
    const int nkt = K >> 6, kt = local % nkt, ntile = local / nkt;
    const int kk = tid >> 3, n8 = (tid & 7) * 8;
    f32x4 a = {0.f, 0.f, 0.f, 0.f}, b = a;
    if (ntile * 64 < N) { const float* sp = src + (size_t)(kt * 64 + kk) * N + ntile * 64 + n8; a = *(const f32x4*)sp; b = *(const f32x4*)(sp + 4); }
    __syncthreads();
#pragma unroll
    for (int i = 0; i < 4; ++i) { tl[(n8 + i) * 65 + kk] = a[i]; tl[(n8 + 4 + i) * 65 + kk] = b[i]; }
    __syncthreads();
    const int n = tid >> 3, k8 = (tid & 7) * 8; float v[8];
#pragma unroll
    for (int i = 0; i < 8; ++i) v[i] = tl[n * 65 + k8 + i];
    *(bf16x8*)(dst + (size_t)(ntile * 64 + n) * K + kt * 64 + k8) = pack8(v);
  }
  float* part = (float*)(p->ws + OFF_MODP);
  for (int it = blockIdx.x; it < 4 * 16 * 6; it += gridDim.x) {
    const int nb = it % 6, kc = (it / 6) & 15, layer = it / 96;
    __syncthreads();
    if (tid < 320) { const int s = tid >> 6, kk = tid & 63; const float cv = s < 4 ? p->in[IN_C][s * DM + kc * 64 + kk] : p->in[IN_CCTX][kc * 64 + kk]; tl[tid] = silu_f(cv); }
    __syncthreads();
    const int n = nb * 512 + tid; const float* wp = p->in[IN_MODW] + ((size_t)layer * DM + kc * 64) * 3072 + n;
    float a0 = 0, a1 = 0, a2 = 0, a3 = 0, a4 = 0;
#pragma unroll 8
    for (int kk = 0; kk < 64; ++kk) { const float w = wp[(size_t)kk * 3072]; a0 += tl[kk] * w; a1 += tl[64 + kk] * w; a2 += tl[128 + kk] * w; a3 += tl[192 + kk] * w; a4 += tl[256 + kk] * w; }
    float* pp = part + ((size_t)(kc * 4 + layer) * 5) * 3072 + n;
    pp[0] = a0; pp[3072] = a1; pp[2 * 3072] = a2; pp[3 * 3072] = a3; pp[4 * 3072] = a4;
  }
  for (int i = blockIdx.x * NTHREADS + tid; i < 128 * 48; i += gridDim.x * NTHREADS) {
    int pos, f; float inv; float2* dstp;
    if (i < 128 * 32) { pos = i >> 5; f = i & 31; inv = INV_A[f]; dstp = (float2*)(p->ws + OFF_TABA) + i; }
    else { const int q = i - 128 * 32; pos = q >> 4; f = q & 15; inv = INV_M[f]; dstp = (float2*)(p->ws + OFF_TABM) + q; }
    const float angf = (float)pos * inv;
    const double ang = (double)angf, k = __builtin_rint(ang * 0.15915494309189535), r = ang - k * 6.283185307179586476925287, r2 = r * r;
    double sn = r, cs = 1.0, ts = r, tc = 1.0;
#pragma unroll 1
    for (int q = 1; q <= 14; ++q) { tc = -tc * r2 / (double)((2 * q - 1) * (2 * q)); cs += tc; ts = -ts * r2 / (double)((2 * q) * (2 * q + 1)); sn += ts; }
    *dstp = make_float2((float)cs, (float)sn);
  }
}
__device__ __forceinline__ void phase_modfin(KP p, const int tid) {
  const float* part = (const float*)(p->ws + OFF_MODP); float* mod = (float*)(p->ws + OFF_MOD);
  for (int i = blockIdx.x * NTHREADS + tid; i < 4 * 5 * 3072; i += gridDim.x * NTHREADS) {
    const int n = i % 3072, layer = i / (5 * 3072);
    float a = p->in[IN_MODB][layer * 3072 + n];
#pragma unroll
    for (int kc = 0; kc < 16; ++kc) a += part[(size_t)kc * (4 * 5 * 3072) + i];
    mod[i] = a;
  }
}
__device__ __forceinline__ void phase_norm(KP p, int layer, const int tid) {
  const int lane = tid & 63, gw = blockIdx.x * 8 + (tid >> 6), nw = gridDim.x * 8;
  const float* mod = (const float*)(p->ws + OFF_MOD) + (size_t)layer * 5 * 3072; const float* g = p->in[IN_NORMG] + layer * DM; bf16_t* hb = (bf16_t*)(p->ws + OFF_HB);
  for (int row0 = gw * 4; row0 < T; row0 += nw * 4) {
    f32x4 v[4][4];
#pragma unroll
    for (int r = 0; r < 4; ++r) { const float* xr = res_src(p, layer, row0 + r);
#pragma unroll
      for (int i = 0; i < 4; ++i) v[r][i] = *(const f32x4*)(xr + i * 256 + lane * 4); }
    const int b = row0 / TPB, j = row0 - b * TPB; const float* m = mod + (j < CTX ? 4 : b) * 3072;
    f32x4 gm[4], sh[4];
#pragma unroll
    for (int i = 0; i < 4; ++i) { const int col = i * 256 + lane * 4; const f32x4 gg = *(const f32x4*)(g + col), scl = *(const f32x4*)(m + 1024 + col); sh[i] = *(const f32x4*)(m + col); gm[i] = gg * (1.f + scl); }
#pragma unroll
    for (int r = 0; r < 4; ++r) {
      float ss = 0;
#pragma unroll
      for (int i = 0; i < 4; ++i) ss += v[r][i][0] * v[r][i][0] + v[r][i][1] * v[r][i][1] + v[r][i][2] * v[r][i][2] + v[r][i][3] * v[r][i][3];
      ss = wave_sum(ss); const float rstd = rsqrtf(ss * (1.f / DM) + EPS);
#pragma unroll
      for (int i = 0; i < 4; ++i) { const int col = i * 256 + lane * 4; const f32x4 y = v[r][i] * rstd * gm[i] + sh[i];
        u32x2 w = {cvtpk(y[0], y[1]), cvtpk(y[2], y[3])}; *(u32x2*)(hb + (size_t)(row0 + r) * DM + col) = w; }
    }
  }
}
__device__ __forceinline__ void phase_final(KP p, int dummy, const int tid) {
  const int lane = tid & 63, gw = blockIdx.x * 8 + (tid >> 6), nw = gridDim.x * 8;
  const float* outp = p->out; float* dstp = dummy ? (float*)(p->ws + OFF_PJ) : p->out; const float* fg = p->in[IN_FINALG];
  f32x4 gg[4];
#pragma unroll
  for (int i = 0; i < 4; ++i) gg[i] = *(const f32x4*)(fg + i * 256 + lane * 4);
  for (int row0 = gw * 4; row0 < NB * SEQ; row0 += nw * 4) {
    f32x4 v[4][4];
#pragma unroll
    for (int r = 0; r < 4; ++r)
#pragma unroll
      for (int i = 0; i < 4; ++i) v[r][i] = *(const f32x4*)(outp + (size_t)(row0 + r) * DM + i * 256 + lane * 4);
#pragma unroll
    for (int r = 0; r < 4; ++r) {
      float ss = 0;
#pragma unroll
      for (int i = 0; i < 4; ++i) ss += v[r][i][0] * v[r][i][0] + v[r][i][1] * v[r][i][1] + v[r][i][2] * v[r][i][2] + v[r][i][3] * v[r][i][3];
      ss = wave_sum(ss); const float rstd = rsqrtf(ss * (1.f / DM) + EPS);
#pragma unroll
      for (int i = 0; i < 4; ++i) *(f32x4*)(dstp + (size_t)(row0 + r) * DM + i * 256 + lane * 4) = v[r][i] * rstd * gg[i];
    }
  }
}
__device__ __forceinline__ void phase_gqa_post(KP p, int j, int dummy, const int tid) {
  const int lane = tid & 63, gw = blockIdx.x * 8 + (tid >> 6), nw = gridDim.x * 8, g4 = lane >> 4, i = lane & 15;
  bf16_t* pj = (bf16_t*)(p->ws + (dummy ? OFF_QM : OFF_PJ)); const int ldp = dummy ? 1280 : 2560; const float2* tab = (const float2*)(p->ws + OFF_TABA);
  const float* kg = p->in[IN_GA_KG] + j * 128 + i * 8;
  float gk[8];
#pragma unroll
  for (int e = 0; e < 8; ++e) gk[e] = kg[e];
  const int axis = i >> 3, half = (i >> 2) & 1;
  for (int wi0 = gw * 4; wi0 < T * 2 / 4; wi0 += nw * 4) {
    bf16x8 raw[4]; bf16_t* ptr[4]; int rw[4];
#pragma unroll
    for (int u = 0; u < 4; ++u) { const int hv = (wi0 + u) * 4 + g4; rw[u] = hv >> 1; ptr[u] = pj + (size_t)rw[u] * ldp + 1024 + (hv & 1) * 128 + i * 8; raw[u] = *(const bf16x8*)ptr[u]; }
#pragma unroll
    for (int u = 0; u < 4; ++u) {
      float x[8]; float ss = 0;
#pragma unroll
      for (int e = 0; e < 8; ++e) { x[e] = bf2f(raw[u][e]); ss += x[e] * x[e]; }
      ss += __shfl_xor(ss, 1); ss += __shfl_xor(ss, 2); ss += __shfl_xor(ss, 4); ss += __shfl_xor(ss, 8);
      const float rstd = rsqrtf(ss * (1.f / 128.f) + EPS);
#pragma unroll
      for (int e = 0; e < 8; ++e) x[e] = x[e] * rstd * gk[e];
      const int b = rw[u] / TPB, jj = rw[u] - b * TPB; const bool lat = jj >= CTX; const int t = jj - CTX;
      const int pos = lat ? (axis ? (t & 63) : (t >> 6)) : 0;
      float y[8];
#pragma unroll
      for (int e = 0; e < 8; ++e) { const float xp = __shfl_xor(x[e], 4); const float2 cs = tab[pos * 32 + (i & 3) * 8 + e];
        y[e] = lat ? (half ? x[e] * cs.x + xp * cs.y : x[e] * cs.x - xp * cs.y) : x[e]; }
      *(bf16x8*)ptr[u] = pack8(y);
    }
  }
}
__device__ __forceinline__ void phase_mla_post1(KP p, int dummy, const int tid) {
  const int lane = tid & 63, gw = blockIdx.x * 8 + (tid >> 6), nw = gridDim.x * 8;
  bf16_t* pj = (bf16_t*)(p->ws + (dummy ? OFF_HB : OFF_PJ)); const int ldp = dummy ? 1024 : 2048; const float2* tab = (const float2*)(p->ws + OFF_TABM); const float* qgp = p->in[IN_ML_QG]; const float* kvgp = p->in[IN_ML_KVG];
  const int l2 = lane & 31, l3 = lane & 7;
  float gq[8], gkv[8];
#pragma unroll
  for (int e = 0; e < 8; ++e) { gq[e] = qgp[lane * 8 + e]; gkv[e] = kvgp[l2 * 8 + e]; }
  for (int row0 = gw * 2; row0 < T; row0 += nw * 2) {
    bf16x8 rq[2], rkv[2], rr[2];
#pragma unroll
    for (int u = 0; u < 2; ++u) { bf16_t* pr = pj + (size_t)(row0 + u) * ldp; rq[u] = *(const bf16x8*)(pr + lane * 8); rkv[u] = *(const bf16x8*)(pr + 512 + l2 * 8); rr[u] = *(const bf16x8*)(pr + 768 + l3 * 8); }
#pragma unroll
    for (int u = 0; u < 2; ++u) {
      const int row = row0 + u; bf16_t* pr = pj + (size_t)row * ldp;
      { float x[8]; float ss = 0;
#pragma unroll
        for (int e = 0; e < 8; ++e) { x[e] = bf2f(rq[u][e]); ss += x[e] * x[e]; }
        ss = wave_sum(ss); const float rstd = rsqrtf(ss * (1.f / 512.f) + EPS);
#pragma unroll
        for (int e = 0; e < 8; ++e) x[e] = x[e] * rstd * gq[e];
        *(bf16x8*)(pr + lane * 8) = pack8(x); }
      { float x[8]; float ss = 0;
#pragma unroll
        for (int e = 0; e < 8; ++e) { x[e] = bf2f(rkv[u][e]); ss += x[e] * x[e]; }
        ss = wave_sum(ss) * 0.5f; const float rstd = rsqrtf(ss * (1.f / 256.f) + EPS);
#pragma unroll
        for (int e = 0; e < 8; ++e) x[e] = x[e] * rstd * gkv[e];
        if (lane < 32) *(bf16x8*)(pr + 512 + l2 * 8) = pack8(x); }
      { const int b = row / TPB, jj = row - b * TPB; const bool lat = jj >= CTX; const int t = jj - CTX;
        const int axis = l3 >> 2, half = (l3 >> 1) & 1, pos = lat ? (axis ? (t & 63) : (t >> 6)) : 0; float y[8];
#pragma unroll
        for (int e = 0; e < 8; ++e) { const float x = bf2f(rr[u][e]); const float xp = __shfl_xor(x, 2); const float2 cs = tab[pos * 16 + (l3 & 1) * 8 + e];
          y[e] = half ? x * cs.x + xp * cs.y : x * cs.x - xp * cs.y; }
        if (lat && lane < 8) *(bf16x8*)(pr + 768 + l3 * 8) = pack8(y); }
    }
  }
}
__device__ __forceinline__ void phase_mla_post2(KP p, const int tid) {
  const int lane = tid & 63, gw = blockIdx.x * 8 + (tid >> 6), nw = gridDim.x * 8, h = lane >> 3, i = lane & 7;
  bf16_t* qm = (bf16_t*)(p->ws + OFF_QM); const float2* tab = (const float2*)(p->ws + OFF_TABM);
  const int axis = i >> 2, half = (i >> 1) & 1;
  for (int lr0 = gw * 4; lr0 < NB * SEQ; lr0 += nw * 4) {
    bf16x8 raw[4]; bf16_t* ptr[4];
#pragma unroll
    for (int u = 0; u < 4; ++u) { const int lr = lr0 + u, b = lr >> 13, t = lr & 8191; ptr[u] = qm + ((size_t)b * TPB + CTX + t) * 1536 + h * 192 + 128 + i * 8; raw[u] = *(const bf16x8*)ptr[u]; }
#pragma unroll
    for (int u = 0; u < 4; ++u) { const int t = (lr0 + u) & 8191, pos = axis ? (t & 63) : (t >> 6); float y[8];
#pragma unroll
      for (int e = 0; e < 8; ++e) { const float x = bf2f(raw[u][e]); const float xp = __shfl_xor(x, 2); const float2 cs = tab[pos * 16 + (i & 1) * 8 + e];
        y[e] = half ? x * cs.x + xp * cs.y : x * cs.x - xp * cs.y; }
      *(bf16x8*)ptr[u] = pack8(y); }
  }
}
__device__ __forceinline__ void phase_att_gqa(KP p, int need_ctx, int dummy, int jl, char* lds, const int tid) {
  bf16_t* pj = (bf16_t*)(p->ws + OFF_PJ); const float* qgain = p->in[IN_GA_QG] + jl * 128;
  const int nit = 1024 + (need_ctx ? 32 : 0);
  for (int it = blockIdx.x; it < nit; it += gridDim.x) {
    int b, h, row0, nt, qt0;
    if (it < 1024) { b = it >> 8; h = it & 7; const int qb = (it >> 3) & 31; row0 = b * TPB + CTX + qb * 256; nt = TPB / 64; qt0 = qb * 256; }
    else { const int q = it - 1024; b = q >> 3; h = q & 7; row0 = b * TPB; nt = CTX / 64; qt0 = -1; }
    __syncthreads();
    attn_body_seq<128, 128, 0, 1, 1, 2560, 2560, 2560>(pj + (size_t)row0 * 2560 + h * 128, pj + 1024 + (h >> 2) * 128, nullptr, pj + 1280 + (h >> 2) * 128, b * TPB,
                           pj + (size_t)row0 * 2560 + 1536 + h * 128, nt, 0, lds, tid, dummy, qgain, (const float2*)(p->ws + OFF_TABA), qt0);
  }
}
__device__ __forceinline__ void phase_att_mla(KP p, int need_ctx, int dummy, char* lds, const int tid) {
  bf16_t* pj = (bf16_t*)(p->ws + OFF_PJ); bf16_t* kvm = pj + (size_t)T * 2048; bf16_t* qm = (bf16_t*)(p->ws + OFF_QM);
  const int nit = 1024 + (need_ctx ? 32 : 0);
  for (int it = blockIdx.x; it < nit; it += gridDim.x) {
    int b, h, row0, nt, qt0;
    if (it < 1024) { b = it >> 8; h = it & 7; const int qb = (it >> 3) & 31; row0 = b * TPB + CTX + qb * 256; nt = TPB / 64; qt0 = qb * 256; }
    else { const int q = it - 1024; b = q >> 3; h = q & 7; row0 = b * TPB; nt = CTX / 64; qt0 = -1; }
    __syncthreads();
    attn_body_seq<192, 128, 0, 0, 0, 1536, 2048, 2048>(qm + (size_t)row0 * 1536 + h * 192, kvm + h * 256, pj + 768, kvm + h * 256 + 128, b * TPB,
                            pj + (size_t)row0 * 2048 + 832 + h * 128, nt, 0, lds, tid, dummy, nullptr, (const float2*)(p->ws + OFF_TABM), qt0);
  }
}
__device__ __forceinline__ void phase_att_na(KP p, int need_ctx, int dummy, char* lds, const int tid) {
  bf16_t* pj = (bf16_t*)(p->ws + OFF_PJ);
  float* bias_l = (float*)(lds + 2 * 8192 + 2 * 8192 + 8 * 64 * 4);
  const int nit = 2048 + (need_ctx ? 64 : 0);
  for (int it = blockIdx.x; it < nit; it += gridDim.x) {
    __syncthreads();
    int ntl = it < 2048 ? 16 : 4; asm volatile("" : "+s"(ntl));
    if (it < 2048) {
      const int b = it >> 9, h = it & 15, r0 = ((it >> 4) & 31) * 4, row0 = b * TPB + CTX + r0 * 64;
      if (tid < 15 * 32) { const int ro = tid >> 5, co = tid & 31; bias_l[tid] = co < 31 ? p->in[IN_NA_RPB][(h * 15 + ro) * 31 + co] * 1.4426950408889634f : 0.f; }
      attn_body_seq<64, 64, 1, 0, 1, 4096, 4096, 4096>(pj + (size_t)row0 * 4096 + h * 64, pj + 1024 + h * 64, nullptr, pj + 2048 + h * 64, b * TPB,
                           pj + (size_t)row0 * 4096 + 3072 + h * 64, ntl, r0, lds, tid, dummy, nullptr, nullptr, -1);
    } else {
      const int q = it - 2048, b = q >> 4, h = q & 15, row0 = b * TPB;
      attn_body_seq<64, 64, 0, 0, 1, 4096, 4096, 4096>(pj + (size_t)row0 * 4096 + h * 64, pj + 1024 + h * 64, nullptr, pj + 2048 + h * 64, b * TPB,
                           pj + (size_t)row0 * 4096 + 3072 + h * 64, ntl, 0, lds, tid, dummy, nullptr, nullptr, -1);
    }
  }
}

#define XB_TMO      128
#define XB_XCNT(j)  (256  + 64 * (j))
#define XB_XSUB(j)  (1280 + 64 * (j))
#define XB_XGEN(j)  (2304 + 64 * (j))
#define XB_TOP      3328
#define XB_TOPGEN   3392
#define XCD_BAR_WORDS 3456
#define XB_SPIN_CAP (1u << 22)
__device__ __forceinline__ unsigned xb_ld(unsigned* p)              { return __hip_atomic_load(p, __ATOMIC_RELAXED, __HIP_MEMORY_SCOPE_AGENT); }
__device__ __forceinline__ unsigned xb_add(unsigned* p, unsigned v) { return __hip_atomic_fetch_add(p, v, __ATOMIC_RELAXED, __HIP_MEMORY_SCOPE_AGENT); }
__device__ __forceinline__ unsigned xb_xcc_id() { return (unsigned)__builtin_amdgcn_s_getreg((3 << 11) | 20) & 0xFu; }
#define XB_SPIN(cond, bar) do { unsigned _sp = 0; while (cond) { __builtin_amdgcn_s_sleep(1); \
    if ((++_sp & 255u) == 0u) { if (xb_ld(&(bar)[XB_TMO])) break; if (_sp > XB_SPIN_CAP) { atomicAdd(&(bar)[XB_TMO], 1u); break; } } } } while (0)
struct XcdBarrier { unsigned* bar; unsigned x; volatile LAS unsigned* st; };
__device__ __forceinline__ XcdBarrier xcd_barrier_post(unsigned* bar, volatile LAS unsigned* st) {
    XcdBarrier b; b.bar = bar; b.x = xb_xcc_id(); b.st = st;
    if (threadIdx.x == 0) (void)xb_add(&bar[XB_XCNT(b.x)], 1u);
    return b;
}
__device__ __forceinline__ void xcd_barrier_complete(unsigned* bar, unsigned x, unsigned& nloc, unsigned& nx) {
    const unsigned G = gridDim.x * gridDim.y * gridDim.z;
    unsigned sum, cnt, mine, sp = 0u;
    for (;;) {
        sum = 0u; cnt = 0u; mine = 0u;
#pragma unroll
        for (unsigned j = 0; j < 16; ++j) { const unsigned c = xb_ld(&bar[XB_XCNT(j)]); sum += c; cnt += (c > 0u) ? 1u : 0u; mine = (j == x) ? c : mine; }
        if (sum == G) break;
        __builtin_amdgcn_s_sleep(1);
        if ((++sp & 255u) == 0u) { if (xb_ld(&bar[XB_TMO])) break; if (sp > XB_SPIN_CAP) { atomicAdd(&bar[XB_TMO], 1u); break; } }
    }
    nloc = mine > 0u ? mine : 1u; nx = cnt > 0u ? cnt : 1u;
}
__device__ __forceinline__ void xcd_barrier(const XcdBarrier& b, const int tid) {
    asm volatile("s_waitcnt vmcnt(0)" ::: "memory");
    __syncthreads();
    if (tid == 0) {
        unsigned* bar = b.bar;
        __builtin_amdgcn_s_waitcnt(0);
        unsigned nloc = b.st[0], nx = b.st[1];
        if (nloc == 0u) { xcd_barrier_complete(bar, b.x, nloc, nx); b.st[0] = nloc; b.st[1] = nx; }
        const unsigned old = xb_add(&bar[XB_XSUB(b.x)], 1u);
        const unsigned gen = old / nloc;
        if (old + 1u == (gen + 1u) * nloc) {
            __builtin_amdgcn_fence(__ATOMIC_RELEASE, "agent");
            asm volatile("s_waitcnt vmcnt(0)" ::: "memory");
            const unsigned og = xb_add(&bar[XB_TOP], 1u);
            const unsigned tg = og / nx;
            if (og + 1u == (tg + 1u) * nx) xb_add(&bar[XB_TOPGEN], 1u);
            else XB_SPIN(xb_ld(&bar[XB_TOPGEN]) == tg, bar);
            __builtin_amdgcn_fence(__ATOMIC_ACQUIRE, "agent");
            xb_add(&bar[XB_XGEN(b.x)], 1u);
            asm volatile("s_waitcnt vmcnt(0)" ::: "memory");
        } else {
            XB_SPIN(xb_ld(&bar[XB_XGEN(b.x)]) == gen, bar);
            __builtin_amdgcn_fence(__ATOMIC_ACQUIRE, "agent");
            asm volatile("s_waitcnt vmcnt(0)" ::: "memory");
        }
    }
    __syncthreads();
}

__global__ void __launch_bounds__(NTHREADS, 2) fwd_megakernel(const Params p_unused) {
  extern __shared__ __attribute__((aligned(16))) unsigned char shm[];
  cg::grid_group grid = cg::this_grid();
  char* lds = (char*)shm;
  __shared__ uint4 xb_words;
  const int wave_s = __builtin_amdgcn_readfirstlane((int)(threadIdx.x >> 6));
  if (threadIdx.x == 0) xb_words = make_uint4(0u, 0u, 0u, 0u);
  __syncthreads();
  { KP p0 = (KP)__builtin_amdgcn_kernarg_segment_ptr(); (void)xcd_barrier_post((unsigned*)(p0->ws + OFF_BAR), (volatile LAS unsigned*)&xb_words);
    phase_pre(p0, lds, (int)threadIdx.x); }
  { KP p0 = (KP)__builtin_amdgcn_kernarg_segment_ptr(); char* w0 = p0->ws;
    if (w0 == nullptr) grid.sync();
    XcdBarrier xb; xb.bar = (unsigned*)(w0 + OFF_BAR); xb.x = xb_xcc_id(); xb.st = (volatile LAS unsigned*)&xb_words; xcd_barrier(xb, (int)threadIdx.x); }
#ifndef PHM
#define PHM 0xffff
#endif
#define PH(k) if constexpr (((PHM) >> (k)) & 1)
  for (int oi = 1; oi < PROG.n; ++oi) {
    const Op op = PROG.ops[oi];
    unsigned zz = 0u; asm volatile("" : "+v"(zz));
    int tid = wave_s * 64 + (int)__builtin_amdgcn_mbcnt_hi(~0u, __builtin_amdgcn_mbcnt_lo(~0u, zz)); asm volatile("" : "+v"(tid));
    KP p = (KP)__builtin_amdgcn_kernarg_segment_ptr(); asm volatile("" : "+s"(p));
    char* ws = p->ws;
    switch (op.type) {
      case OP_MODFIN: PH(1) phase_modfin(p, tid); break;
      case OP_NORM: PH(2) phase_norm(p, op.i0, tid); break;
      case OP_GEMM_BF: case OP_GEMM_BF_NOSYNC: PH(3) {
        pg8::Gemm g{(const bf16_t*)(ws + op.a), (const bf16_t*)(ws + op.b), T, op.i0, op.i1, op.i2};
        pg8::StaticOrder S; S.init(T, op.i0, (int)gridDim.x, (int)blockIdx.x);
        pg8::EpiBf16 E{(bf16_t*)(ws + op.o), op.i0};
        pg8::gemm_phase<pg8::EpiBf16>((LAS unsigned char*)shm, g, S, E, tid);
      } break;
      case OP_GEMM_RES: PH(4) {
        pg8::Gemm g{(const bf16_t*)(ws + op.a), (const bf16_t*)(ws + op.b), T, DM, DM, op.i2};
        pg8::StaticOrder S; S.init(T, DM, (int)gridDim.x, (int)blockIdx.x, op.i0 == DEPTH - 1);
        float* xsc = (float*)(ws + OFF_XSC); float* outp = p->out;
        pg8::EpiResid E{op.i0 == 0 ? p->in[IN_X] : (const float*)outp, op.i0 == 0 ? p->in[IN_CTX] : (const float*)xsc, outp, xsc, (const float*)(ws + OFF_MOD) + (size_t)op.i0 * 5 * 3072};
        pg8::gemm_phase<pg8::EpiResid>((LAS unsigned char*)shm, g, S, E, tid);
      } break;
      case OP_GQA_POST: PH(5) phase_gqa_post(p, op.i0, op.i1, tid); break;
      case OP_ATT_GQA: PH(6) phase_att_gqa(p, op.i0, op.i1, op.i2, lds, tid); break;
      case OP_ATT_NA: PH(7) phase_att_na(p, op.i0, op.i1, lds, tid); break;
      case OP_MLA_POST1: PH(8) phase_mla_post1(p, op.i1, tid); break;
      case OP_MLA_POST2: PH(9) phase_mla_post2(p, tid); break;
      case OP_ATT_MLA: PH(10) phase_att_mla(p, op.i0, op.i1, lds, tid); break;
      case OP_FINAL: PH(11) phase_final(p, op.i1, tid); break;
      default: break;
    }
    if (op.type == OP_GEMM_BF_NOSYNC) __syncthreads(); else { XcdBarrier xb; xb.bar = (unsigned*)(ws + OFF_BAR); xb.x = xb_xcc_id(); xb.st = (volatile LAS unsigned*)&xb_words; xcd_barrier(xb, tid);
      if (PROBE_DUP & 512) { xcd_barrier(xb, tid); xcd_barrier(xb, tid); } }
  }
}

extern "C" void kernel_launch(void* const* d_in, const int* in_sizes, int n_in, void* d_out, int out_size, void* d_ws, size_t ws_size, hipStream_t stream) {
  static int grid_blocks = 0;
  if (!grid_blocks) {
    if (ws_size < WS_END) { fprintf(stderr, "kernel_launch: workspace too small: %zu < %zu\n", ws_size, (size_t)WS_END); return; }
    if (hipFuncSetAttribute((const void*)fwd_megakernel, hipFuncAttributeMaxDynamicSharedMemorySize, LDS_BYTES) != hipSuccess) { fprintf(stderr, "kernel_launch: hipFuncSetAttribute failed\n"); return; }
    int dev = 0, cus = 0, per_cu = 0;
    hipGetDevice(&dev);
    hipDeviceGetAttribute(&cus, hipDeviceAttributeMultiprocessorCount, dev);
    hipOccupancyMaxActiveBlocksPerMultiprocessor(&per_cu, fwd_megakernel, NTHREADS, LDS_BYTES);
    if (per_cu < 1) { fprintf(stderr, "kernel_launch: occupancy query returned %d\n", per_cu); return; }
    grid_blocks = cus;
  }
  Params p; memset(&p, 0, sizeof(p));
  if (n_in != N_IN) { fprintf(stderr, "kernel_launch: expected %d inputs, got %d\n", (int)N_IN, n_in); return; }
  for (int i = 0; i < N_IN; ++i) p.in[i] = (const float*)d_in[i];
  p.out = (float*)d_out; p.ws = (char*)d_ws;
  hipMemsetAsync((char*)d_ws + OFF_BAR, 0, XCD_BAR_WORDS * 4, stream);
  void* args[] = {&p};
  hipError_t e = hipLaunchCooperativeKernel((const void*)fwd_megakernel, dim3(grid_blocks), dim3(NTHREADS), args, LDS_BYTES, stream);
  if (e != hipSuccess) fprintf(stderr, "kernel_launch: cooperative launch failed: %s (grid %d)\n", hipGetErrorString(e), grid_blocks);
}
```
